# Optimizing an MI355X kernel written in HIP

```python
import math
import jax, jax.numpy as jnp
from jax import lax
import numpy as np

D_MODEL = 1024
BATCH = 8
SEQ = 2048
DEPTH = 2

CHUNK = 64
RET_HEADS = 8
RET_QK = D_MODEL // 2
RET_V = D_MODEL
RET_QK_DIM = RET_QK // RET_HEADS
RET_V_DIM = RET_V // RET_HEADS
ROPE_BASE = 10000.0
S5_WIDTH = D_MODEL // 2
S5_GROUP_CH = 16
S5_GROUPS = S5_WIDTH // S5_GROUP_CH
S5_STATE = 64
MOE_GROUPS = 4
EXPERTS_PER_GROUP = 8
N_EXPERTS = MOE_GROUPS * EXPERTS_PER_GROUP
TOP_K_IN_GROUP = 2
EXPERT_FF = D_MODEL // 4
LN_EPS = 1e-5
HEAD_NORM_EPS = 1e-6
DN_ALPHA = (2 * DEPTH) ** 0.25
DN_BETA = (8 * DEPTH) ** -0.25
IN_WIDTH = 2 * RET_QK + 2 * RET_V + S5_WIDTH + 2 * D_MODEL
IN_SPLITS = (RET_QK, 2 * RET_QK, 2 * RET_QK + RET_V, 2 * RET_QK + 2 * RET_V,
             2 * RET_QK + 2 * RET_V + S5_WIDTH, 2 * RET_QK + 2 * RET_V + S5_WIDTH + D_MODEL)

kernel_name = 'hybrid_retention_s5_hmoe'


def layer_norm(x, g, b):
    xf = x.astype(jnp.float32)
    mu = jnp.mean(xf, -1, keepdims=True)
    var = jnp.mean(jnp.square(xf - mu), -1, keepdims=True)
    return ((xf - mu) * lax.rsqrt(var + LN_EPS) * g.astype(jnp.float32) + b.astype(jnp.float32)).astype(x.dtype)


def rope_tables(seq_len, dim):
    half = dim // 2
    inv_freq = ROPE_BASE ** (-jnp.arange(half, dtype=jnp.float32) / half)
    ang = jnp.arange(seq_len, dtype=jnp.float32)[:, None] * inv_freq[None, :]
    return jnp.cos(ang), jnp.sin(ang)


def rotary(x, cos, sin):
    x1, x2 = jnp.split(x, 2, axis=-1)
    c = cos[None, :, None, :]
    s = sin[None, :, None, :]
    return jnp.concatenate([x1 * c - x2 * s, x1 * s + x2 * c], axis=-1)


def chunk_retention(q, k, v):
    b, s, h, dk = q.shape
    dv = v.shape[-1]
    nc = s // CHUNK
    log_gamma = jnp.log1p(-(2.0 ** (-5.0 - jnp.arange(h, dtype=jnp.float32))))
    pos = jnp.arange(CHUNK, dtype=jnp.float32)
    intra = jnp.exp(log_gamma[:, None, None] * jnp.abs(pos[:, None] - pos[None, :]))
    k_decay = jnp.exp(log_gamma[None, :] * (CHUNK - 1.0 - pos)[:, None])
    q_decay = jnp.exp(log_gamma[None, :] * (pos + 1.0)[:, None])
    chunk_decay = jnp.exp(log_gamma * CHUNK)
    qc = q.reshape(b, nc, CHUNK, h, dk)
    kc = k.reshape(b, nc, CHUNK, h, dk) * (dk ** -0.5)
    vc = v.reshape(b, nc, CHUNK, h, dv)
    scores = jnp.einsum('bnihd,bnjhd->bnhij', qc, kc) * intra[None, None]
    o_intra = jnp.einsum('bnhij,bnjhe->bnihe', scores, vc)
    kv = jnp.einsum('bnjhd,bnjhe->nbhde', kc * k_decay[:, :, None], vc)

    def step(state, kv_n):
        return chunk_decay[None, :, None, None] * state + kv_n, state

    _, states = lax.scan(step, jnp.zeros_like(kv[0]), kv)
    o_inter = jnp.einsum('bnihd,nbhde->bnihe', qc * q_decay[:, :, None], states)
    return (o_intra + o_inter).reshape(b, s, h, dv)


def s5_ssm(u, lam_re, lam_im, log_step, b_re, b_im, c_re, c_im, d_skip):
    f32 = jnp.float32
    bsz, s, _ = u.shape
    lam_re = jnp.minimum(lam_re.astype(f32), -1e-4)
    lam_im = lam_im.astype(f32)
    b_re, b_im = b_re.astype(f32), b_im.astype(f32)
    c_re, c_im = c_re.astype(f32), c_im.astype(f32)
    ug = u.reshape(bsz, s, S5_GROUPS, S5_GROUP_CH)
    step = jnp.exp(log_step.astype(f32))[:, None]
    mag = jnp.exp(lam_re * step)
    ang = lam_im * step
    ab_re = mag * jnp.cos(ang)
    ab_im = mag * jnp.sin(ang)
    den = lam_re * lam_re + lam_im * lam_im
    n_re = ab_re - 1.0
    zc_re = (n_re * lam_re + ab_im * lam_im) / den
    zc_im = (ab_im * lam_re - n_re * lam_im) / den
    bb_re = zc_re[..., None] * b_re - zc_im[..., None] * b_im
    bb_im = zc_re[..., None] * b_im + zc_im[..., None] * b_re
    bu_re = jnp.einsum('bsgc,gnc->bsgn', ug, bb_re)
    bu_im = jnp.einsum('bsgc,gnc->bsgn', ug, bb_im)
    a_re = jnp.broadcast_to(ab_re[None, None], (1, s, S5_GROUPS, S5_STATE))
    a_im = jnp.broadcast_to(ab_im[None, None], (1, s, S5_GROUPS, S5_STATE))

    def combine(e1, e2):
        a1r, a1i, b1r, b1i = e1
        a2r, a2i, b2r, b2i = e2
        return (a2r * a1r - a2i * a1i, a2r * a1i + a2i * a1r,
                a2r * b1r - a2i * b1i + b2r, a2r * b1i + a2i * b1r + b2i)

    _, _, h_re, h_im = lax.associative_scan(combine, (a_re, a_im, bu_re, bu_im), axis=1)
    y = jnp.einsum('bsgn,gcn->bsgc', h_re, c_re) - jnp.einsum('bsgn,gcn->bsgc', h_im, c_im)
    return y.reshape(bsz, s, S5_WIDTH) + d_skip.astype(f32) * u


def hybrid_mixer(h, w_in, lam_re, lam_im, log_step, b_re, b_im, c_re, c_im, d_skip,
                 w_glu, w_branch_ret, w_branch_s5, w_out, cos, sin):
    f32 = jnp.float32
    bsz, s, _ = h.shape
    proj = h @ w_in
    q, k, v, g_ret, u, gate_ret, gate_s5 = jnp.split(proj, IN_SPLITS, axis=-1)
    q = rotary(q.reshape(bsz, s, RET_HEADS, RET_QK_DIM).astype(f32), cos, sin)
    k = rotary(k.reshape(bsz, s, RET_HEADS, RET_QK_DIM).astype(f32), cos, sin)
    v = v.reshape(bsz, s, RET_HEADS, RET_V_DIM).astype(f32)
    o = chunk_retention(q, k, v)
    mu = jnp.mean(o, -1, keepdims=True)
    var = jnp.mean(jnp.square(o - mu), -1, keepdims=True)
    o = ((o - mu) * lax.rsqrt(var + HEAD_NORM_EPS)).reshape(bsz, s, RET_V).astype(h.dtype)
    ret_branch = (jax.nn.silu(g_ret) * o) @ w_branch_ret
    y = s5_ssm(u.astype(f32), lam_re, lam_im, log_step, b_re, b_im, c_re, c_im, d_skip).astype(h.dtype)
    z = jax.nn.gelu(y)
    s5_branch = (z * jax.nn.sigmoid(z @ w_glu)) @ w_branch_s5
    merged = jax.nn.sigmoid(gate_ret) * ret_branch + jax.nn.sigmoid(gate_s5) * s5_branch
    return merged @ w_out


def hier_moe(h, w_rg, b_rg, w_re, b_re, w_gate, w_up, w_down):
    f32 = jnp.float32
    bsz, s, d = h.shape
    xt = h.reshape(-1, d)
    t = xt.shape[0]
    g_prob = jax.nn.softmax((xt @ w_rg + b_rg).astype(f32), axis=-1)
    g_top, g_idx = lax.top_k(g_prob, 1)
    g_onehot = jax.nn.one_hot(g_idx[:, 0], MOE_GROUPS, dtype=f32)
    e_logits = (xt @ w_re + b_re).astype(f32).reshape(t, MOE_GROUPS, EXPERTS_PER_GROUP)
    e_logits = jnp.einsum('tge,tg->te', e_logits, g_onehot)
    e_prob = jax.nn.softmax(e_logits, axis=-1)
    e_top, e_idx = lax.top_k(e_prob, TOP_K_IN_GROUP)
    e_top = e_top / jnp.sum(e_top, -1, keepdims=True)
    w_local = jnp.sum(jax.nn.one_hot(e_idx, EXPERTS_PER_GROUP, dtype=f32) * e_top[..., None], axis=1)
    comb = (g_onehot[:, :, None] * (g_top[:, :, None] * w_local[:, None, :])).astype(h.dtype)
    out = jnp.zeros_like(xt)
    for gi in range(MOE_GROUPS):
        sl = slice(gi * EXPERTS_PER_GROUP, (gi + 1) * EXPERTS_PER_GROUP)
        act = jax.nn.silu(jnp.einsum('td,edf->tef', xt, w_gate[sl])) * jnp.einsum('td,edf->tef', xt, w_up[sl])
        out = out + jnp.einsum('tef,efd->td', act * comb[:, gi, :, None], w_down[sl])
    return out.reshape(bsz, s, d)


def setup_inputs(seed: int = 0) -> dict:
    key = jax.random.key(seed)
    ks = jax.random.split(key, 32)
    f32 = jnp.float32
    L, D = DEPTH, D_MODEL
    G, N, GC = S5_GROUPS, S5_STATE, S5_GROUP_CH

    def nrm(k, shape, scale):
        return scale * jax.random.normal(k, shape, f32)

    col_scale = jnp.concatenate([jnp.ones((2 * RET_QK,), f32), jnp.full((RET_V,), DN_BETA, f32),
                                 jnp.ones((IN_WIDTH - 2 * RET_QK - RET_V,), f32)])
    return {
        'x': jax.random.normal(ks[0], (BATCH, SEQ, D), f32),
        'ln_in_g': 1.0 + nrm(ks[1], (D,), 0.01),
        'ln_in_b': nrm(ks[2], (D,), 0.01),
        'w_in': nrm(ks[3], (L, D, IN_WIDTH), D ** -0.5) * col_scale,
        's5_lambda_re': -0.5 + nrm(ks[4], (L, G, N), 0.01),
        's5_lambda_im': math.pi * jnp.arange(N, dtype=f32) + nrm(ks[5], (L, G, N), 0.01),
        's5_log_step': jax.random.uniform(ks[6], (L, G), f32, math.log(1e-3), math.log(1e-1)),
        's5_b_re': nrm(ks[7], (L, G, N, GC), (2.0 * GC) ** -0.5),
        's5_b_im': nrm(ks[8], (L, G, N, GC), (2.0 * GC) ** -0.5),
        's5_c_re': nrm(ks[9], (L, G, GC, N), N ** -0.5),
        's5_c_im': nrm(ks[10], (L, G, GC, N), N ** -0.5),
        's5_d': nrm(ks[11], (L, S5_WIDTH), 1.0),
        'w_glu': nrm(ks[12], (L, S5_WIDTH, S5_WIDTH), S5_WIDTH ** -0.5),
        'w_branch_ret': nrm(ks[13], (L, RET_V, D), RET_V ** -0.5 * DN_BETA),
        'w_branch_s5': nrm(ks[14], (L, S5_WIDTH, D), S5_WIDTH ** -0.5 * DN_BETA),
        'w_out': nrm(ks[15], (L, D, D), D ** -0.5 * DN_BETA),
        'ln_mix_g': 1.0 + nrm(ks[16], (L, D), 0.01),
        'ln_mix_b': nrm(ks[17], (L, D), 0.01),
        'w_router_group': nrm(ks[18], (L, D, MOE_GROUPS), D ** -0.5),
        'b_router_group': nrm(ks[19], (L, MOE_GROUPS), 0.01),
        'w_router_expert': nrm(ks[20], (L, D, N_EXPERTS), D ** -0.5),
        'b_router_expert': nrm(ks[21], (L, N_EXPERTS), 0.01),
        'w_exp_gate': nrm(ks[22], (L, N_EXPERTS, D, EXPERT_FF), D ** -0.5),
        'w_exp_up': nrm(ks[23], (L, N_EXPERTS, D, EXPERT_FF), D ** -0.5 * DN_BETA),
        'w_exp_down': nrm(ks[24], (L, N_EXPERTS, EXPERT_FF, D), EXPERT_FF ** -0.5 * DN_BETA),
        'ln_ffn_g': 1.0 + nrm(ks[25], (L, D), 0.01),
        'ln_ffn_b': nrm(ks[26], (L, D), 0.01),
    }


def reference(x, ln_in_g, ln_in_b, w_in, s5_lambda_re, s5_lambda_im, s5_log_step,
              s5_b_re, s5_b_im, s5_c_re, s5_c_im, s5_d, w_glu, w_branch_ret, w_branch_s5,
              w_out, ln_mix_g, ln_mix_b, w_router_group, b_router_group, w_router_expert,
              b_router_expert, w_exp_gate, w_exp_up, w_exp_down, ln_ffn_g, ln_ffn_b):
    cos, sin = rope_tables(x.shape[1], RET_QK_DIM)
    h = layer_norm(x, ln_in_g, ln_in_b)
    for l in range(DEPTH):
        mix = hybrid_mixer(h, w_in[l], s5_lambda_re[l], s5_lambda_im[l], s5_log_step[l],
                           s5_b_re[l], s5_b_im[l], s5_c_re[l], s5_c_im[l], s5_d[l],
                           w_glu[l], w_branch_ret[l], w_branch_s5[l], w_out[l], cos, sin)
        h = layer_norm(DN_ALPHA * h + mix, ln_mix_g[l], ln_mix_b[l])
        ffn = hier_moe(h, w_router_group[l], b_router_group[l], w_router_expert[l],
                       b_router_expert[l], w_exp_gate[l], w_exp_up[l], w_exp_down[l])
        h = layer_norm(DN_ALPHA * h + ffn, ln_ffn_g[l], ln_ffn_b[l])
    return h
```

```cpp
#include <hip/hip_runtime.h>
#include <cstdio>
#include <cstdint>
#include <cmath>

typedef unsigned short bf16;
#define DEV __device__ __forceinline__

constexpr int Dm = 1024, BATCH = 8, SEQ = 2048, T = BATCH * SEQ, DEPTH = 2;
constexpr int CHUNK = 64, NCH = SEQ / CHUNK;
constexpr int RH = 8, RQK = 512, RV = 1024, DK = 64, DV = 128;
constexpr int S5W = 512, S5G = 32, S5GC = 16, S5N = 64;
constexpr int MG = 4, EPG = 8, NE = 32, FF = 256;
constexpr int INW = 5632;
constexpr float LN_EPS = 1e-5f, HN_EPS = 1e-6f;
constexpr float ALPHA = 1.41421356237309515f;

constexpr size_t MiB = 1u << 20;
constexpr size_t WS_CTL = 0;
constexpr size_t WS_CNT = 64 * 1024;
constexpr size_t WS_TAB = 1 * MiB;
constexpr size_t TAB_COS = WS_TAB;
constexpr size_t TAB_SIN = TAB_COS + 2048 * 32 * 4;
constexpr size_t TAB_POWG = TAB_SIN + 2048 * 32 * 4;
constexpr size_t TAB_AB = TAB_POWG + 8 * 80 * 4;
constexpr size_t TAB_BB = TAB_AB + DEPTH * S5G * S5N * 2 * 4;
constexpr size_t TAB_END = TAB_BB + (size_t)DEPTH * S5G * S5N * 16 * 2 * 4;
static_assert(TAB_END <= 3 * MiB, "tables");
constexpr size_t WS_S5E = 3 * MiB;
constexpr size_t WS_ROUTE = 7 * MiB;
constexpr size_t RT_E = WS_ROUTE, RT_C = RT_E + (size_t)T * 2 * 4, RT_LIST = RT_C + (size_t)T * 2 * 4;
static_assert(RT_LIST + (size_t)NE * T * 4 <= 10 * MiB, "route");
constexpr size_t WS_WSM = 10 * MiB;
constexpr size_t W_IN = WS_WSM;
constexpr size_t W_GLU = W_IN + (size_t)DEPTH * INW * Dm * 2;
constexpr size_t W_BRET = W_GLU + (size_t)DEPTH * S5W * S5W * 2;
constexpr size_t W_BS5 = W_BRET + (size_t)DEPTH * Dm * RV * 2;
constexpr size_t W_OUT = W_BS5 + (size_t)DEPTH * Dm * S5W * 2;
constexpr size_t W_END = W_OUT + (size_t)DEPTH * Dm * Dm * 2;
static_assert(W_END <= 44 * MiB, "small weights");
constexpr size_t WS_HB = 44 * MiB;
constexpr size_t WS_HBF = 108 * MiB;
constexpr size_t WS_R1 = 140 * MiB;
constexpr size_t R_Q = WS_R1, R_K = R_Q + 16 * MiB, R_U = R_K + 16 * MiB, R_GR = R_U + 16 * MiB, R_GS = R_GR + 32 * MiB;
constexpr size_t WS_R2 = 252 * MiB;
constexpr size_t R_V = WS_R2, R_G = R_V + 32 * MiB;
constexpr size_t WS_END = 316 * MiB;
constexpr size_t R_S5IN = R_Q;
constexpr size_t R_WGU = WS_R1;
constexpr size_t R_WDN = WS_R1 + 32 * MiB;
constexpr size_t R_ACT = WS_R1 + 48 * MiB;
constexpr size_t R_Y = WS_R2;

DEV float bf2f(bf16 v) { return __uint_as_float((unsigned)v << 16); }
DEV bf16 f2bf(float f) { unsigned u = __float_as_uint(f); return (bf16)((u + 0x7fffu + ((u >> 16) & 1u)) >> 16); }
DEV float sigmoidf_(float x) { return 1.f / (1.f + __expf(-x)); }
DEV float siluf_(float x) { return x * sigmoidf_(x); }
DEV float geluf_(float x) { const float c = 0.7978845608028654f; float t = tanhf(c * (x + 0.044715f * x * x * x)); return 0.5f * x * (1.f + t); }
DEV float wave_sum(float v) {
#pragma unroll
    for (int o = 1; o < 64; o <<= 1) v += __shfl_xor(v, o);
    return v;
}

__global__ void __launch_bounds__(256) k_convT(const float* __restrict__ src, bf16* __restrict__ dst, int K, int N, int rmul, int radd, int dzrows) {
    __shared__ float tile[32][33];
    const int z = blockIdx.z; src += (size_t)z * K * N; dst += (size_t)z * dzrows * K;
    const int n0 = blockIdx.x * 32, k0 = blockIdx.y * 32, tx = threadIdx.x & 31, ty = threadIdx.x >> 5;
#pragma unroll
    for (int i = 0; i < 4; ++i) tile[ty + 8 * i][tx] = src[(size_t)(k0 + ty + 8 * i) * N + n0 + tx];
    __syncthreads();
#pragma unroll
    for (int i = 0; i < 4; ++i) { const int n = n0 + ty + 8 * i; dst[(size_t)(n * rmul + radd) * K + k0 + tx] = f2bf(tile[tx][ty + 8 * i]); }
}

__global__ void __launch_bounds__(256) k_tables(const float* lam_re, const float* lam_im, const float* log_step, const float* b_re, const float* b_im, unsigned char* ws) {
    const int gid = blockIdx.x * 256 + threadIdx.x;
    float* COS = (float*)(ws + TAB_COS); float* SIN = (float*)(ws + TAB_SIN); float* POWG = (float*)(ws + TAB_POWG);
    float* AB = (float*)(ws + TAB_AB); float* BB = (float*)(ws + TAB_BB);
    if (gid < 2048 * 32) { const int pos = gid >> 5, i = gid & 31; const float inv = (float)pow(10000.0, -(double)i / 32.0); const float ang = (float)pos * inv;
        COS[gid] = (float)cos((double)ang); SIN[gid] = (float)sin((double)ang); }
    if (gid < 8 * 80) { const int h = gid / 80, n = gid % 80; const double g = 1.0 - pow(2.0, -5.0 - h); POWG[gid] = (float)pow(g, (double)n); }
    if (gid < DEPTH * S5G * S5N) {
        const int g = (gid / S5N) % S5G, l = gid / (S5G * S5N);
        double lr = lam_re[gid]; if (lr > -1e-4) lr = -1e-4; const double li = lam_im[gid];
        const double step = exp((double)log_step[l * S5G + g]);
        const double mag = exp(lr * step), ang = li * step, abr = mag * cos(ang), abi = mag * sin(ang);
        const double den = lr * lr + li * li, nre = abr - 1.0;
        const double zr = (nre * lr + abi * li) / den, zi = (abi * lr - nre * li) / den;
        AB[gid * 2] = (float)abr; AB[gid * 2 + 1] = (float)abi;
        for (int c = 0; c < 16; ++c) { const double br = b_re[(size_t)gid * 16 + c], bi = b_im[(size_t)gid * 16 + c];
            BB[((size_t)gid * 16 + c) * 2] = (float)(zr * br - zi * bi); BB[((size_t)gid * 16 + c) * 2 + 1] = (float)(zr * bi + zi * br); }
    }
}

__global__ void __launch_bounds__(256) k_ln(const float* __restrict__ pre, float scale, const bf16* __restrict__ y2, const float* __restrict__ g, const float* __restrict__ b, float* __restrict__ of, bf16* __restrict__ ob) {
    const int row = blockIdx.x * 4 + (threadIdx.x >> 6), lane = threadIdx.x & 63;
    float v[16]; float s = 0.f;
#pragma unroll
    for (int j = 0; j < 4; ++j) { const float4 x = *(const float4*)(pre + (size_t)row * Dm + j * 256 + lane * 4); v[4 * j] = x.x * scale; v[4 * j + 1] = x.y * scale; v[4 * j + 2] = x.z * scale; v[4 * j + 3] = x.w * scale; }
    if (y2) {
#pragma unroll
        for (int j = 0; j < 4; ++j)
#pragma unroll
            for (int e = 0; e < 4; ++e) { const int c = j * 256 + lane * 4 + e; v[4 * j + e] += bf2f(y2[(size_t)(2 * row) * Dm + c]) + bf2f(y2[(size_t)(2 * row + 1) * Dm + c]); }
    }
#pragma unroll
    for (int i = 0; i < 16; ++i) s += v[i];
    const float mean = wave_sum(s) * (1.f / Dm); float q = 0.f;
#pragma unroll
    for (int i = 0; i < 16; ++i) { v[i] -= mean; q += v[i] * v[i]; }
    const float rstd = rsqrtf(wave_sum(q) * (1.f / Dm) + LN_EPS);
#pragma unroll
    for (int j = 0; j < 4; ++j)
#pragma unroll
        for (int e = 0; e < 4; ++e) { const int c = j * 256 + lane * 4 + e; const float o = v[4 * j + e] * rstd * g[c] + b[c]; of[(size_t)row * Dm + c] = o; ob[(size_t)row * Dm + c] = f2bf(o); }
}

struct EpiArgs { unsigned char* ws; const float* hres; float* hout; int layer; int pad; };
enum { EPI_PROJ = 0, EPI_RET = 1, EPI_GLU = 2, EPI_S5B = 3, EPI_OUT = 4 };
template <int EPI> DEV void epi_store(const EpiArgs& e, int m, int n, float acc) {
    unsigned char* ws = e.ws;
    if (EPI == EPI_PROJ) {
        if (n < 512) ((bf16*)(ws + R_Q))[(size_t)m * 512 + n] = f2bf(acc);
        else if (n < 1024) ((bf16*)(ws + R_K))[(size_t)m * 512 + (n - 512)] = f2bf(acc * 0.125f);
        else if (n < 2048) ((bf16*)(ws + R_V))[(size_t)m * 1024 + (n - 1024)] = f2bf(acc);
        else if (n < 3072) ((bf16*)(ws + R_G))[(size_t)m * 1024 + (n - 2048)] = f2bf(siluf_(acc));
        else if (n < 3584) ((bf16*)(ws + R_U))[(size_t)m * 512 + (n - 3072)] = f2bf(acc);
        else if (n < 4608) ((bf16*)(ws + R_GR))[(size_t)m * 1024 + (n - 3584)] = f2bf(sigmoidf_(acc));
        else ((bf16*)(ws + R_GS))[(size_t)m * 1024 + (n - 4608)] = f2bf(sigmoidf_(acc));
    } else if (EPI == EPI_RET) {
        const float g = bf2f(((const bf16*)(ws + R_GR))[(size_t)m * 1024 + n]);
        ((bf16*)(ws + R_G))[(size_t)m * 1024 + n] = f2bf(g * acc);
    } else if (EPI == EPI_GLU) {
        const float z = bf2f(((const bf16*)(ws + R_U))[(size_t)m * 512 + n]);
        ((bf16*)(ws + R_S5IN))[(size_t)m * 512 + n] = f2bf(z * sigmoidf_(acc));
    } else if (EPI == EPI_S5B) {
        const float g = bf2f(((const bf16*)(ws + R_GS))[(size_t)m * 1024 + n]);
        bf16* p = ((bf16*)(ws + R_G)) + (size_t)m * 1024 + n; *p = f2bf(bf2f(*p) + g * acc);
    } else if (EPI == EPI_OUT) {
        e.hout[(size_t)m * Dm + n] = ALPHA * e.hres[(size_t)m * Dm + n] + acc;
    }
}
template <int EPI> __global__ void __launch_bounds__(256) k_gemm_naive(const bf16* __restrict__ A, const bf16* __restrict__ Bt, int M, int N, int K, EpiArgs e) {
    __shared__ float sA[32][65], sB[32][65];
    const int m0 = blockIdx.y * 64, n0 = blockIdx.x * 64, tid = threadIdx.x, tx = tid & 15, ty = tid >> 4;
    float acc[4][4];
#pragma unroll
    for (int i = 0; i < 4; ++i)
#pragma unroll
        for (int j = 0; j < 4; ++j) acc[i][j] = 0.f;
    for (int k0 = 0; k0 < K; k0 += 32) {
#pragma unroll
        for (int i = 0; i < 8; ++i) { const int idx = tid + 256 * i, r = idx >> 5, c = idx & 31;
            sA[c][r] = bf2f(A[(size_t)(m0 + r) * K + k0 + c]); sB[c][r] = bf2f(Bt[(size_t)(n0 + r) * K + k0 + c]); }
        __syncthreads();
#pragma unroll 8
        for (int k = 0; k < 32; ++k) {
            float a[4], b[4];
#pragma unroll
            for (int i = 0; i < 4; ++i) { a[i] = sA[k][ty * 4 + i]; b[i] = sB[k][tx * 4 + i]; }
#pragma unroll
            for (int i = 0; i < 4; ++i)
#pragma unroll
                for (int j = 0; j < 4; ++j) acc[i][j] += a[i] * b[j];
        }
        __syncthreads();
    }
#pragma unroll
    for (int i = 0; i < 4; ++i)
#pragma unroll
        for (int j = 0; j < 4; ++j) epi_store<EPI>(e, m0 + ty * 4 + i, n0 + tx * 4 + j, acc[i][j]);
}

DEV void load_rot(float* dst, const bf16* src  , int row0, int h, int pos0, const float* COS, const float* SIN, int tid, int nthr) {
    for (int idx = tid; idx < 64 * 32; idx += nthr) { const int i = idx >> 5, c = idx & 31;
        const float x1 = bf2f(src[(size_t)(row0 + i) * 512 + h * 64 + c]), x2 = bf2f(src[(size_t)(row0 + i) * 512 + h * 64 + 32 + c]);
        const float cs = COS[(pos0 + i) * 32 + c], sn = SIN[(pos0 + i) * 32 + c];
        dst[i * 64 + c] = x1 * cs - x2 * sn; dst[i * 64 + 32 + c] = x1 * sn + x2 * cs; }
}
__global__ void __launch_bounds__(256) k_ret_kv(unsigned char* ws) {
    extern __shared__ float sm[];
    float* kr = sm; float* vv = sm + 64 * 64;
    const int item = blockIdx.x, n = item % NCH, h = (item / NCH) % RH, b = item / (NCH * RH), tid = threadIdx.x;
    const int row0 = b * SEQ + n * CHUNK;
    const float* COS = (const float*)(ws + TAB_COS); const float* SIN = (const float*)(ws + TAB_SIN); const float* POWG = (const float*)(ws + TAB_POWG) + h * 80;
    load_rot(kr, (const bf16*)(ws + R_K), row0, h, n * CHUNK, COS, SIN, tid, 256);
    const bf16* V = (const bf16*)(ws + R_V);
    for (int idx = tid; idx < 64 * 128; idx += 256) { const int j = idx >> 7, c = idx & 127; vv[idx] = bf2f(V[(size_t)(row0 + j) * 1024 + h * 128 + c]); }
    __syncthreads();
    for (int idx = tid; idx < 64 * 64; idx += 256) { const int j = idx >> 6; kr[idx] *= POWG[63 - j]; }
    __syncthreads();
    float* KV = (float*)(ws + WS_HB) + (size_t)item * 64 * 128;
    const int dv = tid & 127, dk0 = (tid >> 7) * 32;
    for (int dk = dk0; dk < dk0 + 32; ++dk) { float s = 0.f;
        for (int j = 0; j < 64; ++j) s += kr[j * 64 + dk] * vv[j * 128 + dv];
        KV[dk * 128 + dv] = s; }
}
__global__ void __launch_bounds__(256) k_ret_scan(unsigned char* ws) {
    const int gid = blockIdx.x * 256 + threadIdx.x;
    const int e = gid & 8191, bh = gid >> 13, h = bh % RH;
    const float cd = ((const float*)(ws + TAB_POWG))[h * 80 + 64];
    float* KV = (float*)(ws + WS_HB) + (size_t)bh * NCH * 8192 + e;
    float s = 0.f;
    for (int n = 0; n < NCH; ++n) { const float kv = KV[(size_t)n * 8192]; KV[(size_t)n * 8192] = s; s = cd * s + kv; }
}
__global__ void __launch_bounds__(256) k_ret_out(unsigned char* ws) {
    extern __shared__ float sm[];
    float* qr = sm; float* kr = sm + 4096; float* vv = sm + 8192; float* S = sm + 8192 + 8192;
    const int item = blockIdx.x, n = item % NCH, h = (item / NCH) % RH, b = item / (NCH * RH), tid = threadIdx.x;
    const int row0 = b * SEQ + n * CHUNK;
    const float* COS = (const float*)(ws + TAB_COS); const float* SIN = (const float*)(ws + TAB_SIN); const float* POWG = (const float*)(ws + TAB_POWG) + h * 80;
    load_rot(qr, (const bf16*)(ws + R_Q), row0, h, n * CHUNK, COS, SIN, tid, 256);
    load_rot(kr, (const bf16*)(ws + R_K), row0, h, n * CHUNK, COS, SIN, tid, 256);
    bf16* V = (bf16*)(ws + R_V);
    for (int idx = tid; idx < 64 * 128; idx += 256) { const int j = idx >> 7, c = idx & 127; vv[idx] = bf2f(V[(size_t)(row0 + j) * 1024 + h * 128 + c]); }
    __syncthreads();
    for (int idx = tid; idx < 64 * 64; idx += 256) { const int i = idx >> 6, j = idx & 63; float s = 0.f;
        for (int d = 0; d < 64; ++d) s += qr[i * 64 + d] * kr[j * 64 + d];
        const int dd = i > j ? i - j : j - i; S[idx] = s * POWG[dd]; }
    __syncthreads();
    const float* ST = (const float*)(ws + WS_HB) + (size_t)item * 64 * 128;
    const int i = tid >> 2, c0 = (tid & 3) * 32;
    float o[32];
#pragma unroll
    for (int c = 0; c < 32; ++c) o[c] = 0.f;
    for (int j = 0; j < 64; ++j) { const float sij = S[i * 64 + j];
#pragma unroll
        for (int c = 0; c < 32; ++c) o[c] += sij * vv[j * 128 + c0 + c]; }
    const float qd = POWG[i + 1];
    for (int d = 0; d < 64; ++d) { const float qv = qr[i * 64 + d] * qd;
#pragma unroll
        for (int c = 0; c < 32; ++c) o[c] += qv * ST[d * 128 + c0 + c]; }
    float s = 0.f;
#pragma unroll
    for (int c = 0; c < 32; ++c) s += o[c];
    s += __shfl_xor(s, 1); s += __shfl_xor(s, 2);
    const float mean = s * (1.f / 128.f); float q = 0.f;
#pragma unroll
    for (int c = 0; c < 32; ++c) { o[c] -= mean; q += o[c] * o[c]; }
    q += __shfl_xor(q, 1); q += __shfl_xor(q, 2);
    const float rstd = rsqrtf(q * (1.f / 128.f) + HN_EPS);
    const bf16* G = (const bf16*)(ws + R_G);
#pragma unroll
    for (int c = 0; c < 32; ++c) { const size_t off = (size_t)(row0 + i) * 1024 + h * 128 + c0 + c; V[off] = f2bf(bf2f(G[off]) * o[c] * rstd); }
}

__global__ void __launch_bounds__(64) k_s5(unsigned char* ws, const float* __restrict__ c_re, const float* __restrict__ c_im, const float* __restrict__ dsk, int layer) {
    __shared__ float hb[64][64][2];
    __shared__ float us[64][16];
    const int g = blockIdx.x % S5G, b = blockIdx.x / S5G, n = threadIdx.x;
    const float* AB = (const float*)(ws + TAB_AB) + ((size_t)(layer * S5G + g) * S5N + n) * 2;
    const float* BB = (const float*)(ws + TAB_BB) + ((size_t)(layer * S5G + g) * S5N + n) * 32;
    const float ar = AB[0], ai = AB[1];
    float bbr[16], bbi[16];
#pragma unroll
    for (int c = 0; c < 16; ++c) { bbr[c] = BB[2 * c]; bbi[c] = BB[2 * c + 1]; }
    bf16* U = (bf16*)(ws + R_U);
    const float* CR = c_re + (size_t)(layer * S5G + g) * 16 * 64; const float* CI = c_im + (size_t)(layer * S5G + g) * 16 * 64;
    float hr = 0.f, hi = 0.f;
    for (int ch = 0; ch < NCH; ++ch) {
        const int row0 = b * SEQ + ch * 64;
        for (int idx = n; idx < 64 * 16; idx += 64) us[idx >> 4][idx & 15] = bf2f(U[(size_t)(row0 + (idx >> 4)) * 512 + g * 16 + (idx & 15)]);
        __syncthreads();
        for (int t = 0; t < 64; ++t) { float br = 0.f, bi = 0.f;
#pragma unroll
            for (int c = 0; c < 16; ++c) { br += us[t][c] * bbr[c]; bi += us[t][c] * bbi[c]; }
            const float nr = ar * hr - ai * hi + br, ni = ar * hi + ai * hr + bi; hr = nr; hi = ni;
            hb[t][n][0] = hr; hb[t][n][1] = hi; }
        __syncthreads();
        for (int idx = n; idx < 64 * 16; idx += 64) { const int t = idx >> 4, c = idx & 15; float y = 0.f;
            for (int m = 0; m < 64; ++m) y += hb[t][m][0] * CR[c * 64 + m] - hb[t][m][1] * CI[c * 64 + m];
            y += dsk[layer * 512 + g * 16 + c] * us[t][c];
            U[(size_t)(row0 + t) * 512 + g * 16 + c] = f2bf(geluf_(y)); }
        __syncthreads();
    }
}

__global__ void __launch_bounds__(256) k_ln_route(float* __restrict__ pre, const float* __restrict__ g, const float* __restrict__ b, bf16* __restrict__ ob,
                                                  const float* __restrict__ wrg, const float* __restrict__ brg, const float* __restrict__ wre, const float* __restrict__ bre, unsigned char* ws, int layer) {
    const int row = blockIdx.x * 4 + (threadIdx.x >> 6), lane = threadIdx.x & 63;
    float v[16]; float s = 0.f;
#pragma unroll
    for (int j = 0; j < 4; ++j) { const float4 x = *(const float4*)(pre + (size_t)row * Dm + j * 256 + lane * 4); v[4 * j] = x.x; v[4 * j + 1] = x.y; v[4 * j + 2] = x.z; v[4 * j + 3] = x.w; }
#pragma unroll
    for (int i = 0; i < 16; ++i) s += v[i];
    const float mean = wave_sum(s) * (1.f / Dm); float q = 0.f;
#pragma unroll
    for (int i = 0; i < 16; ++i) { v[i] -= mean; q += v[i] * v[i]; }
    const float rstd = rsqrtf(wave_sum(q) * (1.f / Dm) + LN_EPS);
#pragma unroll
    for (int j = 0; j < 4; ++j)
#pragma unroll
        for (int e = 0; e < 4; ++e) { const int c = j * 256 + lane * 4 + e; const float o = v[4 * j + e] * rstd * g[c] + b[c]; v[4 * j + e] = o; pre[(size_t)row * Dm + c] = o; ob[(size_t)row * Dm + c] = f2bf(o); }
    float lg[4];
#pragma unroll
    for (int k = 0; k < 4; ++k) { float a = 0.f;
#pragma unroll
        for (int j = 0; j < 4; ++j)
#pragma unroll
            for (int e = 0; e < 4; ++e) a += v[4 * j + e] * wrg[(size_t)(j * 256 + lane * 4 + e) * MG + k];
        lg[k] = wave_sum(a) + brg[k]; }
    int gi = 0; float gm = lg[0];
#pragma unroll
    for (int k = 1; k < 4; ++k) if (lg[k] > gm) { gm = lg[k]; gi = k; }
    float den = 0.f;
#pragma unroll
    for (int k = 0; k < 4; ++k) den += __expf(lg[k] - gm);
    const float gtop = 1.f / den;
    float le[8];
#pragma unroll
    for (int k = 0; k < 8; ++k) { float a = 0.f;
#pragma unroll
        for (int j = 0; j < 4; ++j)
#pragma unroll
            for (int e = 0; e < 4; ++e) a += v[4 * j + e] * wre[(size_t)(j * 256 + lane * 4 + e) * NE + gi * 8 + k];
        le[k] = wave_sum(a) + bre[gi * 8 + k]; }
    int i1 = 0; float m1 = le[0];
#pragma unroll
    for (int k = 1; k < 8; ++k) if (le[k] > m1) { m1 = le[k]; i1 = k; }
    int i2 = -1; float m2 = -INFINITY;
#pragma unroll
    for (int k = 0; k < 8; ++k) if (k != i1 && le[k] > m2) { m2 = le[k]; i2 = k; }
    const float p2 = __expf(m2 - m1);
    const float w1 = 1.f / (1.f + p2), w2 = p2 / (1.f + p2);
    if (lane == 0) {
        int* TE = (int*)(ws + RT_E); float* TC = (float*)(ws + RT_C); int* LIST = (int*)(ws + RT_LIST); unsigned* CNT = (unsigned*)(ws + WS_CNT) + layer * NE;
        const int e1 = gi * 8 + i1, e2 = gi * 8 + i2;
        TE[row * 2] = e1; TE[row * 2 + 1] = e2; TC[row * 2] = gtop * w1; TC[row * 2 + 1] = gtop * w2;
        const unsigned p1 = atomicAdd(&CNT[e1], 1u); LIST[(size_t)e1 * T + p1] = row * 2;
        const unsigned p2_ = atomicAdd(&CNT[e2], 1u); LIST[(size_t)e2 * T + p2_] = row * 2 + 1;
    }
}

__global__ void __launch_bounds__(256) k_moe_naive(unsigned char* ws) {
    __shared__ float xs[1024]; __shared__ float as[256];
    const int p = blockIdx.x, tok = p >> 1, tid = threadIdx.x;
    const int E = ((const int*)(ws + RT_E))[p]; const float cw = ((const float*)(ws + RT_C))[p];
    const bf16* X = (const bf16*)(ws + WS_HBF) + (size_t)tok * Dm;
    for (int i = tid; i < 1024; i += 256) xs[i] = bf2f(X[i]);
    __syncthreads();
    const bf16* WG = (const bf16*)(ws + R_WGU) + ((size_t)E * 512 + 2 * tid) * 1024; const bf16* WU = WG + 1024;
    float ga = 0.f, ua = 0.f;
    for (int k = 0; k < 1024; k += 8) { const uint4 a4 = *(const uint4*)(WG + k), b4 = *(const uint4*)(WU + k);
        const unsigned aw[4] = {a4.x, a4.y, a4.z, a4.w}, bw[4] = {b4.x, b4.y, b4.z, b4.w};
#pragma unroll
        for (int j = 0; j < 4; ++j) { ga += xs[k + 2 * j] * __uint_as_float(aw[j] << 16) + xs[k + 2 * j + 1] * __uint_as_float(aw[j] & 0xffff0000u);
                                      ua += xs[k + 2 * j] * __uint_as_float(bw[j] << 16) + xs[k + 2 * j + 1] * __uint_as_float(bw[j] & 0xffff0000u); } }
    const float a = bf2f(f2bf(siluf_(ga) * ua));
    as[tid] = a; ((bf16*)(ws + R_ACT))[(size_t)p * 256 + tid] = f2bf(a);
    __syncthreads();
    bf16* Y = (bf16*)(ws + R_Y) + (size_t)p * Dm;
    for (int d = tid; d < 1024; d += 256) { const bf16* WD = (const bf16*)(ws + R_WDN) + ((size_t)E * 1024 + d) * 256; float s = 0.f;
        for (int f = 0; f < 256; ++f) s += as[f] * bf2f(WD[f]);
        Y[d] = f2bf(cw * s); }
}

extern "C" void kernel_launch(void* const* d_in, const int* in_sizes, int n_in, void* d_out, int out_size, void* d_ws, size_t ws_size, hipStream_t stream) {
    static int ok = 0;
    if (ok == 0) {
        if (n_in != 27 || in_sizes[0] != T * Dm || out_size != T * Dm || ws_size < WS_END) { fprintf(stderr, "kernel_launch: unexpected shapes/ws (%d, %d, %d, %zu < %zu)\n", n_in, n_in > 0 ? in_sizes[0] : -1, out_size, ws_size, (size_t)WS_END); ok = -1; return; }
        (void)hipFuncSetAttribute((const void*)k_ret_out, hipFuncAttributeMaxDynamicSharedMemorySize, 80 * 1024);
        (void)hipFuncSetAttribute((const void*)k_ret_kv, hipFuncAttributeMaxDynamicSharedMemorySize, 48 * 1024);
        ok = 1;
    }
    if (ok < 0) return;
    unsigned char* ws = (unsigned char*)d_ws;
    const float* const* in = (const float* const*)d_in;
    float* hA = (float*)d_out; float* hB = (float*)(ws + WS_HB); bf16* hbf = (bf16*)(ws + WS_HBF);
    (void)hipMemsetAsync(ws + WS_CTL, 0, 1 * MiB, stream);
    k_convT<<<dim3(INW / 32, Dm / 32, DEPTH), 256, 0, stream>>>(in[3], (bf16*)(ws + W_IN), Dm, INW, 1, 0, INW);
    k_convT<<<dim3(S5W / 32, S5W / 32, DEPTH), 256, 0, stream>>>(in[12], (bf16*)(ws + W_GLU), S5W, S5W, 1, 0, S5W);
    k_convT<<<dim3(Dm / 32, RV / 32, DEPTH), 256, 0, stream>>>(in[13], (bf16*)(ws + W_BRET), RV, Dm, 1, 0, Dm);
    k_convT<<<dim3(Dm / 32, S5W / 32, DEPTH), 256, 0, stream>>>(in[14], (bf16*)(ws + W_BS5), S5W, Dm, 1, 0, Dm);
    k_convT<<<dim3(Dm / 32, Dm / 32, DEPTH), 256, 0, stream>>>(in[15], (bf16*)(ws + W_OUT), Dm, Dm, 1, 0, Dm);
    k_tables<<<256, 256, 0, stream>>>(in[4], in[5], in[6], in[7], in[8], ws);
    k_ln<<<T / 4, 256, 0, stream>>>(in[0], 1.f, nullptr, in[1], in[2], hA, hbf);
    for (int l = 0; l < DEPTH; ++l) {
        EpiArgs e{}; e.ws = ws; e.hres = hA; e.hout = hB; e.layer = l;
        k_gemm_naive<EPI_PROJ><<<dim3(INW / 64, T / 64), 256, 0, stream>>>(hbf, (const bf16*)(ws + W_IN) + (size_t)l * INW * Dm, T, INW, Dm, e);
        k_ret_kv<<<BATCH * RH * NCH, 256, 48 * 1024, stream>>>(ws);
        k_ret_scan<<<BATCH * RH * 8192 / 256, 256, 0, stream>>>(ws);
        k_ret_out<<<BATCH * RH * NCH, 256, 80 * 1024, stream>>>(ws);
        k_s5<<<BATCH * S5G, 64, 0, stream>>>(ws, in[9], in[10], in[11], l);
        k_gemm_naive<EPI_RET><<<dim3(Dm / 64, T / 64), 256, 0, stream>>>((const bf16*)(ws + R_V), (const bf16*)(ws + W_BRET) + (size_t)l * Dm * RV, T, Dm, RV, e);
        k_gemm_naive<EPI_GLU><<<dim3(S5W / 64, T / 64), 256, 0, stream>>>((const bf16*)(ws + R_U), (const bf16*)(ws + W_GLU) + (size_t)l * S5W * S5W, T, S5W, S5W, e);
        k_gemm_naive<EPI_S5B><<<dim3(Dm / 64, T / 64), 256, 0, stream>>>((const bf16*)(ws + R_S5IN), (const bf16*)(ws + W_BS5) + (size_t)l * Dm * S5W, T, Dm, S5W, e);
        k_gemm_naive<EPI_OUT><<<dim3(Dm / 64, T / 64), 256, 0, stream>>>((const bf16*)(ws + R_G), (const bf16*)(ws + W_OUT) + (size_t)l * Dm * Dm, T, Dm, Dm, e);
        k_convT<<<dim3(FF / 32, Dm / 32, NE), 256, 0, stream>>>(in[22] + (size_t)l * NE * Dm * FF, (bf16*)(ws + R_WGU), Dm, FF, 2, 0, 512);
        k_convT<<<dim3(FF / 32, Dm / 32, NE), 256, 0, stream>>>(in[23] + (size_t)l * NE * Dm * FF, (bf16*)(ws + R_WGU), Dm, FF, 2, 1, 512);
        k_convT<<<dim3(Dm / 32, FF / 32, NE), 256, 0, stream>>>(in[24] + (size_t)l * NE * FF * Dm, (bf16*)(ws + R_WDN), FF, Dm, 1, 0, Dm);
        k_ln_route<<<T / 4, 256, 0, stream>>>(hB, in[16] + l * Dm, in[17] + l * Dm, hbf, in[18] + (size_t)l * Dm * MG, in[19] + l * MG, in[20] + (size_t)l * Dm * NE, in[21] + l * NE, ws, l);
        k_moe_naive<<<2 * T, 256, 0, stream>>>(ws);
        k_ln<<<T / 4, 256, 0, stream>>>(hB, ALPHA, (const bf16*)(ws + R_Y), in[25] + l * Dm, in[26] + l * Dm, hA, hbf);
    }
}
```

```cpp
#include <hip/hip_runtime.h>
#include <cstdio>
#include <cstdint>
#include <cmath>

typedef unsigned short bf16;
#define DEV __device__ __forceinline__

constexpr int Dm = 1024, BATCH = 8, SEQ = 2048, T = BATCH * SEQ, DEPTH = 2;
constexpr int CHUNK = 64, NCH = SEQ / CHUNK;
constexpr int RH = 8, RQK = 512, RV = 1024, DK = 64, DV = 128;
constexpr int S5W = 512, S5G = 32, S5GC = 16, S5N = 64;
constexpr int MG = 4, EPG = 8, NE = 32, FF = 256;
constexpr int INW = 5632;
constexpr float LN_EPS = 1e-5f, HN_EPS = 1e-6f;
constexpr float ALPHA = 1.41421356237309515f;

constexpr size_t MiB = 1u << 20;
constexpr size_t WS_CTL = 0;
constexpr size_t WS_CNT = 64 * 1024;
constexpr size_t WS_TAB = 1 * MiB;
constexpr size_t TAB_COS = WS_TAB;
constexpr size_t TAB_SIN = TAB_COS + 2048 * 32 * 4;
constexpr size_t TAB_POWG = TAB_SIN + 2048 * 32 * 4;
constexpr size_t TAB_AB = TAB_POWG + 8 * 80 * 4;
constexpr size_t TAB_BB = TAB_AB + DEPTH * S5G * S5N * 2 * 4;
constexpr size_t TAB_CT = TAB_BB + (size_t)DEPTH * S5G * S5N * 16 * 2 * 4;
constexpr size_t TAB_WRT = TAB_CT + (size_t)DEPTH * S5G * S5N * 16 * 2 * 4;
constexpr size_t TAB_END = TAB_WRT + (size_t)DEPTH * 36 * Dm * 4;
static_assert(TAB_END <= 3 * MiB, "tables");
constexpr size_t WS_S5E = 3 * MiB;
constexpr size_t WS_ROUTE = 7 * MiB;
constexpr size_t RT_E = WS_ROUTE, RT_C = RT_E + (size_t)T * 2 * 4, RT_LIST = RT_C + (size_t)T * 2 * 4;
static_assert(RT_LIST + (size_t)NE * T * 4 <= 10 * MiB, "route");
constexpr size_t WS_WSM = 10 * MiB;
constexpr size_t W_IN = WS_WSM;
constexpr size_t W_GLU = W_IN + (size_t)DEPTH * INW * Dm * 2;
constexpr size_t W_BRET = W_GLU + (size_t)DEPTH * S5W * S5W * 2;
constexpr size_t W_BS5 = W_BRET + (size_t)DEPTH * Dm * RV * 2;
constexpr size_t W_OUT = W_BS5 + (size_t)DEPTH * Dm * S5W * 2;
constexpr size_t W_END = W_OUT + (size_t)DEPTH * Dm * Dm * 2;
static_assert(W_END <= 44 * MiB, "small weights");
constexpr size_t WS_HB = 44 * MiB;
constexpr size_t WS_HBF = 108 * MiB;
constexpr size_t WS_R1 = 140 * MiB;
constexpr size_t R_Q = WS_R1, R_K = R_Q + 16 * MiB, R_U = R_K + 16 * MiB, R_GR = R_U + 16 * MiB, R_GS = R_GR + 32 * MiB;
constexpr size_t WS_R2 = 252 * MiB;
constexpr size_t R_V = WS_R2, R_G = R_V + 32 * MiB;
constexpr size_t WS_END = 316 * MiB;
constexpr size_t R_S5IN = R_Q;
constexpr size_t R_WGU = WS_R1;
constexpr size_t R_WDN = WS_R1 + 32 * MiB;
constexpr size_t R_ACT = WS_R1 + 48 * MiB;
constexpr size_t R_Y = WS_R2;

DEV float bf2f(bf16 v) { return __uint_as_float((unsigned)v << 16); }
DEV bf16 f2bf(float f) { unsigned u = __float_as_uint(f); return (bf16)((u + 0x7fffu + ((u >> 16) & 1u)) >> 16); }
DEV float sigmoidf_(float x) { return 1.f / (1.f + __expf(-x)); }
DEV float siluf_(float x) { return x * sigmoidf_(x); }
DEV float geluf_(float x) { const float c = 0.7978845608028654f; float t = tanhf(c * (x + 0.044715f * x * x * x)); return 0.5f * x * (1.f + t); }
DEV float wave_sum(float v) {
#pragma unroll
    for (int o = 1; o < 64; o <<= 1) v += __shfl_xor(v, o);
    return v;
}

namespace pg8 {
#define PG8_LAS __attribute__((address_space(3)))
typedef unsigned short bf16_t;
typedef short bf16x8 __attribute__((ext_vector_type(8)));
typedef float f32x4 __attribute__((ext_vector_type(4)));
typedef unsigned u32x4 __attribute__((ext_vector_type(4)));
typedef unsigned u32x2 __attribute__((ext_vector_type(2)));
typedef float f32x2 __attribute__((ext_vector_type(2)));
constexpr int BM = 256, BK = 64, HALF = 128, HTB = HALF * BK * 2  , STAGE_BYTES = 8 * HTB, NXCD = 8, WGM = 8;

__host__ __device__ __forceinline__ int lds_byte(int r, int c) { const int st = (r >> 4) * 2 + (c >> 5), rr = r & 15, cc = c & 31, ob = rr * 64 + cc * 2; return st * 1024 + (ob ^ (((ob >> 9) & 1) << 5)); }
__host__ __device__ __forceinline__ void stage_rc(int b, int& R, int& C) { const int st = b / 1024, sb = b % 1024, swz = sb ^ (((sb >> 9) & 1) << 5); R = (st >> 1) * 16 + swz / 64; C = (st & 1) * 32 + (swz % 64) / 2; }
__host__ __device__ __forceinline__ int perm32(int rho) { const int n = rho >> 4, i = rho & 15; return 8 * (i >> 2) + 4 * n + (i & 3); }

struct Unit { int pm, pn, pnb, e, cnt; };
struct Gemm { const bf16_t* A; const bf16_t* Bt; int K; };

struct StaticOrder {
    int nM, nN, nwg, G, c, K;
    __device__ void init(int M, int N, int K_, int G_, int c_) { nM = M / BM; nN = N / BM; nwg = nM * nN; G = G_; c = c_; K = K_; }
    __device__ bool next(int i, Unit& u) const {
        const long L = (long)i * G + c; if (L >= nwg) return false;
        int wgid = (int)L; { const int q = nwg / NXCD, r = nwg % NXCD, xcd = wgid % NXCD, off = wgid / NXCD; wgid = (xcd < r ? xcd * (q + 1) : r * (q + 1) + (xcd - r) * q) + off; }
        const int nig = WGM * nN, gid = wgid / nig, fm = gid * WGM, gsz = (nM - fm) < WGM ? (nM - fm) : WGM;
        u.pm = fm + ((wgid % nig) % gsz); u.pn = (wgid % nig) / gsz; u.pnb = u.pn; u.e = 0; u.cnt = 0; return true;
    }
    static constexpr bool GATHER = false;
    __device__ __forceinline__ const unsigned* list_ptr(const Unit&, int) const { return nullptr; }
    __device__ __forceinline__ unsigned row_of(unsigned e) const { return e; }
};

__device__ __forceinline__ unsigned cvt_pk_bf16(float lo, float hi) { unsigned r; asm volatile("v_cvt_pk_bf16_f32 %0, %1, %2" : "=v"(r) : "v"(lo), "v"(hi)); return r; }

__device__ __forceinline__ int fresh_tid(int wbase) { int t = wbase + (int)__builtin_amdgcn_mbcnt_hi(~0u, __builtin_amdgcn_mbcnt_lo(~0u, 0u)); asm volatile("" : "+v"(t)); return t; }
template <int K, class Epi, class Sched, bool ALIGN_EPI = false>
__device__ __forceinline__ void gemm_phase(const int wbase, PG8_LAS unsigned char* lds, PG8_LAS unsigned char* park, const Gemm g, const Sched& S, const Epi& E) {
    constexpr bool GA = Sched::GATHER;
    const int wid = wbase >> 6, wr = wid >> 2, wc = wid & 3;
    const int tid = fresh_tid(wbase);
    constexpr int nt = K / BK; static_assert(K % 128 == 0 && K >= 256, "K");
    unsigned voffA[2], voffB[2];
#pragma unroll
    for (int i = 0; i < 2; ++i) { int R, C; stage_rc(tid * 16 + i * 8192, R, C); const int Rb = Epi::PERM ? ((R & ~31) + perm32(R & 31)) : R;
        voffA[i] = (unsigned)(R * K + C) * 2u; voffB[i] = (unsigned)(Rb * K + C) * 2u; }
#define PG8_RC(i, R, C) int R, C; stage_rc(fresh_tid(wbase) * 16 + (i) * 8192, R, C)
    const int kstep = BK * 2;
    const int hstep = HALF * K * 2;
    const int tstep = 2 * hstep;
    const __amdgpu_buffer_rsrc_t rsA = __builtin_amdgcn_make_buffer_rsrc((void*)g.A, 0, 0x7fffffff, 0x00020000);
    const __amdgpu_buffer_rsrc_t rsB = __builtin_amdgcn_make_buffer_rsrc((void*)g.Bt, 0, 0x7fffffff, 0x00020000);
    const unsigned ldsw = (unsigned)wid * 1024u;
    const int aoff = lds_byte(wr * 64 + (tid & 15), ((tid & 63) >> 4) * 8), boff = lds_byte(wc * 32 + (tid & 15), ((tid & 63) >> 4) * 8);
#define PG8_SA(b, h) (((b) * 2 + (h)) * HTB)
#define PG8_SB(b, h) ((4 + (b) * 2 + (h)) * HTB)
#define PG8_STAGE(bufoff, rs, voff, so) do { _Pragma("unroll") for (int _i = 0; _i < 2; ++_i) \
        __builtin_amdgcn_raw_ptr_buffer_load_lds(rs, (PG8_LAS void*)(lds + (bufoff) + ldsw + _i * 8192), 16, (int)(voff)[_i], (int)(so), 0, 0); } while (0)
#define PG8_STAGE_B(bufoff, so) PG8_STAGE(bufoff, rsB, voffB, so)
#define PG8_STAGE_A(bufoff, h, kb) do { if constexpr (GA) { if ((h) == 0) PG8_STAGE(bufoff, rsA, ao0, kb); else PG8_STAGE(bufoff, rsA, ao1, kb); } else { PG8_STAGE(bufoff, rsA, voffA, (kb) + (h) * hstep); } } while (0)
#define PG8_LDA(dst, b, h) do { _Pragma("unroll") for (int m = 0; m < 4; ++m) _Pragma("unroll") for (int k = 0; k < 2; ++k) dst[m][k] = *(const PG8_LAS bf16x8*)(lds + PG8_SA(b, h) + aoff + m * 2048 + k * 1024); } while (0)
#define PG8_LDB(dst, b, h) do { _Pragma("unroll") for (int n = 0; n < 2; ++n) _Pragma("unroll") for (int k = 0; k < 2; ++k) dst[n][k] = *(const PG8_LAS bf16x8*)(lds + PG8_SB(b, h) + boff + n * 2048 + k * 1024); } while (0)
#define PG8_MMA(ai, bj, At, Bt) do { __builtin_amdgcn_s_setprio(1); _Pragma("unroll") for (int m = 0; m < 4; ++m) _Pragma("unroll") for (int n = 0; n < 2; ++n) _Pragma("unroll") for (int k = 0; k < 2; ++k) \
        acc[ai][bj][m][n] = __builtin_amdgcn_mfma_f32_16x16x32_bf16(Bt[n][k], At[m][k], acc[ai][bj][m][n], 0, 0, 0); __builtin_amdgcn_s_setprio(0); } while (0)
#define PG8_WAIT_V(n) asm volatile("s_waitcnt vmcnt(" #n ")" ::: "memory")
#define PG8_WAIT_L(n) asm volatile("s_waitcnt lgkmcnt(" #n ")" ::: "memory")
#define PG8_BAR __builtin_amdgcn_s_barrier()
#define PG8_SCHED __builtin_amdgcn_sched_barrier(0)
    Unit cur, nxt; int ui = 0;
    if (!S.next(0, cur)) return;
    f32x4 acc[2][2][4][2];
#pragma unroll
    for (int a = 0; a < 2; ++a)
#pragma unroll
        for (int b = 0; b < 2; ++b)
#pragma unroll
            for (int m = 0; m < 4; ++m)
#pragma unroll
                for (int n = 0; n < 2; ++n) acc[a][b][m][n] = (f32x4){0.f, 0.f, 0.f, 0.f};
    bf16x8 At[4][2], B0[2][2], B1[2][2];
    unsigned ao0[2] = {0u, 0u}, ao1[2] = {0u, 0u};
    if constexpr (GA) {
#pragma unroll
        for (int i = 0; i < 2; ++i) { PG8_RC(i, R, C); ao0[i] = (S.row_of(*S.list_ptr(cur, R)) * (unsigned)K + (unsigned)C) * 2u; ao1[i] = (S.row_of(*S.list_ptr(cur, HALF + R)) * (unsigned)K + (unsigned)C) * 2u; }
    }
    int cA = GA ? 0 : cur.pm * tstep;
    int cB = cur.pnb * tstep;
    PG8_STAGE_B(PG8_SB(0, 0), cB); PG8_STAGE_B(PG8_SB(0, 1), cB + hstep); PG8_STAGE_A(PG8_SA(0, 0), 0, cA); PG8_STAGE_A(PG8_SA(0, 1), 1, cA);
    if (wr == 1) PG8_BAR;
    PG8_WAIT_V(2); PG8_BAR;
    PG8_STAGE_B(PG8_SB(1, 0), cB + kstep); PG8_STAGE_A(PG8_SA(1, 0), 0, cA + kstep); PG8_STAGE_B(PG8_SB(1, 1), cB + hstep + kstep);
    PG8_WAIT_V(6); PG8_BAR;
    for (;;) {
        const bool has_next = S.next(ui + 1, nxt);
        const int nA = (GA || !has_next) ? cA : nxt.pm * tstep; const int nB = has_next ? nxt.pnb * tstep : cB;
        if constexpr (GA) { if (has_next) {
#pragma unroll
            for (int s = 0; s < 4; ++s) { PG8_RC(s & 1, R, C); (void)C; __builtin_amdgcn_global_load_lds(S.list_ptr(nxt, (s >> 1) * HALF + R), (PG8_LAS unsigned*)(park + s * 2048 + wid * 256), 4, 0, 0); } } }
#define PG8_TRIP(LASTT) do { \
            const int a1 = cA + (t + 1) * kstep; \
            PG8_LDB(B0, 0, 0); PG8_LDB(B1, 0, 1); PG8_SCHED; PG8_LDA(At, 0, 0); PG8_STAGE_A(PG8_SA(1, 1), 1, a1); \
            if constexpr (GA && (LASTT)) { if (has_next) { _Pragma("unroll") for (int i = 0; i < 2; ++i) { PG8_RC(i, R, C); (void)R; const int t4 = fresh_tid(wbase) * 4; \
                ao0[i] = (S.row_of(*(const PG8_LAS unsigned*)(park + (0 + i) * 2048 + t4)) * (unsigned)K + (unsigned)C) * 2u; \
                ao1[i] = (S.row_of(*(const PG8_LAS unsigned*)(park + (2 + i) * 2048 + t4)) * (unsigned)K + (unsigned)C) * 2u; } } } \
            const int a2 = (LASTT) ? nA : cA + (t + 2) * kstep; const int b2 = (LASTT) ? nB : cB + (t + 2) * kstep; \
            const int a3 = a2 + kstep; const int b3 = b2 + kstep; \
            PG8_WAIT_V(8); PG8_WAIT_L(0); PG8_BAR; PG8_MMA(0, 0, At, B0); PG8_MMA(0, 1, At, B1); PG8_BAR; PG8_SCHED; \
            PG8_LDA(At, 0, 1); PG8_STAGE_B(PG8_SB(0, 0), b2); PG8_STAGE_B(PG8_SB(0, 1), b2 + hstep); PG8_STAGE_A(PG8_SA(0, 0), 0, a2); \
            PG8_WAIT_V(8); PG8_WAIT_L(0); PG8_BAR; PG8_MMA(1, 0, At, B0); PG8_MMA(1, 1, At, B1); PG8_BAR; PG8_SCHED; \
            PG8_LDB(B0, 1, 0); PG8_LDB(B1, 1, 1); PG8_SCHED; PG8_LDA(At, 1, 0); PG8_STAGE_A(PG8_SA(0, 1), 1, a2); \
            PG8_WAIT_V(8); PG8_WAIT_L(0); PG8_BAR; PG8_MMA(0, 0, At, B0); PG8_MMA(0, 1, At, B1); PG8_BAR; PG8_SCHED; \
            PG8_LDA(At, 1, 1); PG8_STAGE_B(PG8_SB(1, 0), b3); PG8_STAGE_B(PG8_SB(1, 1), b3 + hstep); PG8_STAGE_A(PG8_SA(1, 0), 0, a3); \
            PG8_WAIT_V(8); PG8_WAIT_L(0); PG8_BAR; PG8_MMA(1, 0, At, B0); PG8_MMA(1, 1, At, B1); PG8_BAR; PG8_SCHED; \
        } while (0)
        int t = 0; int ntm = nt - 2; asm volatile("" : "+s"(ntm));
        for (; t < ntm; t += 2) PG8_TRIP(false);
        PG8_TRIP(true);
#undef PG8_TRIP
        if constexpr (ALIGN_EPI) { if (wr == 0) PG8_BAR; }
        { const int te = fresh_tid(wbase); E(acc, cur, wr, wc, te & 15, (te & 63) >> 4); }
        if (!has_next) break;
#pragma unroll
        for (int a = 0; a < 2; ++a)
#pragma unroll
            for (int b = 0; b < 2; ++b)
#pragma unroll
                for (int m = 0; m < 4; ++m)
#pragma unroll
                    for (int n = 0; n < 2; ++n) acc[a][b][m][n] = (f32x4){0.f, 0.f, 0.f, 0.f};
        cur = nxt; cA = nA; cB = nB; ++ui;
        if constexpr (ALIGN_EPI) { if (wr == 1) PG8_BAR; }
    }
    PG8_WAIT_V(0);
    if constexpr (!ALIGN_EPI) { if (wr == 0) PG8_BAR; }
    PG8_BAR;
#undef PG8_SA
#undef PG8_SB
#undef PG8_STAGE
#undef PG8_STAGE_A
#undef PG8_STAGE_B
#undef PG8_RC
#undef PG8_LDA
#undef PG8_LDB
#undef PG8_MMA
#undef PG8_WAIT_V
#undef PG8_WAIT_L
#undef PG8_BAR
#undef PG8_SCHED
}
}
namespace epi {
using pg8::f32x4; using pg8::u32x4; using pg8::u32x2; using pg8::Unit; using pg8::cvt_pk_bf16;
DEV float fsig(float x) { return __builtin_amdgcn_rcpf(1.f + __expf(-x)); }
DEV u32x4 pack8(const f32x4 a, const f32x4 b) { u32x4 w; w.x = cvt_pk_bf16(a[0], a[1]); w.y = cvt_pk_bf16(a[2], a[3]); w.z = cvt_pk_bf16(b[0], b[1]); w.w = cvt_pk_bf16(b[2], b[3]); return w; }
DEV void unpack8(const u32x4 w, f32x4& a, f32x4& b) {
    a[0] = __uint_as_float(w.x << 16); a[1] = __uint_as_float(w.x & 0xffff0000u); a[2] = __uint_as_float(w.y << 16); a[3] = __uint_as_float(w.y & 0xffff0000u);
    b[0] = __uint_as_float(w.z << 16); b[1] = __uint_as_float(w.z & 0xffff0000u); b[2] = __uint_as_float(w.w << 16); b[3] = __uint_as_float(w.w & 0xffff0000u); }
#define EPI_FOR8(...) _Pragma("unroll") for (int ai = 0; ai < 2; ++ai) _Pragma("unroll") for (int m = 0; m < 4; ++m) _Pragma("unroll") for (int bj = 0; bj < 2; ++bj) { \
        const int row = u.pm * 256 + ai * 128 + wr * 64 + m * 16 + fr; const int ct = bj * 128 + wc * 32 + 8 * fq; f32x4 v0 = acc[ai][bj][m][0], v1 = acc[ai][bj][m][1]; __VA_ARGS__ }

struct EpiProj {
    static constexpr bool PERM = true;
    unsigned char* ws;
    DEV void operator()(const f32x4 (&acc)[2][2][4][2], const Unit& u, int wr, int wc, int fr, int fq) const {
        const int pn = u.pn; bf16* base; int ld, c0, act; float sc = 1.f;
        if (pn < 2) { base = (bf16*)(ws + R_Q); ld = 512; c0 = pn * 256; act = 0; }
        else if (pn < 4) { base = (bf16*)(ws + R_K); ld = 512; c0 = (pn - 2) * 256; act = 0; sc = 0.125f; }
        else if (pn < 8) { base = (bf16*)(ws + R_V); ld = 1024; c0 = (pn - 4) * 256; act = 0; }
        else if (pn < 12) { base = (bf16*)(ws + R_G); ld = 1024; c0 = (pn - 8) * 256; act = 1; }
        else if (pn < 14) { base = (bf16*)(ws + R_U); ld = 512; c0 = (pn - 12) * 256; act = 0; }
        else if (pn < 18) { base = (bf16*)(ws + R_GR); ld = 1024; c0 = (pn - 14) * 256; act = 2; }
        else { base = (bf16*)(ws + R_GS); ld = 1024; c0 = (pn - 18) * 256; act = 2; }
        EPI_FOR8(
            if (act == 1) { _Pragma("unroll") for (int j = 0; j < 4; ++j) { v0[j] = v0[j] * fsig(v0[j]); v1[j] = v1[j] * fsig(v1[j]); } }
            else if (act == 2) { _Pragma("unroll") for (int j = 0; j < 4; ++j) { v0[j] = fsig(v0[j]); v1[j] = fsig(v1[j]); } }
            else { v0 = v0 * sc; v1 = v1 * sc; }
            *(u32x4*)(base + (size_t)row * ld + c0 + ct) = pack8(v0, v1); )
    }
};
struct EpiRet {
    static constexpr bool PERM = true;
    unsigned char* ws;
    DEV void operator()(const f32x4 (&acc)[2][2][4][2], const Unit& u, int wr, int wc, int fr, int fq) const {
        const bf16* GR = (const bf16*)(ws + R_GR); bf16* O = (bf16*)(ws + R_G);
        EPI_FOR8( const size_t off = (size_t)row * 1024 + u.pn * 256 + ct; f32x4 g0, g1; unpack8(*(const u32x4*)(GR + off), g0, g1);
            *(u32x4*)(O + off) = pack8(v0 * g0, v1 * g1); )
    }
};
struct EpiGlu {
    static constexpr bool PERM = true;
    unsigned char* ws;
    DEV void operator()(const f32x4 (&acc)[2][2][4][2], const Unit& u, int wr, int wc, int fr, int fq) const {
        const bf16* Z = (const bf16*)(ws + R_U); bf16* O = (bf16*)(ws + R_S5IN);
        EPI_FOR8( const size_t off = (size_t)row * 512 + u.pn * 256 + ct; f32x4 z0, z1; unpack8(*(const u32x4*)(Z + off), z0, z1);
            _Pragma("unroll") for (int j = 0; j < 4; ++j) { v0[j] = z0[j] * fsig(v0[j]); v1[j] = z1[j] * fsig(v1[j]); }
            *(u32x4*)(O + off) = pack8(v0, v1); )
    }
};
struct EpiS5b {
    static constexpr bool PERM = true;
    unsigned char* ws;
    DEV void operator()(const f32x4 (&acc)[2][2][4][2], const Unit& u, int wr, int wc, int fr, int fq) const {
        const bf16* GS = (const bf16*)(ws + R_GS); bf16* O = (bf16*)(ws + R_G);
        EPI_FOR8( const size_t off = (size_t)row * 1024 + u.pn * 256 + ct; f32x4 g0, g1, p0, p1; unpack8(*(const u32x4*)(GS + off), g0, g1); unpack8(*(const u32x4*)(O + off), p0, p1);
            *(u32x4*)(O + off) = pack8(p0 + v0 * g0, p1 + v1 * g1); )
    }
};
struct EpiOut {
    static constexpr bool PERM = false;
    const float* hres; float* out;
    DEV void operator()(const f32x4 (&acc)[2][2][4][2], const Unit& u, int wr, int wc, int fr, int fq) const {
#pragma unroll
        for (int ai = 0; ai < 2; ++ai)
#pragma unroll
            for (int m = 0; m < 4; ++m) { const size_t ro = (size_t)(u.pm * 256 + ai * 128 + wr * 64 + m * 16 + fr) * Dm + u.pn * 256 + wc * 32 + 4 * fq;
#pragma unroll
                for (int bj = 0; bj < 2; ++bj)
#pragma unroll
                    for (int n = 0; n < 2; ++n) { const size_t off = ro + bj * 128 + n * 16; const f32x4 hv = *(const f32x4*)(hres + off); *(f32x4*)(out + off) = hv * ALPHA + acc[ai][bj][m][n]; } }
    }
};
}
namespace pg8 {
struct GroupedOrder {
    static constexpr bool GATHER = true;
    const PG8_LAS unsigned* tp; const unsigned* list; int NT, G, c, shift;
    __device__ bool next(int i, Unit& u) const {
        const unsigned total = (unsigned)__builtin_amdgcn_readfirstlane((int)tp[32]) * (unsigned)NT; const unsigned L = (unsigned)i * (unsigned)G + (unsigned)c;
        if (L >= total) return false;
        const unsigned mt = L / (unsigned)NT; int e = 0;
#pragma unroll
        for (int j = 1; j < 32; ++j) e += (mt >= tp[j]) ? 1 : 0;
        e = __builtin_amdgcn_readfirstlane(e);
        u.e = e; u.pm = (int)mt - __builtin_amdgcn_readfirstlane((int)tp[e]); u.pn = (int)(L % (unsigned)NT); u.pnb = e * NT + u.pn; u.cnt = __builtin_amdgcn_readfirstlane((int)tp[33 + e]); return true;
    }
    __device__ __forceinline__ const unsigned* list_ptr(const Unit& u, int r) const { int rr = u.pm * BM + r; rr = rr < u.cnt ? rr : u.cnt - 1; return list + (size_t)u.e * T + rr; }
    __device__ __forceinline__ unsigned row_of(unsigned e) const { return e >> shift; }
};
}
namespace epi {
struct EpiMoeGU {
    static constexpr bool PERM = true;
    unsigned char* ws; const unsigned* list;
    DEV void operator()(const f32x4 (&acc)[2][2][4][2], const Unit& u, int wr, int wc, int fr, int fq) const {
        bf16* ACT = (bf16*)(ws + R_ACT);
#pragma unroll
        for (int ai = 0; ai < 2; ++ai)
#pragma unroll
            for (int m = 0; m < 4; ++m) { const int r = u.pm * 256 + ai * 128 + wr * 64 + m * 16 + fr;
                if (r < u.cnt) { const unsigned p = list[(size_t)u.e * T + r];
#pragma unroll
                    for (int bj = 0; bj < 2; ++bj) { const int f0 = u.pn * 128 + bj * 64 + wc * 16 + 4 * fq; const f32x4 v0 = acc[ai][bj][m][0], v1 = acc[ai][bj][m][1];
                        const float a0 = v0[0] * fsig(v0[0]) * v0[1], a1 = v0[2] * fsig(v0[2]) * v0[3], a2 = v1[0] * fsig(v1[0]) * v1[1], a3 = v1[2] * fsig(v1[2]) * v1[3];
                        u32x2 w; w.x = cvt_pk_bf16(a0, a1); w.y = cvt_pk_bf16(a2, a3); *(u32x2*)(ACT + (size_t)p * 256 + f0) = w; } } }
    }
};
struct EpiMoeDN {
    static constexpr bool PERM = true;
    unsigned char* ws; const unsigned* list;
    DEV void operator()(const f32x4 (&acc)[2][2][4][2], const Unit& u, int wr, int wc, int fr, int fq) const {
        bf16* Y = (bf16*)(ws + R_Y); const float* TC = (const float*)(ws + RT_C);
#pragma unroll
        for (int ai = 0; ai < 2; ++ai)
#pragma unroll
            for (int m = 0; m < 4; ++m) { const int r = u.pm * 256 + ai * 128 + wr * 64 + m * 16 + fr;
                if (r < u.cnt) { const unsigned p = list[(size_t)u.e * T + r]; const float cw = TC[p];
#pragma unroll
                    for (int bj = 0; bj < 2; ++bj) { const int d0 = u.pn * 256 + bj * 128 + wc * 32 + 8 * fq;
                        *(u32x4*)(Y + (size_t)p * Dm + d0) = pack8(acc[ai][bj][m][0] * cw, acc[ai][bj][m][1] * cw); } } }
    }
};
}
#define GAS __attribute__((address_space(1)))
#define LAS __attribute__((address_space(3)))
constexpr int NWAVES = 8;
constexpr int RING_OFF = 0, RING_BYTES = 131072;
constexpr int LDSCTL_OFF = RING_BYTES, MISC_OFF = LDSCTL_OFF + 320, PARK_OFF = RING_BYTES + 1024;
constexpr int LDS_BYTES = 147456;
constexpr int CW_TMO = 0, CW_CODE = 1, CW_BAR = 4096;

#define XB_TMO      128
#define XB_XCNT(j)  (256  + 64 * (j))
#define XB_XSUB(j)  (1280 + 64 * (j))
#define XB_XGEN(j)  (2304 + 64 * (j))
#define XB_TOP      3328
#define XB_TOPGEN   3392
#define XCD_BAR_WORDS 3456
#define XB_SPIN_CAP (1u << 18)
__device__ __forceinline__ unsigned xb_ld(unsigned* p)              { return __hip_atomic_load(p, __ATOMIC_RELAXED, __HIP_MEMORY_SCOPE_AGENT); }
__device__ __forceinline__ unsigned xb_add(unsigned* p, unsigned v) { return __hip_atomic_fetch_add(p, v, __ATOMIC_RELAXED, __HIP_MEMORY_SCOPE_AGENT); }
__device__ __forceinline__ unsigned xb_xcc_id() { return (unsigned)__builtin_amdgcn_s_getreg((3 << 11) | 20) & 0xFu; }
#define XB_SPIN(cond, bar) do { unsigned _sp = 0; while (cond) { __builtin_amdgcn_s_sleep(1); \
    if ((++_sp & 255u) == 0u) { if (xb_ld(&(bar)[XB_TMO])) break; if (_sp > XB_SPIN_CAP) { atomicAdd(&(bar)[XB_TMO], 1u); break; } } } } while (0)
struct XcdBarrier { unsigned* bar; unsigned x; volatile LAS unsigned* st; };
__device__ __forceinline__ XcdBarrier xcd_barrier_post(unsigned* bar, volatile LAS unsigned* st, bool t0) {
    XcdBarrier b; b.bar = bar; b.x = xb_xcc_id(); b.st = st;
    if (t0) (void)xb_add(&bar[XB_XCNT(b.x)], 1u);
    return b;
}
__device__ __forceinline__ void xcd_barrier_complete(unsigned* bar, unsigned x, unsigned& nloc, unsigned& nx) {
    const unsigned G = gridDim.x * gridDim.y * gridDim.z;
    unsigned sum, cnt, mine, sp = 0u;
    for (;;) {
        sum = 0u; cnt = 0u; mine = 0u;
#pragma unroll
        for (unsigned j = 0; j < 16; ++j) { const unsigned c = xb_ld(&bar[XB_XCNT(j)]); sum += c; cnt += (c > 0u) ? 1u : 0u; mine = (j == x) ? c : mine; }
        if (sum == G) break;
        __builtin_amdgcn_s_sleep(1);
        if ((++sp & 255u) == 0u) { if (xb_ld(&bar[XB_TMO])) break; if (sp > XB_SPIN_CAP) { atomicAdd(&bar[XB_TMO], 1u); break; } }
    }
    nloc = mine > 0u ? mine : 1u; nx = cnt > 0u ? cnt : 1u;
}
__device__ __forceinline__ void xcd_barrier(const XcdBarrier& b, bool t0) {
    asm volatile("s_waitcnt vmcnt(0)" ::: "memory");
    __syncthreads();
    if (t0) {
        unsigned* bar = b.bar;
        __builtin_amdgcn_s_waitcnt(0);
        unsigned nloc = b.st[0], nx = b.st[1];
        if (nloc == 0u) { xcd_barrier_complete(bar, b.x, nloc, nx); b.st[0] = nloc; b.st[1] = nx; }
        const unsigned old = xb_add(&bar[XB_XSUB(b.x)], 1u);
        const unsigned gen = old / nloc;
        if (old + 1u == (gen + 1u) * nloc) {
            __builtin_amdgcn_fence(__ATOMIC_RELEASE, "agent");
            asm volatile("s_waitcnt vmcnt(0)" ::: "memory");
            const unsigned og = xb_add(&bar[XB_TOP], 1u);
            const unsigned tg = og / nx;
            if (og + 1u == (tg + 1u) * nx) xb_add(&bar[XB_TOPGEN], 1u);
            else XB_SPIN(xb_ld(&bar[XB_TOPGEN]) == tg, bar);
            __builtin_amdgcn_fence(__ATOMIC_ACQUIRE, "agent");
            xb_add(&bar[XB_XGEN(b.x)], 1u);
            asm volatile("s_waitcnt vmcnt(0)" ::: "memory");
        } else {
            XB_SPIN(xb_ld(&bar[XB_XGEN(b.x)]) == gen, bar);
            __builtin_amdgcn_fence(__ATOMIC_ACQUIRE, "agent");
            asm volatile("s_waitcnt vmcnt(0)" ::: "memory");
        }
    }
    __syncthreads();
}

struct Args { const float* in[27]; float* out; unsigned char* ws; int ph_lo, ph_hi, bar_id, pad; };
constexpr int NPL = 11, NPH = 1 + DEPTH * NPL;
enum { K_PROJ = 0, K_KV = 1, K_SCAN = 2, K_RETOUT = 3, K_BRANCH = 4, K_S5B = 5, K_OUT = 6, K_LNROUTE = 7, K_MOEGU = 8, K_MOEDN = 9, K_LN2 = 10 };
namespace ph {
#define LDSW() asm volatile("s_waitcnt lgkmcnt(0)" ::: "memory")
DEV int lane_id(int wbase) { return pg8::fresh_tid(wbase) & 63; }
DEV unsigned pk2(float lo, float hi) { return (unsigned)f2bf(lo) | ((unsigned)f2bf(hi) << 16); }
DEV void transpose_item(const float* __restrict__ W, int K, int N, bf16* __restrict__ WT, int rmul, int radd, LAS float* scr, int item, int lane) {
    const int nblk = N / 32, kb = item / nblk, nb = item % nblk, k0 = 64 * kb, n0 = 32 * nb;
#pragma unroll 8
    for (int i = 0; i < 32; ++i) { const int kk = 2 * i + (lane >> 5); scr[kk * 33 + (lane & 31)] = W[(size_t)(k0 + kk) * N + n0 + (lane & 31)]; }
    LDSW(); asm volatile("" ::: "memory");
    const int c = lane & 7;
#pragma unroll
    for (int j = 0; j < 4; ++j) { const int n = (lane >> 3) + 8 * j; const LAS float* s = scr + (8 * c) * 33 + n;
        uint4 o; o.x = pk2(s[0 * 33], s[1 * 33]); o.y = pk2(s[2 * 33], s[3 * 33]); o.z = pk2(s[4 * 33], s[5 * 33]); o.w = pk2(s[6 * 33], s[7 * 33]);
        *(uint4*)(WT + (size_t)((n0 + n) * rmul + radd) * K + k0 + 8 * c) = o; }
    LDSW(); asm volatile("" ::: "memory");
}
DEV void ln_row(const float* pre, float scale, const bf16* y2, const float* __restrict__ g, const float* __restrict__ b, float* of, bf16* ob, int lane, float (&v)[16]) {
    float s = 0.f;
#pragma unroll
    for (int j = 0; j < 4; ++j) { const float4 x = *(const float4*)(pre + j * 256 + lane * 4); v[4 * j] = x.x * scale; v[4 * j + 1] = x.y * scale; v[4 * j + 2] = x.z * scale; v[4 * j + 3] = x.w * scale; }
    if (y2) {
#pragma unroll
        for (int j = 0; j < 4; ++j) { const uint2 a = *(const uint2*)(y2 + j * 256 + lane * 4), c = *(const uint2*)(y2 + Dm + j * 256 + lane * 4);
            v[4 * j] += __uint_as_float(a.x << 16) + __uint_as_float(c.x << 16); v[4 * j + 1] += __uint_as_float(a.x & 0xffff0000u) + __uint_as_float(c.x & 0xffff0000u);
            v[4 * j + 2] += __uint_as_float(a.y << 16) + __uint_as_float(c.y << 16); v[4 * j + 3] += __uint_as_float(a.y & 0xffff0000u) + __uint_as_float(c.y & 0xffff0000u); }
    }
#pragma unroll
    for (int i = 0; i < 16; ++i) s += v[i];
    const float mean = wave_sum(s) * (1.f / Dm); float q = 0.f;
#pragma unroll
    for (int i = 0; i < 16; ++i) { v[i] -= mean; q += v[i] * v[i]; }
    const float rstd = rsqrtf(wave_sum(q) * (1.f / Dm) + LN_EPS);
#pragma unroll
    for (int j = 0; j < 4; ++j) { const float4 gg = *(const float4*)(g + j * 256 + lane * 4), bb = *(const float4*)(b + j * 256 + lane * 4);
        float4 o; o.x = v[4 * j] * rstd * gg.x + bb.x; o.y = v[4 * j + 1] * rstd * gg.y + bb.y; o.z = v[4 * j + 2] * rstd * gg.z + bb.z; o.w = v[4 * j + 3] * rstd * gg.w + bb.w;
        v[4 * j] = o.x; v[4 * j + 1] = o.y; v[4 * j + 2] = o.z; v[4 * j + 3] = o.w;
        *(float4*)(of + j * 256 + lane * 4) = o; uint2 w; w.x = pk2(o.x, o.y); w.y = pk2(o.z, o.w); *(uint2*)(ob + j * 256 + lane * 4) = w; }
}

struct ProIn { const float *x, *lng, *lnb, *w_in, *lam_re, *lam_im, *log_step, *b_re, *b_im, *c_re, *c_im, *w_glu, *w_bret, *w_bs5, *w_out, *w_rg, *w_re; float* out; };
DEV void prologue(const int wbase, LAS unsigned char* lds, unsigned char* ws, const ProIn P, int G, int vcu) {
    const int wave = wbase >> 6, lane = lane_id(wbase), tid = wbase + lane;
    LAS float* scr = (LAS float*)(lds + wave * 16384);
    const int gw = vcu * NWAVES + wave, NGW = G * NWAVES;
    constexpr int I_IN = (Dm / 64) * (INW / 32), I_GLU = (S5W / 64) * (S5W / 32), I_BRET = (RV / 64) * (Dm / 32), I_BS5 = (S5W / 64) * (Dm / 32), I_OUT = (Dm / 64) * (Dm / 32);
    constexpr int I_L = I_IN + I_GLU + I_BRET + I_BS5 + I_OUT;
    for (int it = gw; it < DEPTH * I_L; it += NGW) {
        const int l = it / I_L; int r = it % I_L;
        if (r < I_IN) { transpose_item(P.w_in + (size_t)l * Dm * INW, Dm, INW, (bf16*)(ws + W_IN) + (size_t)l * INW * Dm, 1, 0, scr, r, lane); continue; } r -= I_IN;
        if (r < I_GLU) { transpose_item(P.w_glu + (size_t)l * S5W * S5W, S5W, S5W, (bf16*)(ws + W_GLU) + (size_t)l * S5W * S5W, 1, 0, scr, r, lane); continue; } r -= I_GLU;
        if (r < I_BRET) { transpose_item(P.w_bret + (size_t)l * RV * Dm, RV, Dm, (bf16*)(ws + W_BRET) + (size_t)l * Dm * RV, 1, 0, scr, r, lane); continue; } r -= I_BRET;
        if (r < I_BS5) { transpose_item(P.w_bs5 + (size_t)l * S5W * Dm, S5W, Dm, (bf16*)(ws + W_BS5) + (size_t)l * Dm * S5W, 1, 0, scr, r, lane); continue; } r -= I_BS5;
        transpose_item(P.w_out + (size_t)l * Dm * Dm, Dm, Dm, (bf16*)(ws + W_OUT) + (size_t)l * Dm * Dm, 1, 0, scr, r, lane);
    }
    const int gt = vcu * (NWAVES * 64) + tid, NGT = G * NWAVES * 64;
    float* COS = (float*)(ws + TAB_COS); float* SIN = (float*)(ws + TAB_SIN); float* POWG = (float*)(ws + TAB_POWG);
    float* AB = (float*)(ws + TAB_AB); float* BB = (float*)(ws + TAB_BB); float* CT = (float*)(ws + TAB_CT); float* WRT = (float*)(ws + TAB_WRT);
    for (int gid = gt; gid < 2048 * 32; gid += NGT) { const int pos = gid >> 5, i = gid & 31; const float inv = exp2f(-(float)i * (13.287712379549449f / 32.0f)); const float ang = (float)pos * inv;
        COS[gid] = cosf(ang); SIN[gid] = sinf(ang); }
    for (int gid = gt; gid < 8 * 80; gid += NGT) { const int h = gid / 80, n = gid % 80; const float lg = log1pf(-exp2f(-5.0f - (float)h)); POWG[gid] = expf(lg * (float)n); }
    for (int gid = gt; gid < DEPTH * S5G * S5N; gid += NGT) {
        const int g = (gid / S5N) % S5G, l = gid / (S5G * S5N);
        float lr = P.lam_re[gid]; if (lr > -1e-4f) lr = -1e-4f; const float li = P.lam_im[gid];
        const float step = expf(P.log_step[l * S5G + g]);
        const float em1 = expm1f(lr * step), mag = em1 + 1.f, ang = li * step, cs = cosf(ang), sn = sinf(ang), sh = sinf(0.5f * ang);
        const float abr = mag * cs, abi = mag * sn;
        const float nre = em1 * cs - 2.f * sh * sh;
        const float den = lr * lr + li * li;
        const float zr = (nre * lr + abi * li) / den, zi = (abi * lr - nre * li) / den;
        AB[gid * 2] = abr; AB[gid * 2 + 1] = abi;
        for (int c = 0; c < 16; ++c) { const float br = P.b_re[(size_t)gid * 16 + c], bi = P.b_im[(size_t)gid * 16 + c];
            BB[((size_t)gid * 16 + c) * 2] = zr * br - zi * bi; BB[((size_t)gid * 16 + c) * 2 + 1] = zr * bi + zi * br; }
    }
    for (int gid = gt; gid < DEPTH * S5G * S5N * 16; gid += NGT) { const int c = gid & 15, m = (gid >> 4) & 63, lg = gid >> 10;
        CT[(size_t)gid * 2] = P.c_re[(size_t)(lg * 16 + c) * 64 + m]; CT[(size_t)gid * 2 + 1] = -P.c_im[(size_t)(lg * 16 + c) * 64 + m]; }
    for (int gid = gt; gid < DEPTH * 36 * Dm; gid += NGT) { const int kk = gid % Dm, j = (gid / Dm) % 36, l = gid / (36 * Dm);
        WRT[gid] = j < 4 ? P.w_rg[((size_t)l * Dm + kk) * MG + j] : P.w_re[((size_t)l * Dm + kk) * NE + (j - 4)]; }
    float v[16];
    for (int m = gw; m < T; m += NGW) ln_row(P.x + (size_t)m * Dm, 1.f, nullptr, P.lng, P.lnb, P.out + (size_t)m * Dm, (bf16*)(ws + WS_HBF) + (size_t)m * Dm, lane, v);
}

DEV void load_rot(LAS float* dst, const bf16* __restrict__ src  , int row0, int h, int pos0, const float* __restrict__ COS, const float* __restrict__ SIN, int tid) {
    for (int idx = tid; idx < 64 * 32; idx += NWAVES * 64) { const int i = idx >> 5, c = idx & 31;
        const float x1 = bf2f(src[(size_t)(row0 + i) * 512 + h * 64 + c]), x2 = bf2f(src[(size_t)(row0 + i) * 512 + h * 64 + 32 + c]);
        const float cs = COS[(pos0 + i) * 32 + c], sn = SIN[(pos0 + i) * 32 + c];
        dst[i * 64 + c] = x1 * cs - x2 * sn; dst[i * 64 + 32 + c] = x1 * sn + x2 * cs; }
}
DEV void s5_load_u(LAS float* us, const bf16* __restrict__ U, int row0, int g, int lane) {
#pragma unroll
    for (int i = 0; i < 16; ++i) { const int idx = lane + 64 * i; us[idx] = bf2f(U[(size_t)(row0 + (idx >> 4)) * 512 + g * 16 + (idx & 15)]); }
    LDSW(); asm volatile("" ::: "memory");
}
DEV void phase_kv(const int wbase, LAS unsigned char* lds, unsigned char* ws, int layer, int G, int vcu) {
    const int wave = wbase >> 6, lane = lane_id(wbase), tid = wbase + lane;
    const float* COS = (const float*)(ws + TAB_COS); const float* SIN = (const float*)(ws + TAB_SIN);
    LAS float* kr = (LAS float*)lds; LAS float* vv = kr + 64 * 64;
    for (int item = vcu; item < BATCH * RH * NCH; item += G) {
        const int n = item % NCH, h = (item / NCH) % RH, b = item / (NCH * RH), row0 = b * SEQ + n * CHUNK;
        const float* POWG = (const float*)(ws + TAB_POWG) + h * 80;
        load_rot(kr, (const bf16*)(ws + R_K), row0, h, n * CHUNK, COS, SIN, tid);
        const bf16* V = (const bf16*)(ws + R_V);
        for (int idx = tid; idx < 64 * 128; idx += NWAVES * 64) { const int j = idx >> 7, c = idx & 127; vv[idx] = bf2f(V[(size_t)(row0 + j) * 1024 + h * 128 + c]); }
        __syncthreads();
        for (int idx = tid; idx < 64 * 64; idx += NWAVES * 64) { const int j = idx >> 6; kr[idx] *= POWG[63 - j]; }
        __syncthreads();
        float* KV = (float*)(ws + WS_HB) + (size_t)item * 64 * 128;
        const int dv = tid & 127, dk0 = (tid >> 7) * 16;
#pragma unroll 4
        for (int dk = dk0; dk < dk0 + 16; ++dk) { float s = 0.f;
            for (int j = 0; j < 64; ++j) s += kr[j * 64 + dk] * vv[j * 128 + dv];
            KV[dk * 128 + dv] = s; }
        __syncthreads();
    }
    LAS float* us = (LAS float*)(lds + 65536 + wave * 4096);
    const int gw = vcu * NWAVES + wave, NGW = G * NWAVES;
    for (int item = gw; item < BATCH * NCH * S5G; item += NGW) {
        const int g = item % S5G, ch = (item / S5G) % NCH, b = item / (S5G * NCH), row0 = b * SEQ + ch * 64;
        const float* AB = (const float*)(ws + TAB_AB) + ((size_t)(layer * S5G + g) * S5N + lane) * 2;
        const float* BB = (const float*)(ws + TAB_BB) + ((size_t)(layer * S5G + g) * S5N + lane) * 32;
        const float ar = AB[0], ai = AB[1];
        float bbr[16], bbi[16];
#pragma unroll
        for (int c = 0; c < 16; ++c) { bbr[c] = BB[2 * c]; bbi[c] = BB[2 * c + 1]; }
        s5_load_u(us, (const bf16*)(ws + R_U), row0, g, lane);
        float hr = 0.f, hi = 0.f;
        for (int t = 0; t < 64; ++t) { float br = 0.f, bi = 0.f;
#pragma unroll
            for (int c = 0; c < 16; ++c) { const float uv = us[t * 16 + c]; br += uv * bbr[c]; bi += uv * bbi[c]; }
            const float nr = ar * hr - ai * hi + br, ni = ar * hi + ai * hr + bi; hr = nr; hi = ni; }
        float2* E = (float2*)(ws + WS_S5E) + (size_t)item * S5N + lane;
        *E = make_float2(hr, hi);
        LDSW(); asm volatile("" ::: "memory");
    }
}
DEV void phase_scan(const int wbase, unsigned char* ws, int G, int vcu) {
    const int tid = wbase + lane_id(wbase);
    for (int gid = vcu * (NWAVES * 64) + tid; gid < BATCH * RH * 8192; gid += G * NWAVES * 64) {
        const int e = gid & 8191, bh = gid >> 13, h = bh % RH;
        const float cd = ((const float*)(ws + TAB_POWG))[h * 80 + 64];
        float* KV = (float*)(ws + WS_HB) + (size_t)bh * NCH * 8192 + e;
        float s = 0.f;
        for (int n = 0; n < NCH; ++n) { const float kv = KV[(size_t)n * 8192]; KV[(size_t)n * 8192] = s; s = cd * s + kv; }
    }
}
DEV void phase_retout(const int wbase, LAS unsigned char* lds, unsigned char* ws, const float* __restrict__ dsk, int layer, int G, int vcu) {
    const int wave = wbase >> 6, lane = lane_id(wbase), tid = wbase + lane;
    const float* COS = (const float*)(ws + TAB_COS); const float* SIN = (const float*)(ws + TAB_SIN);
    LAS float* qr = (LAS float*)lds; LAS float* kr = qr + 4096; LAS float* vv = kr + 4096; LAS float* S = vv + 8192;
    for (int item = vcu; item < BATCH * RH * NCH; item += G) {
        const int n = item % NCH, h = (item / NCH) % RH, b = item / (NCH * RH), row0 = b * SEQ + n * CHUNK;
        const float* POWG = (const float*)(ws + TAB_POWG) + h * 80;
        load_rot(qr, (const bf16*)(ws + R_Q), row0, h, n * CHUNK, COS, SIN, tid);
        load_rot(kr, (const bf16*)(ws + R_K), row0, h, n * CHUNK, COS, SIN, tid);
        bf16* V = (bf16*)(ws + R_V);
        for (int idx = tid; idx < 64 * 128; idx += NWAVES * 64) { const int j = idx >> 7, c = idx & 127; vv[idx] = bf2f(V[(size_t)(row0 + j) * 1024 + h * 128 + c]); }
        __syncthreads();
        for (int idx = tid; idx < 64 * 64; idx += NWAVES * 64) { const int i = idx >> 6, j = idx & 63; float s = 0.f;
            for (int d = 0; d < 64; ++d) s += qr[i * 64 + d] * kr[j * 64 + d];
            const int dd = i > j ? i - j : j - i; S[idx] = s * POWG[dd]; }
        __syncthreads();
        const float* ST = (const float*)(ws + WS_HB) + (size_t)item * 64 * 128;
        const int i = tid >> 3, c0 = (tid & 7) * 16;
        float o[16];
#pragma unroll
        for (int c = 0; c < 16; ++c) o[c] = 0.f;
        for (int j = 0; j < 64; ++j) { const float sij = S[i * 64 + j];
#pragma unroll
            for (int c = 0; c < 16; ++c) o[c] += sij * vv[j * 128 + c0 + c]; }
        const float qd = POWG[i + 1];
        for (int d = 0; d < 64; ++d) { const float qv = qr[i * 64 + d] * qd;
#pragma unroll
            for (int c = 0; c < 16; ++c) o[c] += qv * ST[d * 128 + c0 + c]; }
        float s = 0.f;
#pragma unroll
        for (int c = 0; c < 16; ++c) s += o[c];
        s += __shfl_xor(s, 1); s += __shfl_xor(s, 2); s += __shfl_xor(s, 4);
        const float mean = s * (1.f / 128.f); float q = 0.f;
#pragma unroll
        for (int c = 0; c < 16; ++c) { o[c] -= mean; q += o[c] * o[c]; }
        q += __shfl_xor(q, 1); q += __shfl_xor(q, 2); q += __shfl_xor(q, 4);
        const float rstd = rsqrtf(q * (1.f / 128.f) + HN_EPS);
        const bf16* Gt = (const bf16*)(ws + R_G);
#pragma unroll
        for (int c = 0; c < 16; ++c) { const size_t off = (size_t)(row0 + i) * 1024 + h * 128 + c0 + c; V[off] = f2bf(bf2f(Gt[off]) * o[c] * rstd); }
        __syncthreads();
    }
    LAS float* us = (LAS float*)(lds + wave * 12288); LAS float* hb = us + 1024;
    const int gw = vcu * NWAVES + wave, NGW = G * NWAVES;
    for (int item = gw; item < BATCH * NCH * S5G; item += NGW) {
        const int g = item % S5G, ch = (item / S5G) % NCH, b = item / (S5G * NCH), row0 = b * SEQ + ch * 64;
        const float* AB = (const float*)(ws + TAB_AB) + ((size_t)(layer * S5G + g) * S5N + lane) * 2;
        const float* BB = (const float*)(ws + TAB_BB) + ((size_t)(layer * S5G + g) * S5N + lane) * 32;
        const float2* CT = (const float2*)(ws + TAB_CT) + (size_t)(layer * S5G + g) * S5N * 16;
        const float ar = AB[0], ai = AB[1];
        float pr = ar, pi = ai;
#pragma unroll
        for (int k = 0; k < 6; ++k) { const float nr = pr * pr - pi * pi, ni = 2.f * pr * pi; pr = nr; pi = ni; }
        float hr = 0.f, hi = 0.f;
        const float2* E = (const float2*)(ws + WS_S5E) + ((size_t)(b * NCH) * S5G + g) * S5N + lane;
        for (int c = 0; c < ch; ++c) { const float2 e = E[(size_t)c * S5G * S5N]; const float nr = pr * hr - pi * hi + e.x, ni = pr * hi + pi * hr + e.y; hr = nr; hi = ni; }
        float bbr[16], bbi[16];
#pragma unroll
        for (int c = 0; c < 16; ++c) { bbr[c] = BB[2 * c]; bbi[c] = BB[2 * c + 1]; }
        bf16* U = (bf16*)(ws + R_U);
        s5_load_u(us, U, row0, g, lane);
        const int yc = lane & 15, yt = lane >> 4;
        const float dv = dsk[layer * 512 + g * 16 + yc];
        for (int sub = 0; sub < 4; ++sub) {
            for (int t = 0; t < 16; ++t) { float br = 0.f, bi = 0.f;
#pragma unroll
                for (int c = 0; c < 16; ++c) { const float uv = us[(sub * 16 + t) * 16 + c]; br += uv * bbr[c]; bi += uv * bbi[c]; }
                const float nr = ar * hr - ai * hi + br, ni = ar * hi + ai * hr + bi; hr = nr; hi = ni;
                *(LAS pg8::f32x2*)(hb + (t * 64 + lane) * 2) = (pg8::f32x2){hr, hi}; }
            LDSW(); asm volatile("" ::: "memory");
            float y[4] = {0.f, 0.f, 0.f, 0.f};
            for (int m = 0; m < 64; ++m) { const float2 cc = CT[m * 16 + yc];
#pragma unroll
                for (int j = 0; j < 4; ++j) { const pg8::f32x2 hv = *(const LAS pg8::f32x2*)(hb + ((yt * 4 + j) * 64 + m) * 2); y[j] += hv.x * cc.x + hv.y * cc.y; } }
#pragma unroll
            for (int j = 0; j < 4; ++j) { const int t = sub * 16 + yt * 4 + j; const float yy = y[j] + dv * us[t * 16 + yc];
                U[(size_t)(row0 + t) * 512 + g * 16 + yc] = f2bf(geluf_(yy)); }
            LDSW(); asm volatile("" ::: "memory");
        }
    }
}
struct RouteIn { const float *lng, *lnb, *brg, *bre, *wg, *wu, *wd; };
DEV void phase_lnroute(const int wbase, LAS unsigned char* lds, unsigned char* ws, const RouteIn P, int layer, int G, int vcu) {
    const int wave = wbase >> 6, lane = lane_id(wbase);
    const int gw = vcu * NWAVES + wave, NGW = G * NWAVES;
    float* pre = (float*)(ws + WS_HB); bf16* ob = (bf16*)(ws + WS_HBF);
    const float* WRT = (const float*)(ws + TAB_WRT) + (size_t)layer * 36 * Dm;
    const float* brg = P.brg; const float* bre = P.bre;
    int* TE = (int*)(ws + RT_E); float* TC = (float*)(ws + RT_C); int* LIST = (int*)(ws + RT_LIST); unsigned* CNT = (unsigned*)(ws + WS_CNT) + layer * NE;
    for (int row = gw; row < T; row += NGW) {
        float v[16];
        ln_row(pre + (size_t)row * Dm, 1.f, nullptr, P.lng, P.lnb, pre + (size_t)row * Dm, ob + (size_t)row * Dm, lane, v);
        float lg[4];
#pragma unroll
        for (int k = 0; k < 4; ++k) { float a = 0.f;
#pragma unroll
            for (int j = 0; j < 4; ++j) { const float4 w = *(const float4*)(WRT + k * Dm + j * 256 + lane * 4); a += v[4 * j] * w.x + v[4 * j + 1] * w.y + v[4 * j + 2] * w.z + v[4 * j + 3] * w.w; }
            lg[k] = wave_sum(a) + brg[k]; }
        int gi = 0; float gm = lg[0];
#pragma unroll
        for (int k = 1; k < 4; ++k) if (lg[k] > gm) { gm = lg[k]; gi = k; }
        float den = 0.f;
#pragma unroll
        for (int k = 0; k < 4; ++k) den += __expf(lg[k] - gm);
        const float gtop = 1.f / den;
        gi = __builtin_amdgcn_readfirstlane(gi);
        float le[8];
#pragma unroll
        for (int k = 0; k < 8; ++k) { float a = 0.f; const float* wr = WRT + (size_t)(4 + gi * 8 + k) * Dm;
#pragma unroll
            for (int j = 0; j < 4; ++j) { const float4 w = *(const float4*)(wr + j * 256 + lane * 4); a += v[4 * j] * w.x + v[4 * j + 1] * w.y + v[4 * j + 2] * w.z + v[4 * j + 3] * w.w; }
            le[k] = wave_sum(a) + bre[gi * 8 + k]; }
        int i1 = 0; float m1 = le[0];
#pragma unroll
        for (int k = 1; k < 8; ++k) if (le[k] > m1) { m1 = le[k]; i1 = k; }
        int i2 = 0; float m2 = -INFINITY;
#pragma unroll
        for (int k = 0; k < 8; ++k) if (k != i1 && le[k] > m2) { m2 = le[k]; i2 = k; }
        const float p2 = __expf(m2 - m1);
        const float w1 = 1.f / (1.f + p2), w2 = p2 / (1.f + p2);
        if (lane == 0) {
            const int e1 = gi * 8 + i1, e2 = gi * 8 + i2;
            TE[row * 2] = e1; TE[row * 2 + 1] = e2; TC[row * 2] = gtop * w1; TC[row * 2 + 1] = gtop * w2;
            const unsigned q1 = atomicAdd(&CNT[e1], 1u); LIST[(size_t)e1 * T + q1] = row * 2;
            const unsigned q2 = atomicAdd(&CNT[e2], 1u); LIST[(size_t)e2 * T + q2] = row * 2 + 1;
        }
    }
    LAS float* scr = (LAS float*)(lds + wave * 16384);
    constexpr int I_G = (Dm / 64) * (FF / 32), I_D = (FF / 64) * (Dm / 32);
    for (int it = gw; it < NE * (2 * I_G + I_D); it += NGW) {
        const int e = it / (2 * I_G + I_D); int r = it % (2 * I_G + I_D);
        if (r < I_G) { transpose_item(P.wg + (size_t)e * Dm * FF, Dm, FF, (bf16*)(ws + R_WGU) + (size_t)e * 512 * Dm, 2, 0, scr, r, lane); continue; } r -= I_G;
        if (r < I_G) { transpose_item(P.wu + (size_t)e * Dm * FF, Dm, FF, (bf16*)(ws + R_WGU) + (size_t)e * 512 * Dm, 2, 1, scr, r, lane); continue; } r -= I_G;
        transpose_item(P.wd + (size_t)e * FF * Dm, FF, Dm, (bf16*)(ws + R_WDN) + (size_t)e * Dm * FF, 1, 0, scr, r, lane);
    }
}
DEV void phase_ln2(const int wbase, unsigned char* ws, const float* lng, const float* lnb, float* out, int G, int vcu) {
    const int wave = wbase >> 6, lane = lane_id(wbase);
    const int gw = vcu * NWAVES + wave, NGW = G * NWAVES;
    float v[16];
    for (int row = gw; row < T; row += NGW)
        ln_row((const float*)(ws + WS_HB) + (size_t)row * Dm, ALPHA, (const bf16*)(ws + R_Y) + (size_t)(2 * row) * Dm, lng, lnb, out + (size_t)row * Dm, (bf16*)(ws + WS_HBF) + (size_t)row * Dm, lane, v);
}
}

__global__ void __launch_bounds__(NWAVES * 64, 2) mk_fwd(Args args_k) {
    extern __shared__ __attribute__((aligned(16))) unsigned char lds_raw[];
    LAS unsigned char* lds = (LAS unsigned char*)lds_raw;
    volatile LAS unsigned* MISC = (volatile LAS unsigned*)(lds + MISC_OFF);
    const int wbase = __builtin_amdgcn_readfirstlane((int)threadIdx.x) & ~63;
    const int G = gridDim.x, bx = blockIdx.x, vcu = (G % 8 == 0) ? (bx % 8) * (G / 8) + bx / 8 : bx;
    unsigned* ctl = (unsigned*)(args_k.ws + WS_CTL);
    { const int tid = pg8::fresh_tid(wbase); for (int u = tid; u < (LDS_BYTES - LDSCTL_OFF) / 4; u += NWAVES * 64) ((LAS unsigned*)(lds + LDSCTL_OFF))[u] = 0u; }
    __syncthreads();
    if ((args_k.ph_hi - args_k.ph_lo) > 1) (void)xcd_barrier_post(ctl + CW_BAR + args_k.bar_id * XCD_BAR_WORDS, MISC + 8, pg8::fresh_tid(wbase) == 0);
    const int ph_lo = args_k.ph_lo, ph_hi = args_k.ph_hi;
    for (int ph = ph_lo; ph < ph_hi; ++ph) {
        const int l = ph > 0 ? (ph - 1) / NPL : 0, k = ph > 0 ? (ph - 1) % NPL : -1;
        const __attribute__((address_space(4))) Args* ap = (const __attribute__((address_space(4))) Args*)__builtin_amdgcn_kernarg_segment_ptr(); asm volatile("" : "+s"(ap));
        const Args& args = *(const Args*)ap;
        unsigned char* ws = ap->ws;
        float* hA = ap->out; float* hB = (float*)(ws + WS_HB); bf16* hbf = (bf16*)(ws + WS_HBF);
        switch (k) {
        case -1: { ph::ProIn P{args.in[0], args.in[1], args.in[2], args.in[3], args.in[4], args.in[5], args.in[6], args.in[7], args.in[8], args.in[9], args.in[10], args.in[12], args.in[13], args.in[14], args.in[15], args.in[18], args.in[20], args.out};
            ph::prologue(wbase, lds, ws, P, G, vcu); } break;
        case K_PROJ: {
            pg8::Gemm g{hbf, (const bf16*)(ws + W_IN) + (size_t)l * INW * Dm, Dm}; pg8::StaticOrder S; S.init(T, INW, Dm, G, bx);
            epi::EpiProj E{ws}; pg8::gemm_phase<Dm, epi::EpiProj, pg8::StaticOrder, true>(wbase, lds + RING_OFF, lds + PARK_OFF, g, S, E); } break;
        case K_KV: ph::phase_kv(wbase, lds, ws, l, G, vcu); break;
        case K_SCAN: ph::phase_scan(wbase, ws, G, vcu); break;
        case K_RETOUT: ph::phase_retout(wbase, lds, ws, args.in[11], l, G, vcu); break;
        case K_BRANCH: {
            { pg8::Gemm g{(const bf16*)(ws + R_V), (const bf16*)(ws + W_BRET) + (size_t)l * Dm * RV, RV}; pg8::StaticOrder S; S.init(T, Dm, RV, G, bx);
              epi::EpiRet E{ws}; pg8::gemm_phase<RV, epi::EpiRet, pg8::StaticOrder, true>(wbase, lds + RING_OFF, lds + PARK_OFF, g, S, E); }
            { pg8::Gemm g{(const bf16*)(ws + R_U), (const bf16*)(ws + W_GLU) + (size_t)l * S5W * S5W, S5W}; pg8::StaticOrder S; S.init(T, S5W, S5W, G, bx);
              epi::EpiGlu E{ws}; pg8::gemm_phase<S5W, epi::EpiGlu, pg8::StaticOrder, true>(wbase, lds + RING_OFF, lds + PARK_OFF, g, S, E); } } break;
        case K_S5B: {
            pg8::Gemm g{(const bf16*)(ws + R_S5IN), (const bf16*)(ws + W_BS5) + (size_t)l * Dm * S5W, S5W}; pg8::StaticOrder S; S.init(T, Dm, S5W, G, bx);
            epi::EpiS5b E{ws}; pg8::gemm_phase<S5W, epi::EpiS5b, pg8::StaticOrder, true>(wbase, lds + RING_OFF, lds + PARK_OFF, g, S, E); } break;
        case K_OUT: {
            pg8::Gemm g{(const bf16*)(ws + R_G), (const bf16*)(ws + W_OUT) + (size_t)l * Dm * Dm, Dm}; pg8::StaticOrder S; S.init(T, Dm, Dm, G, bx);
            epi::EpiOut E{hA, hB}; pg8::gemm_phase<Dm, epi::EpiOut, pg8::StaticOrder, true>(wbase, lds + RING_OFF, lds + PARK_OFF, g, S, E); } break;
        case K_LNROUTE: { ph::RouteIn P{args.in[16] + l * Dm, args.in[17] + l * Dm, args.in[19] + l * MG, args.in[21] + l * NE, args.in[22] + (size_t)l * NE * Dm * FF, args.in[23] + (size_t)l * NE * Dm * FF, args.in[24] + (size_t)l * NE * FF * Dm};
            ph::phase_lnroute(wbase, lds, ws, P, l, G, vcu); } break;
        case K_MOEGU: case K_MOEDN: {
            LAS unsigned* tp = (LAS unsigned*)(lds + LDSCTL_OFF + 512);
            const int tid = pg8::fresh_tid(wbase);
            if (tid < 32) tp[33 + tid] = __hip_atomic_load((unsigned*)(ws + WS_CNT) + l * NE + tid, __ATOMIC_RELAXED, __HIP_MEMORY_SCOPE_AGENT);
            __syncthreads();
            if (tid == 0) { unsigned a = 0; for (int j = 0; j < 32; ++j) { tp[j] = a; a += (tp[33 + j] + 255u) >> 8; } tp[32] = a; }
            __syncthreads();
            const unsigned* LIST = (const unsigned*)(ws + RT_LIST);
            if (k == K_MOEGU) {
                pg8::Gemm g{hbf, (const bf16*)(ws + R_WGU), Dm}; pg8::GroupedOrder S{tp, LIST, 2, G, bx, 1};
                epi::EpiMoeGU E{ws, LIST}; pg8::gemm_phase<Dm, epi::EpiMoeGU, pg8::GroupedOrder, true>(wbase, lds + RING_OFF, lds + PARK_OFF, g, S, E);
            } else {
                pg8::Gemm g{(const bf16*)(ws + R_ACT), (const bf16*)(ws + R_WDN), FF}; pg8::GroupedOrder S{tp, LIST, 4, G, bx, 0};
                epi::EpiMoeDN E{ws, LIST}; pg8::gemm_phase<FF, epi::EpiMoeDN, pg8::GroupedOrder, true>(wbase, lds + RING_OFF, lds + PARK_OFF, g, S, E);
            } } break;
        case K_LN2: ph::phase_ln2(wbase, ws, args.in[25] + l * Dm, args.in[26] + l * Dm, args.out, G, vcu); break;
        default: break;
        }
        if (ph + 1 < ph_hi) { XcdBarrier bar; bar.bar = (unsigned*)(ws + WS_CTL) + CW_BAR + ap->bar_id * XCD_BAR_WORDS; bar.x = xb_xcc_id(); bar.st = (volatile LAS unsigned*)(lds + MISC_OFF) + 8;
            xcd_barrier(bar, pg8::fresh_tid(wbase) == 0); }
    }
}
__global__ void __launch_bounds__(256) k_convT(const float* __restrict__ src, bf16* __restrict__ dst, int K, int N, int rmul, int radd, int dzrows) {
    __shared__ float tile[32][33];
    const int z = blockIdx.z; src += (size_t)z * K * N; dst += (size_t)z * dzrows * K;
    const int n0 = blockIdx.x * 32, k0 = blockIdx.y * 32, tx = threadIdx.x & 31, ty = threadIdx.x >> 5;
#pragma unroll
    for (int i = 0; i < 4; ++i) tile[ty + 8 * i][tx] = src[(size_t)(k0 + ty + 8 * i) * N + n0 + tx];
    __syncthreads();
#pragma unroll
    for (int i = 0; i < 4; ++i) { const int n = n0 + ty + 8 * i; dst[(size_t)(n * rmul + radd) * K + k0 + tx] = f2bf(tile[tx][ty + 8 * i]); }
}

__global__ void __launch_bounds__(256) k_tables(const float* lam_re, const float* lam_im, const float* log_step, const float* b_re, const float* b_im, unsigned char* ws) {
    const int gid = blockIdx.x * 256 + threadIdx.x;
    float* COS = (float*)(ws + TAB_COS); float* SIN = (float*)(ws + TAB_SIN); float* POWG = (float*)(ws + TAB_POWG);
    float* AB = (float*)(ws + TAB_AB); float* BB = (float*)(ws + TAB_BB);
    if (gid < 2048 * 32) { const int pos = gid >> 5, i = gid & 31; const float inv = (float)pow(10000.0, -(double)i / 32.0); const float ang = (float)pos * inv;
        COS[gid] = (float)cos((double)ang); SIN[gid] = (float)sin((double)ang); }
    if (gid < 8 * 80) { const int h = gid / 80, n = gid % 80; const double g = 1.0 - pow(2.0, -5.0 - h); POWG[gid] = (float)pow(g, (double)n); }
    if (gid < DEPTH * S5G * S5N) {
        const int g = (gid / S5N) % S5G, l = gid / (S5G * S5N);
        double lr = lam_re[gid]; if (lr > -1e-4) lr = -1e-4; const double li = lam_im[gid];
        const double step = exp((double)log_step[l * S5G + g]);
        const double mag = exp(lr * step), ang = li * step, abr = mag * cos(ang), abi = mag * sin(ang);
        const double den = lr * lr + li * li, nre = abr - 1.0;
        const double zr = (nre * lr + abi * li) / den, zi = (abi * lr - nre * li) / den;
        AB[gid * 2] = (float)abr; AB[gid * 2 + 1] = (float)abi;
        for (int c = 0; c < 16; ++c) { const double br = b_re[(size_t)gid * 16 + c], bi = b_im[(size_t)gid * 16 + c];
            BB[((size_t)gid * 16 + c) * 2] = (float)(zr * br - zi * bi); BB[((size_t)gid * 16 + c) * 2 + 1] = (float)(zr * bi + zi * br); }
    }
}

__global__ void __launch_bounds__(256) k_ln(const float* __restrict__ pre, float scale, const bf16* __restrict__ y2, const float* __restrict__ g, const float* __restrict__ b, float* __restrict__ of, bf16* __restrict__ ob) {
    const int row = blockIdx.x * 4 + (threadIdx.x >> 6), lane = threadIdx.x & 63;
    float v[16]; float s = 0.f;
#pragma unroll
    for (int j = 0; j < 4; ++j) { const float4 x = *(const float4*)(pre + (size_t)row * Dm + j * 256 + lane * 4); v[4 * j] = x.x * scale; v[4 * j + 1] = x.y * scale; v[4 * j + 2] = x.z * scale; v[4 * j + 3] = x.w * scale; }
    if (y2) {
#pragma unroll
        for (int j = 0; j < 4; ++j)
#pragma unroll
            for (int e = 0; e < 4; ++e) { const int c = j * 256 + lane * 4 + e; v[4 * j + e] += bf2f(y2[(size_t)(2 * row) * Dm + c]) + bf2f(y2[(size_t)(2 * row + 1) * Dm + c]); }
    }
#pragma unroll
    for (int i = 0; i < 16; ++i) s += v[i];
    const float mean = wave_sum(s) * (1.f / Dm); float q = 0.f;
#pragma unroll
    for (int i = 0; i < 16; ++i) { v[i] -= mean; q += v[i] * v[i]; }
    const float rstd = rsqrtf(wave_sum(q) * (1.f / Dm) + LN_EPS);
#pragma unroll
    for (int j = 0; j < 4; ++j)
#pragma unroll
        for (int e = 0; e < 4; ++e) { const int c = j * 256 + lane * 4 + e; const float o = v[4 * j + e] * rstd * g[c] + b[c]; of[(size_t)row * Dm + c] = o; ob[(size_t)row * Dm + c] = f2bf(o); }
}

struct EpiArgs { unsigned char* ws; const float* hres; float* hout; int layer; int pad; };
enum { EPI_PROJ = 0, EPI_RET = 1, EPI_GLU = 2, EPI_S5B = 3, EPI_OUT = 4 };
template <int EPI> DEV void epi_store(const EpiArgs& e, int m, int n, float acc) {
    unsigned char* ws = e.ws;
    if (EPI == EPI_PROJ) {
        if (n < 512) ((bf16*)(ws + R_Q))[(size_t)m * 512 + n] = f2bf(acc);
        else if (n < 1024) ((bf16*)(ws + R_K))[(size_t)m * 512 + (n - 512)] = f2bf(acc * 0.125f);
        else if (n < 2048) ((bf16*)(ws + R_V))[(size_t)m * 1024 + (n - 1024)] = f2bf(acc);
        else if (n < 3072) ((bf16*)(ws + R_G))[(size_t)m * 1024 + (n - 2048)] = f2bf(siluf_(acc));
        else if (n < 3584) ((bf16*)(ws + R_U))[(size_t)m * 512 + (n - 3072)] = f2bf(acc);
        else if (n < 4608) ((bf16*)(ws + R_GR))[(size_t)m * 1024 + (n - 3584)] = f2bf(sigmoidf_(acc));
        else ((bf16*)(ws + R_GS))[(size_t)m * 1024 + (n - 4608)] = f2bf(sigmoidf_(acc));
    } else if (EPI == EPI_RET) {
        const float g = bf2f(((const bf16*)(ws + R_GR))[(size_t)m * 1024 + n]);
        ((bf16*)(ws + R_G))[(size_t)m * 1024 + n] = f2bf(g * acc);
    } else if (EPI == EPI_GLU) {
        const float z = bf2f(((const bf16*)(ws + R_U))[(size_t)m * 512 + n]);
        ((bf16*)(ws + R_S5IN))[(size_t)m * 512 + n] = f2bf(z * sigmoidf_(acc));
    } else if (EPI == EPI_S5B) {
        const float g = bf2f(((const bf16*)(ws + R_GS))[(size_t)m * 1024 + n]);
        bf16* p = ((bf16*)(ws + R_G)) + (size_t)m * 1024 + n; *p = f2bf(bf2f(*p) + g * acc);
    } else if (EPI == EPI_OUT) {
        e.hout[(size_t)m * Dm + n] = ALPHA * e.hres[(size_t)m * Dm + n] + acc;
    }
}
template <int EPI> __global__ void __launch_bounds__(256) k_gemm_naive(const bf16* __restrict__ A, const bf16* __restrict__ Bt, int M, int N, int K, EpiArgs e) {
    __shared__ float sA[32][65], sB[32][65];
    const int m0 = blockIdx.y * 64, n0 = blockIdx.x * 64, tid = threadIdx.x, tx = tid & 15, ty = tid >> 4;
    float acc[4][4];
#pragma unroll
    for (int i = 0; i < 4; ++i)
#pragma unroll
        for (int j = 0; j < 4; ++j) acc[i][j] = 0.f;
    for (int k0 = 0; k0 < K; k0 += 32) {
#pragma unroll
        for (int i = 0; i < 8; ++i) { const int idx = tid + 256 * i, r = idx >> 5, c = idx & 31;
            sA[c][r] = bf2f(A[(size_t)(m0 + r) * K + k0 + c]); sB[c][r] = bf2f(Bt[(size_t)(n0 + r) * K + k0 + c]); }
        __syncthreads();
#pragma unroll 8
        for (int k = 0; k < 32; ++k) {
            float a[4], b[4];
#pragma unroll
            for (int i = 0; i < 4; ++i) { a[i] = sA[k][ty * 4 + i]; b[i] = sB[k][tx * 4 + i]; }
#pragma unroll
            for (int i = 0; i < 4; ++i)
#pragma unroll
                for (int j = 0; j < 4; ++j) acc[i][j] += a[i] * b[j];
        }
        __syncthreads();
    }
#pragma unroll
    for (int i = 0; i < 4; ++i)
#pragma unroll
        for (int j = 0; j < 4; ++j) epi_store<EPI>(e, m0 + ty * 4 + i, n0 + tx * 4 + j, acc[i][j]);
}

DEV void load_rot(float* dst, const bf16* src  , int row0, int h, int pos0, const float* COS, const float* SIN, int tid, int nthr) {
    for (int idx = tid; idx < 64 * 32; idx += nthr) { const int i = idx >> 5, c = idx & 31;
        const float x1 = bf2f(src[(size_t)(row0 + i) * 512 + h * 64 + c]), x2 = bf2f(src[(size_t)(row0 + i) * 512 + h * 64 + 32 + c]);
        const float cs = COS[(pos0 + i) * 32 + c], sn = SIN[(pos0 + i) * 32 + c];
        dst[i * 64 + c] = x1 * cs - x2 * sn; dst[i * 64 + 32 + c] = x1 * sn + x2 * cs; }
}
__global__ void __launch_bounds__(256) k_ret_kv(unsigned char* ws) {
    extern __shared__ float sm[];
    float* kr = sm; float* vv = sm + 64 * 64;
    const int item = blockIdx.x, n = item % NCH, h = (item / NCH) % RH, b = item / (NCH * RH), tid = threadIdx.x;
    const int row0 = b * SEQ + n * CHUNK;
    const float* COS = (const float*)(ws + TAB_COS); const float* SIN = (const float*)(ws + TAB_SIN); const float* POWG = (const float*)(ws + TAB_POWG) + h * 80;
    load_rot(kr, (const bf16*)(ws + R_K), row0, h, n * CHUNK, COS, SIN, tid, 256);
    const bf16* V = (const bf16*)(ws + R_V);
    for (int idx = tid; idx < 64 * 128; idx += 256) { const int j = idx >> 7, c = idx & 127; vv[idx] = bf2f(V[(size_t)(row0 + j) * 1024 + h * 128 + c]); }
    __syncthreads();
    for (int idx = tid; idx < 64 * 64; idx += 256) { const int j = idx >> 6; kr[idx] *= POWG[63 - j]; }
    __syncthreads();
    float* KV = (float*)(ws + WS_HB) + (size_t)item * 64 * 128;
    const int dv = tid & 127, dk0 = (tid >> 7) * 32;
    for (int dk = dk0; dk < dk0 + 32; ++dk) { float s = 0.f;
        for (int j = 0; j < 64; ++j) s += kr[j * 64 + dk] * vv[j * 128 + dv];
        KV[dk * 128 + dv] = s; }
}
__global__ void __launch_bounds__(256) k_ret_scan(unsigned char* ws) {
    const int gid = blockIdx.x * 256 + threadIdx.x;
    const int e = gid & 8191, bh = gid >> 13, h = bh % RH;
    const float cd = ((const float*)(ws + TAB_POWG))[h * 80 + 64];
    float* KV = (float*)(ws + WS_HB) + (size_t)bh * NCH * 8192 + e;
    float s = 0.f;
    for (int n = 0; n < NCH; ++n) { const float kv = KV[(size_t)n * 8192]; KV[(size_t)n * 8192] = s; s = cd * s + kv; }
}
__global__ void __launch_bounds__(256) k_ret_out(unsigned char* ws) {
    extern __shared__ float sm[];
    float* qr = sm; float* kr = sm + 4096; float* vv = sm + 8192; float* S = sm + 8192 + 8192;
    const int item = blockIdx.x, n = item % NCH, h = (item / NCH) % RH, b = item / (NCH * RH), tid = threadIdx.x;
    const int row0 = b * SEQ + n * CHUNK;
    const float* COS = (const float*)(ws + TAB_COS); const float* SIN = (const float*)(ws + TAB_SIN); const float* POWG = (const float*)(ws + TAB_POWG) + h * 80;
    load_rot(qr, (const bf16*)(ws + R_Q), row0, h, n * CHUNK, COS, SIN, tid, 256);
    load_rot(kr, (const bf16*)(ws + R_K), row0, h, n * CHUNK, COS, SIN, tid, 256);
    bf16* V = (bf16*)(ws + R_V);
    for (int idx = tid; idx < 64 * 128; idx += 256) { const int j = idx >> 7, c = idx & 127; vv[idx] = bf2f(V[(size_t)(row0 + j) * 1024 + h * 128 + c]); }
    __syncthreads();
    for (int idx = tid; idx < 64 * 64; idx += 256) { const int i = idx >> 6, j = idx & 63; float s = 0.f;
        for (int d = 0; d < 64; ++d) s += qr[i * 64 + d] * kr[j * 64 + d];
        const int dd = i > j ? i - j : j - i; S[idx] = s * POWG[dd]; }
    __syncthreads();
    const float* ST = (const float*)(ws + WS_HB) + (size_t)item * 64 * 128;
    const int i = tid >> 2, c0 = (tid & 3) * 32;
    float o[32];
#pragma unroll
    for (int c = 0; c < 32; ++c) o[c] = 0.f;
    for (int j = 0; j < 64; ++j) { const float sij = S[i * 64 + j];
#pragma unroll
        for (int c = 0; c < 32; ++c) o[c] += sij * vv[j * 128 + c0 + c]; }
    const float qd = POWG[i + 1];
    for (int d = 0; d < 64; ++d) { const float qv = qr[i * 64 + d] * qd;
#pragma unroll
        for (int c = 0; c < 32; ++c) o[c] += qv * ST[d * 128 + c0 + c]; }
    float s = 0.f;
#pragma unroll
    for (int c = 0; c < 32; ++c) s += o[c];
    s += __shfl_xor(s, 1); s += __shfl_xor(s, 2);
    const float mean = s * (1.f / 128.f); float q = 0.f;
#pragma unroll
    for (int c = 0; c < 32; ++c) { o[c] -= mean; q += o[c] * o[c]; }
    q += __shfl_xor(q, 1); q += __shfl_xor(q, 2);
    const float rstd = rsqrtf(q * (1.f / 128.f) + HN_EPS);
    const bf16* G = (const bf16*)(ws + R_G);
#pragma unroll
    for (int c = 0; c < 32; ++c) { const size_t off = (size_t)(row0 + i) * 1024 + h * 128 + c0 + c; V[off] = f2bf(bf2f(G[off]) * o[c] * rstd); }
}

__global__ void __launch_bounds__(64) k_s5(unsigned char* ws, const float* __restrict__ c_re, const float* __restrict__ c_im, const float* __restrict__ dsk, int layer) {
    __shared__ float hb[64][64][2];
    __shared__ float us[64][16];
    const int g = blockIdx.x % S5G, b = blockIdx.x / S5G, n = threadIdx.x;
    const float* AB = (const float*)(ws + TAB_AB) + ((size_t)(layer * S5G + g) * S5N + n) * 2;
    const float* BB = (const float*)(ws + TAB_BB) + ((size_t)(layer * S5G + g) * S5N + n) * 32;
    const float ar = AB[0], ai = AB[1];
    float bbr[16], bbi[16];
#pragma unroll
    for (int c = 0; c < 16; ++c) { bbr[c] = BB[2 * c]; bbi[c] = BB[2 * c + 1]; }
    bf16* U = (bf16*)(ws + R_U);
    const float* CR = c_re + (size_t)(layer * S5G + g) * 16 * 64; const float* CI = c_im + (size_t)(layer * S5G + g) * 16 * 64;
    float hr = 0.f, hi = 0.f;
    for (int ch = 0; ch < NCH; ++ch) {
        const int row0 = b * SEQ + ch * 64;
        for (int idx = n; idx < 64 * 16; idx += 64) us[idx >> 4][idx & 15] = bf2f(U[(size_t)(row0 + (idx >> 4)) * 512 + g * 16 + (idx & 15)]);
        __syncthreads();
        for (int t = 0; t < 64; ++t) { float br = 0.f, bi = 0.f;
#pragma unroll
            for (int c = 0; c < 16; ++c) { br += us[t][c] * bbr[c]; bi += us[t][c] * bbi[c]; }
            const float nr = ar * hr - ai * hi + br, ni = ar * hi + ai * hr + bi; hr = nr; hi = ni;
            hb[t][n][0] = hr; hb[t][n][1] = hi; }
        __syncthreads();
        for (int idx = n; idx < 64 * 16; idx += 64) { const int t = idx >> 4, c = idx & 15; float y = 0.f;
            for (int m = 0; m < 64; ++m) y += hb[t][m][0] * CR[c * 64 + m] - hb[t][m][1] * CI[c * 64 + m];
            y += dsk[layer * 512 + g * 16 + c] * us[t][c];
            U[(size_t)(row0 + t) * 512 + g * 16 + c] = f2bf(geluf_(y)); }
        __syncthreads();
    }
}

__global__ void __launch_bounds__(256) k_ln_route(float* __restrict__ pre, const float* __restrict__ g, const float* __restrict__ b, bf16* __restrict__ ob,
                                                  const float* __restrict__ wrg, const float* __restrict__ brg, const float* __restrict__ wre, const float* __restrict__ bre, unsigned char* ws, int layer) {
    const int row = blockIdx.x * 4 + (threadIdx.x >> 6), lane = threadIdx.x & 63;
    float v[16]; float s = 0.f;
#pragma unroll
    for (int j = 0; j < 4; ++j) { const float4 x = *(const float4*)(pre + (size_t)row * Dm + j * 256 + lane * 4); v[4 * j] = x.x; v[4 * j + 1] = x.y; v[4 * j + 2] = x.z; v[4 * j + 3] = x.w; }
#pragma unroll
    for (int i = 0; i < 16; ++i) s += v[i];
    const float mean = wave_sum(s) * (1.f / Dm); float q = 0.f;
#pragma unroll
    for (int i = 0; i < 16; ++i) { v[i] -= mean; q += v[i] * v[i]; }
    const float rstd = rsqrtf(wave_sum(q) * (1.f / Dm) + LN_EPS);
#pragma unroll
    for (int j = 0; j < 4; ++j)
#pragma unroll
        for (int e = 0; e < 4; ++e) { const int c = j * 256 + lane * 4 + e; const float o = v[4 * j + e] * rstd * g[c] + b[c]; v[4 * j + e] = o; pre[(size_t)row * Dm + c] = o; ob[(size_t)row * Dm + c] = f2bf(o); }
    float lg[4];
#pragma unroll
    for (int k = 0; k < 4; ++k) { float a = 0.f;
#pragma unroll
        for (int j = 0; j < 4; ++j)
#pragma unroll
            for (int e = 0; e < 4; ++e) a += v[4 * j + e] * wrg[(size_t)(j * 256 + lane * 4 + e) * MG + k];
        lg[k] = wave_sum(a) + brg[k]; }
    int gi = 0; float gm = lg[0];
#pragma unroll
    for (int k = 1; k < 4; ++k) if (lg[k] > gm) { gm = lg[k]; gi = k; }
    float den = 0.f;
#pragma unroll
    for (int k = 0; k < 4; ++k) den += __expf(lg[k] - gm);
    const float gtop = 1.f / den;
    float le[8];
#pragma unroll
    for (int k = 0; k < 8; ++k) { float a = 0.f;
#pragma unroll
        for (int j = 0; j < 4; ++j)
#pragma unroll
            for (int e = 0; e < 4; ++e) a += v[4 * j + e] * wre[(size_t)(j * 256 + lane * 4 + e) * NE + gi * 8 + k];
        le[k] = wave_sum(a) + bre[gi * 8 + k]; }
    int i1 = 0; float m1 = le[0];
#pragma unroll
    for (int k = 1; k < 8; ++k) if (le[k] > m1) { m1 = le[k]; i1 = k; }
    int i2 = -1; float m2 = -INFINITY;
#pragma unroll
    for (int k = 0; k < 8; ++k) if (k != i1 && le[k] > m2) { m2 = le[k]; i2 = k; }
    const float p2 = __expf(m2 - m1);
    const float w1 = 1.f / (1.f + p2), w2 = p2 / (1.f + p2);
    if (lane == 0) {
        int* TE = (int*)(ws + RT_E); float* TC = (float*)(ws + RT_C); int* LIST = (int*)(ws + RT_LIST); unsigned* CNT = (unsigned*)(ws + WS_CNT) + layer * NE;
        const int e1 = gi * 8 + i1, e2 = gi * 8 + i2;
        TE[row * 2] = e1; TE[row * 2 + 1] = e2; TC[row * 2] = gtop * w1; TC[row * 2 + 1] = gtop * w2;
        const unsigned p1 = atomicAdd(&CNT[e1], 1u); LIST[(size_t)e1 * T + p1] = row * 2;
        const unsigned p2_ = atomicAdd(&CNT[e2], 1u); LIST[(size_t)e2 * T + p2_] = row * 2 + 1;
    }
}

__global__ void __launch_bounds__(256) k_moe_naive(unsigned char* ws) {
    __shared__ float xs[1024]; __shared__ float as[256];
    const int p = blockIdx.x, tok = p >> 1, tid = threadIdx.x;
    const int E = ((const int*)(ws + RT_E))[p]; const float cw = ((const float*)(ws + RT_C))[p];
    const bf16* X = (const bf16*)(ws + WS_HBF) + (size_t)tok * Dm;
    for (int i = tid; i < 1024; i += 256) xs[i] = bf2f(X[i]);
    __syncthreads();
    const bf16* WG = (const bf16*)(ws + R_WGU) + ((size_t)E * 512 + 2 * tid) * 1024; const bf16* WU = WG + 1024;
    float ga = 0.f, ua = 0.f;
    for (int k = 0; k < 1024; k += 8) { const uint4 a4 = *(const uint4*)(WG + k), b4 = *(const uint4*)(WU + k);
        const unsigned aw[4] = {a4.x, a4.y, a4.z, a4.w}, bw[4] = {b4.x, b4.y, b4.z, b4.w};
#pragma unroll
        for (int j = 0; j < 4; ++j) { ga += xs[k + 2 * j] * __uint_as_float(aw[j] << 16) + xs[k + 2 * j + 1] * __uint_as_float(aw[j] & 0xffff0000u);
                                      ua += xs[k + 2 * j] * __uint_as_float(bw[j] << 16) + xs[k + 2 * j + 1] * __uint_as_float(bw[j] & 0xffff0000u); } }
    const float a = bf2f(f2bf(siluf_(ga) * ua));
    as[tid] = a; ((bf16*)(ws + R_ACT))[(size_t)p * 256 + tid] = f2bf(a);
    __syncthreads();
    bf16* Y = (bf16*)(ws + R_Y) + (size_t)p * Dm;
    for (int d = tid; d < 1024; d += 256) { const bf16* WD = (const bf16*)(ws + R_WDN) + ((size_t)E * 1024 + d) * 256; float s = 0.f;
        for (int f = 0; f < 256; ++f) s += as[f] * bf2f(WD[f]);
        Y[d] = f2bf(cw * s); }
}

#ifndef MK_ONE_LAUNCH
#define MK_ONE_LAUNCH 0
#endif
static int g_grid = 0;
static void launch_mk(const Args& base, int lo, int hi, int bar_id, hipStream_t stream) {
    Args a = base; a.ph_lo = lo; a.ph_hi = hi; a.bar_id = bar_id;
    hipLaunchKernelGGL(mk_fwd, dim3(g_grid), dim3(NWAVES * 64), LDS_BYTES, stream, a);
}
extern "C" void kernel_launch(void* const* d_in, const int* in_sizes, int n_in, void* d_out, int out_size, void* d_ws, size_t ws_size, hipStream_t stream) {
    static int ok = 0;
    if (ok == 0) {
        if (n_in != 27 || in_sizes[0] != T * Dm || out_size != T * Dm || ws_size < WS_END) { fprintf(stderr, "kernel_launch: unexpected shapes/ws (%d, %d, %d, %zu < %zu)\n", n_in, n_in > 0 ? in_sizes[0] : -1, out_size, ws_size, (size_t)WS_END); ok = -1; return; }
        (void)hipFuncSetAttribute((const void*)k_ret_out, hipFuncAttributeMaxDynamicSharedMemorySize, 80 * 1024);
        (void)hipFuncSetAttribute((const void*)k_ret_kv, hipFuncAttributeMaxDynamicSharedMemorySize, 48 * 1024);
        int dev = 0, cus = 0;
        if (hipGetDevice(&dev) != hipSuccess || hipDeviceGetAttribute(&cus, hipDeviceAttributeMultiprocessorCount, dev) != hipSuccess) { fprintf(stderr, "kernel_launch: device query failed\n"); ok = -1; return; }
        if (hipFuncSetAttribute((const void*)mk_fwd, hipFuncAttributeMaxDynamicSharedMemorySize, LDS_BYTES) != hipSuccess) { fprintf(stderr, "kernel_launch: LDS attribute failed\n"); ok = -1; return; }
        g_grid = cus;
        ok = 1;
    }
    if (ok < 0) return;
    unsigned char* ws = (unsigned char*)d_ws;
    const float* const* in = (const float* const*)d_in;
    float* hA = (float*)d_out;
    (void)hipMemsetAsync(ws + WS_CTL, 0, 1 * MiB, stream);
    Args base{}; for (int i = 0; i < 27; ++i) base.in[i] = in[i]; base.out = hA; base.ws = ws;
#if MK_ONE_LAUNCH
    launch_mk(base, 0, NPH, 0, stream);
#else
    for (int p = 0; p < NPH; ++p) launch_mk(base, p, p + 1, 0, stream);
#endif
}
```

```cpp
#include <hip/hip_runtime.h>
#include <cstdio>
#include <cstdint>
#include <cmath>

typedef unsigned short bf16;
#define DEV __device__ __forceinline__

constexpr int Dm = 1024, BATCH = 8, SEQ = 2048, T = BATCH * SEQ, DEPTH = 2;
constexpr int CHUNK = 64, NCH = SEQ / CHUNK;
constexpr int RH = 8, RQK = 512, RV = 1024, DK = 64, DV = 128;
constexpr int S5W = 512, S5G = 32, S5GC = 16, S5N = 64;
constexpr int MG = 4, EPG = 8, NE = 32, FF = 256;
constexpr int INW = 5632;
constexpr float LN_EPS = 1e-5f, HN_EPS = 1e-6f;
constexpr float ALPHA = 1.41421356237309515f;

constexpr size_t MiB = 1u << 20;
constexpr size_t WS_CTL = 0;
constexpr size_t WS_CNT = 64 * 1024;
constexpr size_t WS_TAB = 1 * MiB;
constexpr size_t TAB_COS = WS_TAB;
constexpr size_t TAB_SIN = TAB_COS + 2048 * 32 * 4;
constexpr size_t TAB_POWG = TAB_SIN + 2048 * 32 * 4;
constexpr size_t TAB_AB = TAB_POWG + 8 * 80 * 4;
constexpr size_t TAB_BBH = TAB_AB + DEPTH * S5G * S5N * 2 * 4;
constexpr size_t TAB_CTH = TAB_BBH + (size_t)DEPTH * S5G * 128 * 16 * 2;
constexpr size_t TAB_WRT = TAB_CTH + (size_t)DEPTH * S5G * 16 * 128 * 2;
constexpr size_t TAB_WRH = TAB_WRT + (size_t)DEPTH * 36 * Dm * 4;
constexpr size_t TAB_WRL = TAB_WRH + (size_t)DEPTH * 48 * Dm * 2;
constexpr size_t TAB_END = TAB_WRL + (size_t)DEPTH * 48 * Dm * 2;
static_assert(TAB_END <= 3 * MiB, "tables");
constexpr size_t WS_S5E = 3 * MiB;
constexpr size_t WS_ROUTE = 7 * MiB;
constexpr size_t RT_E = WS_ROUTE, RT_C = RT_E + (size_t)T * 2 * 4, RT_LIST = RT_C + (size_t)T * 2 * 4;
static_assert(RT_LIST + (size_t)NE * T * 4 <= 10 * MiB, "route");
constexpr size_t WS_WSM = 10 * MiB;
constexpr size_t W_IN = WS_WSM;
constexpr size_t W_GLU = W_IN + (size_t)DEPTH * INW * Dm * 2;
constexpr size_t W_BRET = W_GLU + (size_t)DEPTH * S5W * S5W * 2;
constexpr size_t W_BS5 = W_BRET + (size_t)DEPTH * Dm * RV * 2;
constexpr size_t W_OUT = W_BS5 + (size_t)DEPTH * Dm * S5W * 2;
constexpr size_t W_END = W_OUT + (size_t)DEPTH * Dm * Dm * 2;
static_assert(W_END <= 44 * MiB, "small weights");
constexpr size_t WS_HB = 44 * MiB;
constexpr size_t WS_HBF = 108 * MiB;
constexpr size_t WS_R1 = 140 * MiB;
constexpr size_t R_Q = WS_R1, R_K = R_Q + 16 * MiB, R_U = R_K + 16 * MiB, R_GR = R_U + 16 * MiB, R_GS = R_GR + 32 * MiB;
constexpr size_t WS_R2 = 252 * MiB;
constexpr size_t R_V = WS_R2, R_G = R_V + 32 * MiB;
constexpr size_t WS_END = 316 * MiB;
constexpr size_t R_S5IN = R_Q;
constexpr size_t R_WGU = WS_R1;
constexpr size_t R_WDN = WS_R1 + 32 * MiB;
constexpr size_t R_ACT = WS_R1 + 48 * MiB;
constexpr size_t R_Y = WS_R2;

DEV float bf2f(bf16 v) { return __uint_as_float((unsigned)v << 16); }
DEV bf16 f2bf(float f) { unsigned u = __float_as_uint(f); return (bf16)((u + 0x7fffu + ((u >> 16) & 1u)) >> 16); }
DEV float sigmoidf_(float x) { return 1.f / (1.f + __expf(-x)); }
DEV float siluf_(float x) { return x * sigmoidf_(x); }
DEV float geluf_(float x) { const float c = 0.7978845608028654f; float t = tanhf(c * (x + 0.044715f * x * x * x)); return 0.5f * x * (1.f + t); }
template <int M> DEV float xshfl(float v) {
    if constexpr (M < 32) return __int_as_float(__builtin_amdgcn_ds_swizzle(__float_as_int(v), 0x1f | (M << 10)));
    else { const unsigned u = __float_as_uint(v); auto rr = __builtin_amdgcn_permlane32_swap(u, u, false, false);
           const bool hi = (__builtin_amdgcn_mbcnt_hi(~0u, __builtin_amdgcn_mbcnt_lo(~0u, 0u)) >= 32u); return __uint_as_float(hi ? rr[0] : rr[1]); }
}
template <int CTRL> DEV float dpp_add(float v) { return v + __int_as_float(__builtin_amdgcn_update_dpp(0, __float_as_int(v), CTRL, 0xf, 0xf, true)); }
DEV float wave_sum(float v) {
    v = dpp_add<0xB1>(v); v = dpp_add<0x4E>(v); v = dpp_add<0x141>(v); v = dpp_add<0x140>(v); v += xshfl<16>(v); v += xshfl<32>(v);
    return v;
}

namespace pg8 {
#define PG8_LAS __attribute__((address_space(3)))
typedef unsigned short bf16_t;
typedef short bf16x8 __attribute__((ext_vector_type(8)));
typedef float f32x4 __attribute__((ext_vector_type(4)));
typedef unsigned u32x4 __attribute__((ext_vector_type(4)));
typedef unsigned u32x2 __attribute__((ext_vector_type(2)));
typedef float f32x2 __attribute__((ext_vector_type(2)));
constexpr int BM = 256, BK = 64, HALF = 128, HTB = HALF * BK * 2  , STAGE_BYTES = 8 * HTB, NXCD = 8, WGM = 8;

__host__ __device__ __forceinline__ int lds_byte(int r, int c) { const int st = (r >> 4) * 2 + (c >> 5), rr = r & 15, cc = c & 31, ob = rr * 64 + cc * 2; return st * 1024 + (ob ^ (((ob >> 9) & 1) << 5)); }
__host__ __device__ __forceinline__ void stage_rc(int b, int& R, int& C) { const int st = b / 1024, sb = b % 1024, swz = sb ^ (((sb >> 9) & 1) << 5); R = (st >> 1) * 16 + swz / 64; C = (st & 1) * 32 + (swz % 64) / 2; }
__host__ __device__ __forceinline__ int perm32(int rho) { const int n = rho >> 4, i = rho & 15; return 8 * (i >> 2) + 4 * n + (i & 3); }

struct Unit { int pm, pn, pnb, e, cnt; };
struct Gemm { const bf16_t* A; const bf16_t* Bt; int K; };

struct StaticOrder {
    int nM, nN, nwg, G, c, K;
    __device__ void init(int M, int N, int K_, int G_, int c_) { nM = M / BM; nN = N / BM; nwg = nM * nN; G = G_; c = c_; K = K_; }
    __device__ bool next(int i, Unit& u) const {
        const long L = (long)i * G + c; if (L >= nwg) return false;
        int wgid = (int)L; { const int q = nwg / NXCD, r = nwg % NXCD, xcd = wgid % NXCD, off = wgid / NXCD; wgid = (xcd < r ? xcd * (q + 1) : r * (q + 1) + (xcd - r) * q) + off; }
        const int nig = WGM * nN, gid = wgid / nig, fm = gid * WGM, gsz = (nM - fm) < WGM ? (nM - fm) : WGM;
        u.pm = fm + ((wgid % nig) % gsz); u.pn = (wgid % nig) / gsz; u.pnb = u.pn; u.e = 0; u.cnt = 0; return true;
    }
    static constexpr bool GATHER = false;
    __device__ __forceinline__ const unsigned* list_ptr(const Unit&, int) const { return nullptr; }
    __device__ __forceinline__ unsigned row_of(unsigned e) const { return e; }
};

__device__ __forceinline__ unsigned cvt_pk_bf16(float lo, float hi) { unsigned r; asm volatile("v_cvt_pk_bf16_f32 %0, %1, %2" : "=v"(r) : "v"(lo), "v"(hi)); return r; }

__device__ __forceinline__ int fresh_tid(int wbase) { int t = wbase + (int)__builtin_amdgcn_mbcnt_hi(~0u, __builtin_amdgcn_mbcnt_lo(~0u, 0u)); asm volatile("" : "+v"(t)); return t; }
template <int K, class Epi, class Sched, bool ALIGN_EPI = false>
__device__ __forceinline__ void gemm_phase(const int wbase, PG8_LAS unsigned char* lds, PG8_LAS unsigned char* park, const Gemm g, const Sched& S, const Epi& E) {
    constexpr bool GA = Sched::GATHER;
    const int wid = wbase >> 6, wr = wid >> 2, wc = wid & 3;
    const int tid = fresh_tid(wbase);
    constexpr int nt = K / BK; static_assert(K % 128 == 0 && K >= 256, "K");
    unsigned voffA[2], voffB[2];
#pragma unroll
    for (int i = 0; i < 2; ++i) { int R, C; stage_rc(tid * 16 + i * 8192, R, C); const int Rb = Epi::PERM ? ((R & ~31) + perm32(R & 31)) : R;
        voffA[i] = (unsigned)(R * K + C) * 2u; voffB[i] = (unsigned)(Rb * K + C) * 2u; }
#define PG8_RC(i, R, C) int R, C; stage_rc(fresh_tid(wbase) * 16 + (i) * 8192, R, C)
    const int kstep = BK * 2;
    const int hstep = HALF * K * 2;
    const int tstep = 2 * hstep;
    const __amdgpu_buffer_rsrc_t rsA = __builtin_amdgcn_make_buffer_rsrc((void*)g.A, 0, 0x7fffffff, 0x00020000);
    const __amdgpu_buffer_rsrc_t rsB = __builtin_amdgcn_make_buffer_rsrc((void*)g.Bt, 0, 0x7fffffff, 0x00020000);
    const unsigned ldsw = (unsigned)wid * 1024u;
    const int aoff = lds_byte(wr * 64 + (tid & 15), ((tid & 63) >> 4) * 8), boff = lds_byte(wc * 32 + (tid & 15), ((tid & 63) >> 4) * 8);
#define PG8_SA(b, h) (((b) * 2 + (h)) * HTB)
#define PG8_SB(b, h) ((4 + (b) * 2 + (h)) * HTB)
#define PG8_STAGE(bufoff, rs, voff, so) do { _Pragma("unroll") for (int _i = 0; _i < 2; ++_i) \
        __builtin_amdgcn_raw_ptr_buffer_load_lds(rs, (PG8_LAS void*)(lds + (bufoff) + ldsw + _i * 8192), 16, (int)(voff)[_i], (int)(so), 0, 0); } while (0)
#define PG8_STAGE_B(bufoff, so) PG8_STAGE(bufoff, rsB, voffB, so)
#define PG8_STAGE_A(bufoff, h, kb) do { if constexpr (GA) { if ((h) == 0) PG8_STAGE(bufoff, rsA, ao0, kb); else PG8_STAGE(bufoff, rsA, ao1, kb); } else { PG8_STAGE(bufoff, rsA, voffA, (kb) + (h) * hstep); } } while (0)
#define PG8_LDA(dst, b, h) do { _Pragma("unroll") for (int m = 0; m < 4; ++m) _Pragma("unroll") for (int k = 0; k < 2; ++k) dst[m][k] = *(const PG8_LAS bf16x8*)(lds + PG8_SA(b, h) + aoff + m * 2048 + k * 1024); } while (0)
#define PG8_LDB(dst, b, h) do { _Pragma("unroll") for (int n = 0; n < 2; ++n) _Pragma("unroll") for (int k = 0; k < 2; ++k) dst[n][k] = *(const PG8_LAS bf16x8*)(lds + PG8_SB(b, h) + boff + n * 2048 + k * 1024); } while (0)
#define PG8_MMA(ai, bj, At, Bt) do { __builtin_amdgcn_s_setprio(1); _Pragma("unroll") for (int m = 0; m < 4; ++m) _Pragma("unroll") for (int n = 0; n < 2; ++n) _Pragma("unroll") for (int k = 0; k < 2; ++k) \
        acc[ai][bj][m][n] = __builtin_amdgcn_mfma_f32_16x16x32_bf16(Bt[n][k], At[m][k], acc[ai][bj][m][n], 0, 0, 0); __builtin_amdgcn_s_setprio(0); } while (0)
#define PG8_WAIT_V(n) asm volatile("s_waitcnt vmcnt(" #n ")" ::: "memory")
#define PG8_WAIT_L(n) asm volatile("s_waitcnt lgkmcnt(" #n ")" ::: "memory")
#define PG8_BAR __builtin_amdgcn_s_barrier()
#define PG8_SCHED __builtin_amdgcn_sched_barrier(0)
    Unit cur, nxt; int ui = 0;
    if (!S.next(0, cur)) return;
    f32x4 acc[2][2][4][2];
#pragma unroll
    for (int a = 0; a < 2; ++a)
#pragma unroll
        for (int b = 0; b < 2; ++b)
#pragma unroll
            for (int m = 0; m < 4; ++m)
#pragma unroll
                for (int n = 0; n < 2; ++n) acc[a][b][m][n] = (f32x4){0.f, 0.f, 0.f, 0.f};
    bf16x8 At[4][2], B0[2][2], B1[2][2];
    unsigned ao0[2] = {0u, 0u}, ao1[2] = {0u, 0u};
    if constexpr (GA) {
#pragma unroll
        for (int i = 0; i < 2; ++i) { PG8_RC(i, R, C); ao0[i] = (S.row_of(*S.list_ptr(cur, R)) * (unsigned)K + (unsigned)C) * 2u; ao1[i] = (S.row_of(*S.list_ptr(cur, HALF + R)) * (unsigned)K + (unsigned)C) * 2u; }
    }
    int cA = GA ? 0 : cur.pm * tstep;
    int cB = cur.pnb * tstep;
    PG8_STAGE_B(PG8_SB(0, 0), cB); PG8_STAGE_B(PG8_SB(0, 1), cB + hstep); PG8_STAGE_A(PG8_SA(0, 0), 0, cA); PG8_STAGE_A(PG8_SA(0, 1), 1, cA);
    if (wr == 1) PG8_BAR;
    PG8_WAIT_V(2); PG8_BAR;
    PG8_STAGE_B(PG8_SB(1, 0), cB + kstep); PG8_STAGE_A(PG8_SA(1, 0), 0, cA + kstep); PG8_STAGE_B(PG8_SB(1, 1), cB + hstep + kstep);
    PG8_WAIT_V(6); PG8_BAR;
    for (;;) {
        const bool has_next = S.next(ui + 1, nxt);
        const int nA = (GA || !has_next) ? cA : nxt.pm * tstep; const int nB = has_next ? nxt.pnb * tstep : cB;
        if constexpr (GA) { if (has_next) {
#pragma unroll
            for (int s = 0; s < 4; ++s) { PG8_RC(s & 1, R, C); (void)C; __builtin_amdgcn_global_load_lds(S.list_ptr(nxt, (s >> 1) * HALF + R), (PG8_LAS unsigned*)(park + s * 2048 + wid * 256), 4, 0, 0); } } }
#define PG8_TRIP(LASTT) do { \
            const int a1 = cA + (t + 1) * kstep; \
            PG8_LDB(B0, 0, 0); PG8_LDB(B1, 0, 1); PG8_SCHED; PG8_LDA(At, 0, 0); PG8_STAGE_A(PG8_SA(1, 1), 1, a1); \
            if constexpr (GA && (LASTT)) { if (has_next) { _Pragma("unroll") for (int i = 0; i < 2; ++i) { PG8_RC(i, R, C); (void)R; const int t4 = fresh_tid(wbase) * 4; \
                ao0[i] = (S.row_of(*(const PG8_LAS unsigned*)(park + (0 + i) * 2048 + t4)) * (unsigned)K + (unsigned)C) * 2u; \
                ao1[i] = (S.row_of(*(const PG8_LAS unsigned*)(park + (2 + i) * 2048 + t4)) * (unsigned)K + (unsigned)C) * 2u; } } } \
            const int a2 = (LASTT) ? nA : cA + (t + 2) * kstep; const int b2 = (LASTT) ? nB : cB + (t + 2) * kstep; \
            const int a3 = a2 + kstep; const int b3 = b2 + kstep; \
            PG8_WAIT_V(8); PG8_WAIT_L(0); PG8_BAR; PG8_MMA(0, 0, At, B0); PG8_MMA(0, 1, At, B1); PG8_BAR; PG8_SCHED; \
            PG8_LDA(At, 0, 1); PG8_STAGE_B(PG8_SB(0, 0), b2); PG8_STAGE_B(PG8_SB(0, 1), b2 + hstep); PG8_STAGE_A(PG8_SA(0, 0), 0, a2); \
            PG8_WAIT_V(8); PG8_WAIT_L(0); PG8_BAR; PG8_MMA(1, 0, At, B0); PG8_MMA(1, 1, At, B1); PG8_BAR; PG8_SCHED; \
            PG8_LDB(B0, 1, 0); PG8_LDB(B1, 1, 1); PG8_SCHED; PG8_LDA(At, 1, 0); PG8_STAGE_A(PG8_SA(0, 1), 1, a2); \
            PG8_WAIT_V(8); PG8_WAIT_L(0); PG8_BAR; PG8_MMA(0, 0, At, B0); PG8_MMA(0, 1, At, B1); PG8_BAR; PG8_SCHED; \
            PG8_LDA(At, 1, 1); PG8_STAGE_B(PG8_SB(1, 0), b3); PG8_STAGE_B(PG8_SB(1, 1), b3 + hstep); PG8_STAGE_A(PG8_SA(1, 0), 0, a3); \
            PG8_WAIT_V(8); PG8_WAIT_L(0); PG8_BAR; PG8_MMA(1, 0, At, B0); PG8_MMA(1, 1, At, B1); PG8_BAR; PG8_SCHED; \
        } while (0)
        int t = 0; int ntm = nt - 2; asm volatile("" : "+s"(ntm));
        for (; t < ntm; t += 2) PG8_TRIP(false);
        PG8_TRIP(true);
#undef PG8_TRIP
        if constexpr (ALIGN_EPI) { if (wr == 0) PG8_BAR; }
        { const int te = fresh_tid(wbase); E(acc, cur, wr, wc, te & 15, (te & 63) >> 4); }
        if (!has_next) break;
#pragma unroll
        for (int a = 0; a < 2; ++a)
#pragma unroll
            for (int b = 0; b < 2; ++b)
#pragma unroll
                for (int m = 0; m < 4; ++m)
#pragma unroll
                    for (int n = 0; n < 2; ++n) acc[a][b][m][n] = (f32x4){0.f, 0.f, 0.f, 0.f};
        cur = nxt; cA = nA; cB = nB; ++ui;
        if constexpr (ALIGN_EPI) { if (wr == 1) PG8_BAR; }
    }
    PG8_WAIT_V(0);
    if constexpr (!ALIGN_EPI) { if (wr == 0) PG8_BAR; }
    PG8_BAR;
#undef PG8_SA
#undef PG8_SB
#undef PG8_STAGE
#undef PG8_STAGE_A
#undef PG8_STAGE_B
#undef PG8_RC
#undef PG8_LDA
#undef PG8_LDB
#undef PG8_MMA
#undef PG8_WAIT_V
#undef PG8_WAIT_L
#undef PG8_BAR
#undef PG8_SCHED
}
}
namespace epi {
using pg8::f32x4; using pg8::u32x4; using pg8::u32x2; using pg8::Unit; using pg8::cvt_pk_bf16;
DEV float fsig(float x) { return __builtin_amdgcn_rcpf(1.f + __expf(-x)); }
DEV void st16(void* p, const u32x4 v) { asm volatile("global_store_dwordx4 %0, %1, off sc1\n\ts_nop 1" :: "v"(p), "v"(v) : "memory"); }
DEV u32x4 pack8(const f32x4 a, const f32x4 b) { u32x4 w; w.x = cvt_pk_bf16(a[0], a[1]); w.y = cvt_pk_bf16(a[2], a[3]); w.z = cvt_pk_bf16(b[0], b[1]); w.w = cvt_pk_bf16(b[2], b[3]); return w; }
DEV void unpack8(const u32x4 w, f32x4& a, f32x4& b) {
    a[0] = __uint_as_float(w.x << 16); a[1] = __uint_as_float(w.x & 0xffff0000u); a[2] = __uint_as_float(w.y << 16); a[3] = __uint_as_float(w.y & 0xffff0000u);
    b[0] = __uint_as_float(w.z << 16); b[1] = __uint_as_float(w.z & 0xffff0000u); b[2] = __uint_as_float(w.w << 16); b[3] = __uint_as_float(w.w & 0xffff0000u); }
#define EPI_FOR8(...) _Pragma("unroll") for (int ai = 0; ai < 2; ++ai) _Pragma("unroll") for (int m = 0; m < 4; ++m) _Pragma("unroll") for (int bj = 0; bj < 2; ++bj) { \
        const int row = u.pm * 256 + ai * 128 + wr * 64 + m * 16 + fr; const int ct = bj * 128 + wc * 32 + 8 * fq; f32x4 v0 = acc[ai][bj][m][0], v1 = acc[ai][bj][m][1]; __VA_ARGS__ }

struct EpiProj {
    static constexpr bool PERM = true;
    unsigned char* ws;
    DEV void operator()(const f32x4 (&acc)[2][2][4][2], const Unit& u, int wr, int wc, int fr, int fq) const {
        const int pn = u.pn; bf16* base; int ld, c0, act; float sc = 1.f;
        if (pn < 2) { base = (bf16*)(ws + R_Q); ld = 512; c0 = pn * 256; act = 0; }
        else if (pn < 4) { base = (bf16*)(ws + R_K); ld = 512; c0 = (pn - 2) * 256; act = 0; sc = 0.125f; }
        else if (pn < 8) { base = (bf16*)(ws + R_V); ld = 1024; c0 = (pn - 4) * 256; act = 0; }
        else if (pn < 12) { base = (bf16*)(ws + R_G); ld = 1024; c0 = (pn - 8) * 256; act = 1; }
        else if (pn < 14) { base = (bf16*)(ws + R_U); ld = 512; c0 = (pn - 12) * 256; act = 0; }
        else if (pn < 18) { base = (bf16*)(ws + R_GR); ld = 1024; c0 = (pn - 14) * 256; act = 2; }
        else { base = (bf16*)(ws + R_GS); ld = 1024; c0 = (pn - 18) * 256; act = 2; }
        EPI_FOR8(
            if (act == 1) { _Pragma("unroll") for (int j = 0; j < 4; ++j) { v0[j] = v0[j] * fsig(v0[j]); v1[j] = v1[j] * fsig(v1[j]); } }
            else if (act == 2) { _Pragma("unroll") for (int j = 0; j < 4; ++j) { v0[j] = fsig(v0[j]); v1[j] = fsig(v1[j]); } }
            else { v0 = v0 * sc; v1 = v1 * sc; }
            st16(base + (size_t)row * ld + c0 + ct, pack8(v0, v1)); )
    }
};
#define EPI_OFF(m, bj, LD) ((size_t)(u.pm * 256 + ai * 128 + wr * 64 + (m) * 16 + fr) * (LD) + u.pn * 256 + (bj) * 128 + wc * 32 + 8 * fq)
struct EpiRet {
    static constexpr bool PERM = true;
    unsigned char* ws;
    DEV void operator()(const f32x4 (&acc)[2][2][4][2], const Unit& u, int wr, int wc, int fr, int fq) const {
        const bf16* GR = (const bf16*)(ws + R_GR); bf16* O = (bf16*)(ws + R_G);
#pragma unroll
        for (int ai = 0; ai < 2; ++ai) { u32x4 gv[4][2];
#pragma unroll
            for (int m = 0; m < 4; ++m)
#pragma unroll
                for (int bj = 0; bj < 2; ++bj) gv[m][bj] = *(const u32x4*)(GR + EPI_OFF(m, bj, 1024));
#pragma unroll
            for (int m = 0; m < 4; ++m)
#pragma unroll
                for (int bj = 0; bj < 2; ++bj) { f32x4 g0, g1; unpack8(gv[m][bj], g0, g1); st16(O + EPI_OFF(m, bj, 1024), pack8(acc[ai][bj][m][0] * g0, acc[ai][bj][m][1] * g1)); } }
    }
};
struct EpiGlu {
    static constexpr bool PERM = true;
    unsigned char* ws;
    DEV void operator()(const f32x4 (&acc)[2][2][4][2], const Unit& u, int wr, int wc, int fr, int fq) const {
        const bf16* Z = (const bf16*)(ws + R_U); bf16* O = (bf16*)(ws + R_S5IN);
#pragma unroll
        for (int ai = 0; ai < 2; ++ai) { u32x4 zv[4][2];
#pragma unroll
            for (int m = 0; m < 4; ++m)
#pragma unroll
                for (int bj = 0; bj < 2; ++bj) zv[m][bj] = *(const u32x4*)(Z + EPI_OFF(m, bj, 512));
#pragma unroll
            for (int m = 0; m < 4; ++m)
#pragma unroll
                for (int bj = 0; bj < 2; ++bj) { f32x4 z0, z1, v0 = acc[ai][bj][m][0], v1 = acc[ai][bj][m][1]; unpack8(zv[m][bj], z0, z1);
#pragma unroll
                    for (int q = 0; q < 4; ++q) { v0[q] = z0[q] * fsig(v0[q]); v1[q] = z1[q] * fsig(v1[q]); }
                    st16(O + EPI_OFF(m, bj, 512), pack8(v0, v1)); } }
    }
};
struct EpiS5b {
    static constexpr bool PERM = true;
    unsigned char* ws;
    DEV void operator()(const f32x4 (&acc)[2][2][4][2], const Unit& u, int wr, int wc, int fr, int fq) const {
        const bf16* GS = (const bf16*)(ws + R_GS); bf16* O = (bf16*)(ws + R_G);
#pragma unroll
        for (int ai = 0; ai < 2; ++ai) { u32x4 gv[4][2], pv[4][2];
#pragma unroll
            for (int m = 0; m < 4; ++m)
#pragma unroll
                for (int bj = 0; bj < 2; ++bj) { gv[m][bj] = *(const u32x4*)(GS + EPI_OFF(m, bj, 1024)); pv[m][bj] = *(const u32x4*)(O + EPI_OFF(m, bj, 1024)); }
#pragma unroll
            for (int m = 0; m < 4; ++m)
#pragma unroll
                for (int bj = 0; bj < 2; ++bj) { f32x4 g0, g1, p0, p1; unpack8(gv[m][bj], g0, g1); unpack8(pv[m][bj], p0, p1);
                    st16(O + EPI_OFF(m, bj, 1024), pack8(p0 + acc[ai][bj][m][0] * g0, p1 + acc[ai][bj][m][1] * g1)); } }
    }
};
struct EpiOut {
    static constexpr bool PERM = true;
    const bf16* hres; bf16* out;
    DEV void operator()(const f32x4 (&acc)[2][2][4][2], const Unit& u, int wr, int wc, int fr, int fq) const {
#pragma unroll
        for (int ai = 0; ai < 2; ++ai) { u32x4 hv[4][2];
#pragma unroll
            for (int m = 0; m < 4; ++m)
#pragma unroll
                for (int bj = 0; bj < 2; ++bj) hv[m][bj] = *(const u32x4*)(hres + EPI_OFF(m, bj, Dm));
#pragma unroll
            for (int m = 0; m < 4; ++m)
#pragma unroll
                for (int bj = 0; bj < 2; ++bj) { f32x4 h0, h1; unpack8(hv[m][bj], h0, h1); st16(out + EPI_OFF(m, bj, Dm), pack8(h0 * ALPHA + acc[ai][bj][m][0], h1 * ALPHA + acc[ai][bj][m][1])); } }
    }
};
}
namespace pg8 {
struct GroupedOrder {
    static constexpr bool GATHER = true;
    const PG8_LAS unsigned* tp; const unsigned* list; int NT, G, c, shift;
    __device__ bool next(int i, Unit& u) const {
        const unsigned total = (unsigned)__builtin_amdgcn_readfirstlane((int)tp[32]) * (unsigned)NT; const unsigned L = (unsigned)i * (unsigned)G + (unsigned)c;
        if (L >= total) return false;
        const unsigned mt = L / (unsigned)NT; int e = 0;
#pragma unroll
        for (int j = 1; j < 32; ++j) e += (mt >= tp[j]) ? 1 : 0;
        e = __builtin_amdgcn_readfirstlane(e);
        u.e = e; u.pm = (int)mt - __builtin_amdgcn_readfirstlane((int)tp[e]); u.pn = (int)(L % (unsigned)NT); u.pnb = e * NT + u.pn; u.cnt = __builtin_amdgcn_readfirstlane((int)tp[33 + e]); return true;
    }
    __device__ __forceinline__ const unsigned* list_ptr(const Unit& u, int r) const { int rr = u.pm * BM + r; rr = rr < u.cnt ? rr : u.cnt - 1; return list + (size_t)u.e * T + rr; }
    __device__ __forceinline__ unsigned row_of(unsigned e) const { return e >> shift; }
};
}
namespace epi {
struct EpiMoeGU {
    static constexpr bool PERM = true;
    unsigned char* ws; const unsigned* list;
    DEV void operator()(const f32x4 (&acc)[2][2][4][2], const Unit& u, int wr, int wc, int fr, int fq) const {
        bf16* ACT = (bf16*)(ws + R_ACT);
        unsigned pp[2][4];
#pragma unroll
        for (int ai = 0; ai < 2; ++ai)
#pragma unroll
            for (int m = 0; m < 4; ++m) { int r = u.pm * 256 + ai * 128 + wr * 64 + m * 16 + fr; r = r < u.cnt ? r : u.cnt - 1; pp[ai][m] = list[(size_t)u.e * T + r]; }
#pragma unroll
        for (int ai = 0; ai < 2; ++ai)
#pragma unroll
            for (int m = 0; m < 4; ++m) { const int r = u.pm * 256 + ai * 128 + wr * 64 + m * 16 + fr;
                if (r < u.cnt) { const unsigned p = pp[ai][m];
#pragma unroll
                    for (int bj = 0; bj < 2; ++bj) { const int f0 = u.pn * 128 + bj * 64 + wc * 16 + 4 * fq; const f32x4 v0 = acc[ai][bj][m][0], v1 = acc[ai][bj][m][1];
                        const float a0 = v0[0] * fsig(v0[0]) * v0[1], a1 = v0[2] * fsig(v0[2]) * v0[3], a2 = v1[0] * fsig(v1[0]) * v1[1], a3 = v1[2] * fsig(v1[2]) * v1[3];
                        u32x2 w; w.x = cvt_pk_bf16(a0, a1); w.y = cvt_pk_bf16(a2, a3); *(u32x2*)(ACT + (size_t)p * 256 + f0) = w; } } }
    }
};
struct EpiMoeDN {
    static constexpr bool PERM = true;
    unsigned char* ws; const unsigned* list;
    DEV void operator()(const f32x4 (&acc)[2][2][4][2], const Unit& u, int wr, int wc, int fr, int fq) const {
        bf16* Y = (bf16*)(ws + R_Y); const float* TC = (const float*)(ws + RT_C);
        unsigned pp[2][4]; float cw[2][4];
#pragma unroll
        for (int ai = 0; ai < 2; ++ai)
#pragma unroll
            for (int m = 0; m < 4; ++m) { int r = u.pm * 256 + ai * 128 + wr * 64 + m * 16 + fr; r = r < u.cnt ? r : u.cnt - 1; pp[ai][m] = list[(size_t)u.e * T + r]; }
#pragma unroll
        for (int ai = 0; ai < 2; ++ai)
#pragma unroll
            for (int m = 0; m < 4; ++m) cw[ai][m] = TC[pp[ai][m]];
#pragma unroll
        for (int ai = 0; ai < 2; ++ai)
#pragma unroll
            for (int m = 0; m < 4; ++m) { const int r = u.pm * 256 + ai * 128 + wr * 64 + m * 16 + fr;
                if (r < u.cnt) { const unsigned p = pp[ai][m]; const float c = cw[ai][m];
#pragma unroll
                    for (int bj = 0; bj < 2; ++bj) { const int d0 = u.pn * 256 + bj * 128 + wc * 32 + 8 * fq;
                        st16(Y + (size_t)p * Dm + d0, pack8(acc[ai][bj][m][0] * c, acc[ai][bj][m][1] * c)); } } }
    }
};
}
#define GAS __attribute__((address_space(1)))
#define LAS __attribute__((address_space(3)))
constexpr int NWAVES = 8;
constexpr int RING_OFF = 0, RING_BYTES = 131072;
constexpr int LDSCTL_OFF = RING_BYTES, MISC_OFF = LDSCTL_OFF + 320, PARK_OFF = RING_BYTES + 1024;
constexpr int LDS_BYTES = 147456;
constexpr int CW_TMO = 0, CW_CODE = 1, CW_BAR = 4096;

#define XB_TMO      128
#define XB_XCNT(j)  (256  + 64 * (j))
#define XB_XSUB(j)  (1280 + 64 * (j))
#define XB_XGEN(j)  (2304 + 64 * (j))
#define XB_TOP      3328
#define XB_TOPGEN   3392
#define XCD_BAR_WORDS 3456
#define XB_SPIN_CAP (1u << 18)
__device__ __forceinline__ unsigned xb_ld(unsigned* p)              { return __hip_atomic_load(p, __ATOMIC_RELAXED, __HIP_MEMORY_SCOPE_AGENT); }
__device__ __forceinline__ unsigned xb_add(unsigned* p, unsigned v) { return __hip_atomic_fetch_add(p, v, __ATOMIC_RELAXED, __HIP_MEMORY_SCOPE_AGENT); }
__device__ __forceinline__ unsigned xb_xcc_id() { return (unsigned)__builtin_amdgcn_s_getreg((3 << 11) | 20) & 0xFu; }
#define XB_SPIN(cond, bar) do { unsigned _sp = 0; while (cond) { __builtin_amdgcn_s_sleep(1); \
    if ((++_sp & 255u) == 0u) { if (xb_ld(&(bar)[XB_TMO])) break; if (_sp > XB_SPIN_CAP) { atomicAdd(&(bar)[XB_TMO], 1u); break; } } } } while (0)
struct XcdBarrier { unsigned* bar; unsigned x; volatile LAS unsigned* st; };
__device__ __forceinline__ XcdBarrier xcd_barrier_post(unsigned* bar, volatile LAS unsigned* st, bool t0) {
    XcdBarrier b; b.bar = bar; b.x = xb_xcc_id(); b.st = st;
    if (t0) st[3] = xb_add(&bar[XB_XCNT(b.x)], 1u);
    return b;
}
__device__ __forceinline__ void xcd_barrier_complete(unsigned* bar, unsigned x, unsigned& nloc, unsigned& nx) {
    const unsigned G = gridDim.x * gridDim.y * gridDim.z;
    unsigned sum, cnt, mine, sp = 0u;
    for (;;) {
        sum = 0u; cnt = 0u; mine = 0u;
#pragma unroll
        for (unsigned j = 0; j < 16; ++j) { const unsigned c = xb_ld(&bar[XB_XCNT(j)]); sum += c; cnt += (c > 0u) ? 1u : 0u; mine = (j == x) ? c : mine; }
        if (sum == G) break;
        __builtin_amdgcn_s_sleep(1);
        if ((++sp & 255u) == 0u) { if (xb_ld(&bar[XB_TMO])) break; if (sp > XB_SPIN_CAP) { atomicAdd(&bar[XB_TMO], 1u); break; } }
    }
    nloc = mine > 0u ? mine : 1u; nx = cnt > 0u ? cnt : 1u;
}
__device__ __forceinline__ void xcd_barrier(const XcdBarrier& b, bool t0, bool local) {
    asm volatile("s_waitcnt vmcnt(0)" ::: "memory");
    __syncthreads();
    if (t0) {
        unsigned* bar = b.bar;
        __builtin_amdgcn_s_waitcnt(0);
        unsigned nloc = b.st[0], nx = b.st[1];
        if (nloc == 0u) { xcd_barrier_complete(bar, b.x, nloc, nx); b.st[0] = nloc; b.st[1] = nx;
            const unsigned G = gridDim.x; unsigned even = (nx == 8u && (G & 7u) == 0u) ? 1u : 0u;
#pragma unroll
            for (unsigned j = 0; j < 8; ++j) even &= (xb_ld(&bar[XB_XCNT(j)]) == G / 8u) ? 1u : 0u;
            b.st[2] = even;
            if (even) { const unsigned rk = b.st[3]; b.st[4] = rk * 8u + b.x; b.st[5] = b.x * (G / 8u) + rk; } }
        const unsigned old = xb_add(&bar[XB_XSUB(b.x)], 1u);
        const unsigned gen = old / nloc;
        if (old + 1u == (gen + 1u) * nloc) {
            if (!local) {
            __builtin_amdgcn_fence(__ATOMIC_RELEASE, "agent");
            asm volatile("s_waitcnt vmcnt(0)" ::: "memory");
            const unsigned og = xb_add(&bar[XB_TOP], 1u);
            const unsigned tg = og / nx;
            if (og + 1u == (tg + 1u) * nx) xb_add(&bar[XB_TOPGEN], 1u);
            else XB_SPIN(xb_ld(&bar[XB_TOPGEN]) == tg, bar);
            }
            __builtin_amdgcn_fence(__ATOMIC_ACQUIRE, "agent");
            xb_add(&bar[XB_XGEN(b.x)], 1u);
            asm volatile("s_waitcnt vmcnt(0)" ::: "memory");
        } else {
            XB_SPIN(xb_ld(&bar[XB_XGEN(b.x)]) == gen, bar);
            __builtin_amdgcn_fence(__ATOMIC_ACQUIRE, "agent");
            asm volatile("s_waitcnt vmcnt(0)" ::: "memory");
        }
    }
    __syncthreads();
}

struct Args { const float* in[27]; float* out; unsigned char* ws; int ph_lo, ph_hi, bar_id, pad; };
constexpr int NPL = 10, NPH = 1 + DEPTH * NPL;
enum { K_PROJ = 0, K_RETA = 1, K_RETB = 2, K_BRANCH = 3, K_S5B = 4, K_OUT = 5, K_LNROUTE = 6, K_MOEGU = 7, K_MOEDN = 8, K_LN2 = 9 };
namespace ph {
#define LDSW() asm volatile("s_waitcnt lgkmcnt(0)" ::: "memory")
DEV int lane_id(int wbase) { return pg8::fresh_tid(wbase) & 63; }
DEV unsigned pk2(float lo, float hi) { return (unsigned)f2bf(lo) | ((unsigned)f2bf(hi) << 16); }
DEV void transpose_item(const float* __restrict__ W, int K, int N, bf16* __restrict__ WT, int rmul, int radd, LAS float* scr, int item, int lane) {
    const int nblk = N / 32, kb = item / nblk, nb = item % nblk, k0 = 64 * kb, n0 = 32 * nb;
#pragma unroll 8
    for (int i = 0; i < 32; ++i) { const int kk = 2 * i + (lane >> 5); scr[kk * 33 + (lane & 31)] = W[(size_t)(k0 + kk) * N + n0 + (lane & 31)]; }
    LDSW(); asm volatile("" ::: "memory");
    const int c = lane & 7;
#pragma unroll
    for (int j = 0; j < 4; ++j) { const int n = (lane >> 3) + 8 * j; const LAS float* s = scr + (8 * c) * 33 + n;
        uint4 o; o.x = pk2(s[0 * 33], s[1 * 33]); o.y = pk2(s[2 * 33], s[3 * 33]); o.z = pk2(s[4 * 33], s[5 * 33]); o.w = pk2(s[6 * 33], s[7 * 33]);
        *(uint4*)(WT + (size_t)((n0 + n) * rmul + radd) * K + k0 + 8 * c) = o; }
    LDSW(); asm volatile("" ::: "memory");
}
DEV void ln_row(const float* pre, const bf16* preb, float scale, const bf16* y2, const float* __restrict__ g, const float* __restrict__ b, float* of, bf16* ob, int lane, float (&v)[16]) {
    float s = 0.f;
    if (pre) {
#pragma unroll
        for (int j = 0; j < 4; ++j) { const float4 x = *(const float4*)(pre + j * 256 + lane * 4); v[4 * j] = x.x * scale; v[4 * j + 1] = x.y * scale; v[4 * j + 2] = x.z * scale; v[4 * j + 3] = x.w * scale; }
    } else {
#pragma unroll
        for (int j = 0; j < 4; ++j) { const uint2 a = *(const uint2*)(preb + j * 256 + lane * 4);
            v[4 * j] = __uint_as_float(a.x << 16) * scale; v[4 * j + 1] = __uint_as_float(a.x & 0xffff0000u) * scale; v[4 * j + 2] = __uint_as_float(a.y << 16) * scale; v[4 * j + 3] = __uint_as_float(a.y & 0xffff0000u) * scale; }
    }
    if (y2) {
#pragma unroll
        for (int j = 0; j < 4; ++j) { const uint2 a = *(const uint2*)(y2 + j * 256 + lane * 4), c = *(const uint2*)(y2 + Dm + j * 256 + lane * 4);
            v[4 * j] += __uint_as_float(a.x << 16) + __uint_as_float(c.x << 16); v[4 * j + 1] += __uint_as_float(a.x & 0xffff0000u) + __uint_as_float(c.x & 0xffff0000u);
            v[4 * j + 2] += __uint_as_float(a.y << 16) + __uint_as_float(c.y << 16); v[4 * j + 3] += __uint_as_float(a.y & 0xffff0000u) + __uint_as_float(c.y & 0xffff0000u); }
    }
#pragma unroll
    for (int i = 0; i < 16; ++i) s += v[i];
    const float mean = wave_sum(s) * (1.f / Dm); float q = 0.f;
#pragma unroll
    for (int i = 0; i < 16; ++i) { v[i] -= mean; q += v[i] * v[i]; }
    const float rstd = rsqrtf(wave_sum(q) * (1.f / Dm) + LN_EPS);
#pragma unroll
    for (int j = 0; j < 4; ++j) { const float4 gg = *(const float4*)(g + j * 256 + lane * 4), bb = *(const float4*)(b + j * 256 + lane * 4);
        float4 o; o.x = v[4 * j] * rstd * gg.x + bb.x; o.y = v[4 * j + 1] * rstd * gg.y + bb.y; o.z = v[4 * j + 2] * rstd * gg.z + bb.z; o.w = v[4 * j + 3] * rstd * gg.w + bb.w;
        v[4 * j] = o.x; v[4 * j + 1] = o.y; v[4 * j + 2] = o.z; v[4 * j + 3] = o.w;
        if (of) *(float4*)(of + j * 256 + lane * 4) = o;
        uint2 w; w.x = pk2(o.x, o.y); w.y = pk2(o.z, o.w); *(uint2*)(ob + j * 256 + lane * 4) = w; }
}

struct ProIn { const float *x, *lng, *lnb, *w_in, *lam_re, *lam_im, *log_step, *b_re, *b_im, *c_re, *c_im, *w_glu, *w_bret, *w_bs5, *w_out, *w_rg, *w_re; float* out; };
DEV void prologue(const int wbase, LAS unsigned char* lds, unsigned char* ws, const ProIn P, int G, int vcu) {
    const int wave = wbase >> 6, lane = lane_id(wbase), tid = wbase + lane;
    LAS float* scr = (LAS float*)(lds + wave * 16384);
    const int gw = vcu * NWAVES + wave, NGW = G * NWAVES;
    constexpr int I_IN = (Dm / 64) * (INW / 32), I_GLU = (S5W / 64) * (S5W / 32), I_BRET = (RV / 64) * (Dm / 32), I_BS5 = (S5W / 64) * (Dm / 32), I_OUT = (Dm / 64) * (Dm / 32);
    constexpr int I_L = I_IN + I_GLU + I_BRET + I_BS5 + I_OUT;
    for (int it = gw; it < DEPTH * I_L; it += NGW) {
        const int l = it / I_L; int r = it % I_L;
        if (r < I_IN) { transpose_item(P.w_in + (size_t)l * Dm * INW, Dm, INW, (bf16*)(ws + W_IN) + (size_t)l * INW * Dm, 1, 0, scr, r, lane); continue; } r -= I_IN;
        if (r < I_GLU) { transpose_item(P.w_glu + (size_t)l * S5W * S5W, S5W, S5W, (bf16*)(ws + W_GLU) + (size_t)l * S5W * S5W, 1, 0, scr, r, lane); continue; } r -= I_GLU;
        if (r < I_BRET) { transpose_item(P.w_bret + (size_t)l * RV * Dm, RV, Dm, (bf16*)(ws + W_BRET) + (size_t)l * Dm * RV, 1, 0, scr, r, lane); continue; } r -= I_BRET;
        if (r < I_BS5) { transpose_item(P.w_bs5 + (size_t)l * S5W * Dm, S5W, Dm, (bf16*)(ws + W_BS5) + (size_t)l * Dm * S5W, 1, 0, scr, r, lane); continue; } r -= I_BS5;
        transpose_item(P.w_out + (size_t)l * Dm * Dm, Dm, Dm, (bf16*)(ws + W_OUT) + (size_t)l * Dm * Dm, 1, 0, scr, r, lane);
    }
    const int gt = vcu * (NWAVES * 64) + tid, NGT = G * NWAVES * 64;
    float* COS = (float*)(ws + TAB_COS); float* SIN = (float*)(ws + TAB_SIN); float* POWG = (float*)(ws + TAB_POWG);
    float* AB = (float*)(ws + TAB_AB); bf16* BBH = (bf16*)(ws + TAB_BBH); bf16* CTH = (bf16*)(ws + TAB_CTH); float* WRT = (float*)(ws + TAB_WRT);
    for (int gid = gt; gid < 2048 * 32; gid += NGT) { const int pos = gid >> 5, i = gid & 31; const float inv = exp2f(-(float)i * (13.287712379549449f / 32.0f)); const float ang = (float)pos * inv;
        COS[gid] = cosf(ang); SIN[gid] = sinf(ang); }
    for (int gid = gt; gid < 8 * 80; gid += NGT) { const int h = gid / 80, n = gid % 80; const float lg = log1pf(-exp2f(-5.0f - (float)h)); POWG[gid] = expf(lg * (float)n); }
    for (int gid = gt; gid < DEPTH * S5G * S5N; gid += NGT) {
        const int g = (gid / S5N) % S5G, l = gid / (S5G * S5N);
        float lr = P.lam_re[gid]; if (lr > -1e-4f) lr = -1e-4f; const float li = P.lam_im[gid];
        const float step = expf(P.log_step[l * S5G + g]);
        const float em1 = expm1f(lr * step), mag = em1 + 1.f, ang = li * step, cs = cosf(ang), sn = sinf(ang), sh = sinf(0.5f * ang);
        const float abr = mag * cs, abi = mag * sn;
        const float nre = em1 * cs - 2.f * sh * sh;
        const float den = lr * lr + li * li;
        const float zr = (nre * lr + abi * li) / den, zi = (abi * lr - nre * li) / den;
        AB[gid * 2] = abr; AB[gid * 2 + 1] = abi;
        const int n = gid % S5N, lg = gid / S5N;
        for (int c = 0; c < 16; ++c) { const float br = P.b_re[(size_t)gid * 16 + c], bi = P.b_im[(size_t)gid * 16 + c];
            BBH[((size_t)lg * 128 + n) * 16 + c] = f2bf(zr * br - zi * bi); BBH[((size_t)lg * 128 + 64 + n) * 16 + c] = f2bf(zr * bi + zi * br); }
    }
    for (int gid = gt; gid < DEPTH * S5G * 16 * 128; gid += NGT) { const int np = gid & 127, lgc = gid >> 7;
        CTH[gid] = f2bf(np < 64 ? P.c_re[(size_t)lgc * 64 + np] : -P.c_im[(size_t)lgc * 64 + np - 64]); }
    for (int gid = gt; gid < DEPTH * 36 * Dm; gid += NGT) { const int kk = gid % Dm, j = (gid / Dm) % 36, l = gid / (36 * Dm);
        WRT[gid] = j < 4 ? P.w_rg[((size_t)l * Dm + kk) * MG + j] : P.w_re[((size_t)l * Dm + kk) * NE + (j - 4)]; }
    { bf16* WRH = (bf16*)(ws + TAB_WRH); bf16* WRL = (bf16*)(ws + TAB_WRL);
      for (int gid = gt; gid < DEPTH * 48 * Dm; gid += NGT) { const int kk = gid % Dm, j = (gid / Dm) % 48, l = gid / (48 * Dm);
          const float w = j < 4 ? P.w_rg[((size_t)l * Dm + kk) * MG + j] : (j < 36 ? P.w_re[((size_t)l * Dm + kk) * NE + (j - 4)] : 0.f);
          const bf16 hi = f2bf(w); WRH[gid] = hi; WRL[gid] = f2bf(w - bf2f(hi)); } }
    float v[16];
    for (int m = gw; m < T; m += NGW) ln_row(P.x + (size_t)m * Dm, nullptr, 1.f, nullptr, P.lng, P.lnb, nullptr, (bf16*)(ws + WS_HBF) + (size_t)m * Dm, lane, v);
}

struct RouteIn { const float *lng, *lnb, *brg, *bre, *wg, *wu, *wd; };
DEV void phase_lnroute(const int wbase, LAS unsigned char* lds, unsigned char* ws, const RouteIn P, int layer, int G, int vcu) {
    const int wave = wbase >> 6, lane = lane_id(wbase);
    const int gw = vcu * NWAVES + wave, NGW = G * NWAVES;
    const bf16* preb = (const bf16*)(ws + WS_HB); bf16* ob = (bf16*)(ws + WS_HBF);
    const float* WRT = (const float*)(ws + TAB_WRT) + (size_t)layer * 36 * Dm;
    const float* brg = P.brg; const float* bre = P.bre;
    int* TE = (int*)(ws + RT_E); float* TC = (float*)(ws + RT_C); int* LIST = (int*)(ws + RT_LIST); unsigned* CNT = (unsigned*)(ws + WS_CNT) + layer * NE;
    typedef short bf16x8 __attribute__((ext_vector_type(8))); typedef float f32x4 __attribute__((ext_vector_type(4)));
    constexpr int AS = 2064, A_LO = 16 * AS, PL_OFF = 2 * 16 * AS, LG_OFF = PL_OFF + 8 * 16 * 48 * 4, RT_OFF = LG_OFF + 16 * 48 * 4, CAP = 128;
    LAS unsigned* lcnt = (LAS unsigned*)(lds + RT_OFF); LAS unsigned* gbase = lcnt + 32; LAS int* le1 = (LAS int*)(gbase + 32); LAS int* le2 = le1 + CAP;
    LAS unsigned* lr1 = (LAS unsigned*)(le2 + CAP); LAS unsigned* lr2 = lr1 + CAP; LAS float* lc1 = (LAS float*)(lr2 + CAP); LAS float* lc2 = lc1 + CAP; LAS int* lrow = (LAS int*)(lc2 + CAP);
    static_assert(RT_OFF + 64 * 4 + 7 * CAP * 4 <= RING_BYTES, "lnroute LDS");
    const int tid = wbase + lane, fr = lane & 15, fq = lane >> 4;
    bf16x8 bh[3][4], bl[3][4];
    { const bf16* WRH = (const bf16*)(ws + TAB_WRH) + (size_t)layer * 48 * Dm; const bf16* WRL = (const bf16*)(ws + TAB_WRL) + (size_t)layer * 48 * Dm;
#pragma unroll
      for (int nt = 0; nt < 3; ++nt)
#pragma unroll
          for (int ks = 0; ks < 4; ++ks) { const size_t o = (size_t)(16 * nt + fr) * Dm + wave * 128 + ks * 32 + 8 * fq; bh[nt][ks] = *(const bf16x8*)(WRH + o); bl[nt][ks] = *(const bf16x8*)(WRL + o); } }
    if (tid < 32) lcnt[tid] = 0u;
    int nent = 0;
    __syncthreads();
    const bool contig = ((T / 16) % G) == 0; const int nbw = contig ? (T / 16) / G : ((T / 16) + G - 1) / G;
    for (int ib = 0; ib < nbw; ++ib) { const int blk = contig ? vcu * nbw + ib : vcu + ib * G; if (blk >= T / 16) break;
#pragma unroll
        for (int jr = 0; jr < 2; ++jr) { const int lr = 2 * wave + jr, row = blk * 16 + lr;
            float v[16];
            ln_row(nullptr, preb + (size_t)row * Dm, 1.f, nullptr, P.lng, P.lnb, nullptr, ob + (size_t)row * Dm, lane, v);
#pragma unroll
            for (int j = 0; j < 4; ++j) { unsigned hw[2], lw[2];
#pragma unroll
                for (int e2 = 0; e2 < 2; ++e2) { const float x0 = v[4 * j + 2 * e2], x1 = v[4 * j + 2 * e2 + 1]; const bf16 h0 = f2bf(x0), h1 = f2bf(x1);
                    hw[e2] = (unsigned)h0 | ((unsigned)h1 << 16); lw[e2] = (unsigned)f2bf(x0 - bf2f(h0)) | ((unsigned)f2bf(x1 - bf2f(h1)) << 16); }
                *(LAS pg8::u32x2*)(lds + lr * AS + (j * 256 + lane * 4) * 2) = (pg8::u32x2){hw[0], hw[1]};
                *(LAS pg8::u32x2*)(lds + A_LO + lr * AS + (j * 256 + lane * 4) * 2) = (pg8::u32x2){lw[0], lw[1]}; } }
        __syncthreads();
        f32x4 acc[3];
#pragma unroll
        for (int nt = 0; nt < 3; ++nt) acc[nt] = (f32x4){0.f, 0.f, 0.f, 0.f};
#pragma unroll
        for (int ks = 0; ks < 4; ++ks) { const int ao = fr * AS + (wave * 128 + ks * 32 + 8 * fq) * 2;
            const bf16x8 ah = *(const LAS bf16x8*)(lds + ao), al = *(const LAS bf16x8*)(lds + A_LO + ao);
#pragma unroll
            for (int nt = 0; nt < 3; ++nt) { acc[nt] = __builtin_amdgcn_mfma_f32_16x16x32_bf16(ah, bh[nt][ks], acc[nt], 0, 0, 0);
                acc[nt] = __builtin_amdgcn_mfma_f32_16x16x32_bf16(al, bh[nt][ks], acc[nt], 0, 0, 0); acc[nt] = __builtin_amdgcn_mfma_f32_16x16x32_bf16(ah, bl[nt][ks], acc[nt], 0, 0, 0); } }
        { LAS float* PL = (LAS float*)(lds + PL_OFF) + wave * 16 * 48;
#pragma unroll
          for (int nt = 0; nt < 3; ++nt)
#pragma unroll
              for (int rg = 0; rg < 4; ++rg) PL[(4 * fq + rg) * 48 + 16 * nt + fr] = acc[nt][rg]; }
        __syncthreads();
        for (int idx = tid; idx < 16 * 48; idx += NWAVES * 64) { const LAS float* PL = (const LAS float*)(lds + PL_OFF) + idx; float s = 0.f;
#pragma unroll
            for (int w = 0; w < 8; ++w) s += PL[w * 16 * 48];
            ((LAS float*)(lds + LG_OFF))[idx] = s; }
        __syncthreads();
        if (tid < 16) { const LAS float* LG = (const LAS float*)(lds + LG_OFF) + tid * 48; const int row = blk * 16 + tid;
            float lg[4];
#pragma unroll
            for (int kk = 0; kk < 4; ++kk) lg[kk] = LG[kk] + brg[kk];
            int gi = 0; float gm = lg[0];
#pragma unroll
            for (int kk = 1; kk < 4; ++kk) if (lg[kk] > gm) { gm = lg[kk]; gi = kk; }
            float den = 0.f;
#pragma unroll
            for (int kk = 0; kk < 4; ++kk) den += __expf(lg[kk] - gm);
            const float gtop = 1.f / den;
            int i1 = 0, i2 = 0; float m1 = -INFINITY, m2 = -INFINITY;
            for (int kk = 0; kk < 8; ++kk) { const float x = LG[4 + gi * 8 + kk] + bre[gi * 8 + kk];
                if (x > m1) { m2 = m1; i2 = i1; m1 = x; i1 = kk; } else if (x > m2) { m2 = x; i2 = kk; } }
            const float p2 = __expf(m2 - m1);
            const float w1 = 1.f / (1.f + p2), w2 = p2 / (1.f + p2);
            const int e1 = gi * 8 + i1, e2 = gi * 8 + i2, li = nent + tid;
            le1[li] = e1; le2[li] = e2; lc1[li] = gtop * w1; lc2[li] = gtop * w2; lrow[li] = row;
            lr1[li] = __hip_atomic_fetch_add(lcnt + e1, 1u, __ATOMIC_RELAXED, __HIP_MEMORY_SCOPE_WORKGROUP); lr2[li] = __hip_atomic_fetch_add(lcnt + e2, 1u, __ATOMIC_RELAXED, __HIP_MEMORY_SCOPE_WORKGROUP); }
        nent += 16;
        const bool last = (ib + 1 >= nbw) || (!contig && blk + G >= T / 16);
        if (nent == CAP || last) {
            __syncthreads();
            if (tid < 32) { const unsigned c = lcnt[tid]; gbase[tid] = c ? atomicAdd(&CNT[tid], c) : 0u; }
            __syncthreads();
            if (tid < nent) { const int row = lrow[tid], e1 = le1[tid], e2 = le2[tid];
                TE[row * 2] = e1; TE[row * 2 + 1] = e2; TC[row * 2] = lc1[tid]; TC[row * 2 + 1] = lc2[tid];
                LIST[(size_t)e1 * T + gbase[e1] + lr1[tid]] = row * 2; LIST[(size_t)e2 * T + gbase[e2] + lr2[tid]] = row * 2 + 1; }
            __syncthreads();
            if (tid < 32) lcnt[tid] = 0u;
            nent = 0;
        }
        __syncthreads();
    }
    LAS float* scr = (LAS float*)(lds + wave * 16384);
    constexpr int I_G = (Dm / 64) * (FF / 32);
    for (int it = gw; it < NE * 2 * I_G; it += NGW) {
        const int e = it / (2 * I_G); int r = it % (2 * I_G);
        if (r < I_G) { transpose_item(P.wg + (size_t)e * Dm * FF, Dm, FF, (bf16*)(ws + R_WGU) + (size_t)e * 512 * Dm, 2, 0, scr, r, lane); continue; } r -= I_G;
        transpose_item(P.wu + (size_t)e * Dm * FF, Dm, FF, (bf16*)(ws + R_WGU) + (size_t)e * 512 * Dm, 2, 1, scr, r, lane);
    }
}
DEV void phase_ln2(const int wbase, unsigned char* ws, const float* lng, const float* lnb, float* out, int G, int vcu) {
    const int wave = wbase >> 6, lane = lane_id(wbase);
    const int gw = vcu * NWAVES + wave, NGW = G * NWAVES;
    float v[16];
    for (int row = gw; row < T; row += NGW)
        ln_row(nullptr, (const bf16*)(ws + WS_HBF) + (size_t)row * Dm, ALPHA, (const bf16*)(ws + R_Y) + (size_t)(2 * row) * Dm, lng, lnb, out ? out + (size_t)row * Dm : nullptr, (bf16*)(ws + WS_HBF) + (size_t)row * Dm, lane, v);
}
}

namespace ret {
typedef short bf16x8 __attribute__((ext_vector_type(8)));
typedef short s16x4 __attribute__((ext_vector_type(4)));
typedef float f32x16 __attribute__((ext_vector_type(16)));
typedef float f32x4 __attribute__((ext_vector_type(4)));
typedef float f32x2_t __attribute__((ext_vector_type(2))); typedef __bf16 bf16x2_t __attribute__((ext_vector_type(2)));
DEV unsigned cvtpk(float lo, float hi) { f32x2_t v = {lo, hi}; bf16x2_t b = __builtin_convertvector(v, bf16x2_t); return __builtin_bit_cast(unsigned, b); }
#define RMFMA(a, b, c) __builtin_amdgcn_mfma_f32_32x32x16_bf16((a), (b), (c), 0, 0, 0)
constexpr int LS = 72;
constexpr int L_KR = 0, L_QR = 9216, L_KDT = 18432, L_VT = 27648, L_ST = 46080, L_O = 64512, OS = 132, L_END = L_O + 64 * OS * 4;
static_assert(L_END <= RING_BYTES, "retention LDS");
constexpr int SEGC = 8, NSEG = NCH / SEGC;
DEV int crow(int reg, int h) { return (reg & 3) + 8 * (reg >> 2) + 4 * h; }
DEV float bflo(unsigned w) { return __uint_as_float(w << 16); }
DEV float bfhi(unsigned w) { return __uint_as_float(w & 0xffff0000u); }

struct Raw { uint2 k1, k2, q1, q2; float4 cs, sn; uint4 v0, v1; };
template <bool WITH_Q> DEV void load_raw(Raw& R, const unsigned char* ws, int row0, int pos0, int h, int tid) {
    const int j = tid >> 3, c0 = (tid & 7) * 4;
    const bf16* K = (const bf16*)(ws + R_K) + (size_t)(row0 + j) * 512 + h * 64 + c0;
    R.k1 = *(const uint2*)K; R.k2 = *(const uint2*)(K + 32);
    if (WITH_Q) { const bf16* Q = (const bf16*)(ws + R_Q) + (size_t)(row0 + j) * 512 + h * 64 + c0; R.q1 = *(const uint2*)Q; R.q2 = *(const uint2*)(Q + 32); }
    R.cs = *(const float4*)((const float*)(ws + TAB_COS) + (pos0 + j) * 32 + c0); R.sn = *(const float4*)((const float*)(ws + TAB_SIN) + (pos0 + j) * 32 + c0);
    const bf16* V = (const bf16*)(ws + R_V) + (size_t)(row0 + j) * 1024 + h * 128 + (tid & 7) * 16;
    R.v0 = *(const uint4*)V; R.v1 = *(const uint4*)(V + 8);
}
DEV void rot4(const uint2 x1, const uint2 x2, const float4 cs, const float4 sn, float (&r1)[4], float (&r2)[4]) {
    const float a[4] = {bflo(x1.x), bfhi(x1.x), bflo(x1.y), bfhi(x1.y)}, b[4] = {bflo(x2.x), bfhi(x2.x), bflo(x2.y), bfhi(x2.y)};
    const float c[4] = {cs.x, cs.y, cs.z, cs.w}, s[4] = {sn.x, sn.y, sn.z, sn.w};
#pragma unroll
    for (int e = 0; e < 4; ++e) { r1[e] = a[e] * c[e] - b[e] * s[e]; r2[e] = a[e] * s[e] + b[e] * c[e]; }
}
template <bool WITH_Q> DEV void stage(LAS unsigned char* lds, const Raw& R, int tid, float kd) {
    const int j = tid >> 3, c0 = (tid & 7) * 4;
    float r1[4], r2[4];
    rot4(R.k1, R.k2, R.cs, R.sn, r1, r2);
    if (WITH_Q) { LAS bf16* kr = (LAS bf16*)(lds + L_KR) + j * LS + c0;
        *(LAS pg8::u32x2*)kr = (pg8::u32x2){cvtpk(r1[0], r1[1]), cvtpk(r1[2], r1[3])}; *(LAS pg8::u32x2*)(kr + 32) = (pg8::u32x2){cvtpk(r2[0], r2[1]), cvtpk(r2[2], r2[3])}; }
    LAS bf16* kdt = (LAS bf16*)(lds + L_KDT) + c0 * LS + j;
#pragma unroll
    for (int e = 0; e < 4; ++e) { kdt[e * LS] = f2bf(r1[e] * kd); kdt[(32 + e) * LS] = f2bf(r2[e] * kd); }
    if (WITH_Q) { rot4(R.q1, R.q2, R.cs, R.sn, r1, r2); LAS bf16* qr = (LAS bf16*)(lds + L_QR) + j * LS + c0;
        *(LAS pg8::u32x2*)qr = (pg8::u32x2){cvtpk(r1[0], r1[1]), cvtpk(r1[2], r1[3])}; *(LAS pg8::u32x2*)(qr + 32) = (pg8::u32x2){cvtpk(r2[0], r2[1]), cvtpk(r2[2], r2[3])}; }
    LAS bf16* vt = (LAS bf16*)(lds + L_VT) + ((tid & 7) * 16) * LS + j;
    const unsigned vw[8] = {R.v0.x, R.v0.y, R.v0.z, R.v0.w, R.v1.x, R.v1.y, R.v1.z, R.v1.w};
#pragma unroll
    for (int e = 0; e < 8; ++e) { vt[(2 * e) * LS] = (bf16)(vw[e] & 0xffffu); vt[(2 * e + 1) * LS] = (bf16)(vw[e] >> 16); }
}
DEV bf16x8 ld8(const LAS bf16* p) { return *(const LAS bf16x8*)p; }
DEV void state_update(f32x16& ST, const LAS unsigned char* lds, int wi, int wd, int r, int hh, float cd) {
#pragma unroll
    for (int e = 0; e < 16; ++e) ST[e] *= cd;
    const LAS bf16* a = (const LAS bf16*)(lds + L_KDT) + (32 * wi + r) * LS + 8 * hh; const LAS bf16* b = (const LAS bf16*)(lds + L_VT) + (32 * wd + r) * LS + 8 * hh;
#pragma unroll
    for (int s = 0; s < 4; ++s) ST = RMFMA(ld8(a + 16 * s), ld8(b + 16 * s), ST);
}

DEV void phase_a(const int wbase, LAS unsigned char* lds, unsigned char* ws, int G, int vcu) {
    const int wave = wbase >> 6, tid = pg8::fresh_tid(wbase), lane = tid & 63, r = lane & 31, hh = lane >> 5, wi = wave >> 2, wd = wave & 3;
    for (int item = vcu; item < BATCH * RH * NSEG; item += G) {
        const int seg = item % NSEG, h = (item / NSEG) % RH, b = item / (NSEG * RH);
        const float lg2g = log1pf(-__builtin_amdgcn_exp2f(-5.0f - (float)h)) * 1.4426950408889634f, cd = __builtin_amdgcn_exp2f(64.f * lg2g);
        f32x16 ST;
#pragma unroll
        for (int e = 0; e < 16; ++e) ST[e] = 0.f;
        const float kdj = __builtin_amdgcn_exp2f((float)(63 - (tid >> 3)) * lg2g);
        Raw R; load_raw<false>(R, ws, b * SEQ + seg * SEGC * CHUNK, seg * SEGC * CHUNK, h, tid);
#pragma nounroll
        for (int n = 0; n < SEGC; ++n) {
            __syncthreads();
            stage<false>(lds, R, tid, kdj);
            __syncthreads();
            if (n + 1 < SEGC) load_raw<false>(R, ws, b * SEQ + (seg * SEGC + n + 1) * CHUNK, (seg * SEGC + n + 1) * CHUNK, h, tid);
            state_update(ST, lds, wi, wd, r, hh, cd);
        }
        float* TOT = (float*)(ws + WS_HB) + (size_t)item * 8192 + wave * 1024 + lane;
#pragma unroll
        for (int e = 0; e < 16; ++e) TOT[e * 64] = ST[e];
    }
    __syncthreads();
}
DEV void phase_b(const int wbase, LAS unsigned char* lds, unsigned char* ws, int G, int vcu) {
    const int wave = wbase >> 6, tid = pg8::fresh_tid(wbase), lane = tid & 63, r = lane & 31, hh = lane >> 5, wi = wave >> 2, wd = wave & 3;
    for (int item = vcu; item < BATCH * RH * NSEG; item += G) {
        const int seg = item % NSEG, h = (item / NSEG) % RH, b = item / (NSEG * RH);
        const float lg2g = log1pf(-__builtin_amdgcn_exp2f(-5.0f - (float)h)) * 1.4426950408889634f, cd = __builtin_amdgcn_exp2f(64.f * lg2g), cd8 = __builtin_amdgcn_exp2f(64.f * SEGC * lg2g);
        f32x16 ST;
#pragma unroll
        for (int e = 0; e < 16; ++e) ST[e] = 0.f;
#pragma nounroll
        for (int s = 0; s < seg; ++s) { const float* TOT = (const float*)(ws + WS_HB) + (size_t)(item - seg + s) * 8192 + wave * 1024 + lane;
#pragma unroll
            for (int e = 0; e < 16; ++e) ST[e] = cd8 * ST[e] + TOT[e * 64]; }
        const float kdj = __builtin_amdgcn_exp2f((float)(63 - (tid >> 3)) * lg2g);
        Raw R; load_raw<true>(R, ws, b * SEQ + seg * SEGC * CHUNK, seg * SEGC * CHUNK, h, tid);
        float mk0[16], mk1[16], qdec[16];
        { const int lq = pg8::fresh_tid(wbase) & 63, iq = 32 * wi + (lq & 31), hq = lq >> 5;
#pragma unroll
          for (int e = 0; e < 16; ++e) { const int j0 = crow(e, hq), d0 = iq > j0 ? iq - j0 : j0 - iq, d1 = iq > j0 + 32 ? iq - j0 - 32 : j0 + 32 - iq;
              mk0[e] = __builtin_amdgcn_exp2f((float)d0 * lg2g); mk1[e] = __builtin_amdgcn_exp2f((float)d1 * lg2g); qdec[e] = __builtin_amdgcn_exp2f((float)(32 * wi + j0 + 1) * lg2g); } }
#pragma nounroll
        for (int n = 0; n < SEGC; ++n) {
            const int row0 = b * SEQ + (seg * SEGC + n) * CHUNK;
            stage<true>(lds, R, tid, kdj);
            { LAS bf16* st = (LAS bf16*)(lds + L_ST) + (32 * wd + r) * LS + 32 * wi + 4 * hh;
#pragma unroll
              for (int g4 = 0; g4 < 4; ++g4) *(LAS pg8::u32x2*)(st + 8 * g4) = (pg8::u32x2){cvtpk(ST[4 * g4], ST[4 * g4 + 1]), cvtpk(ST[4 * g4 + 2], ST[4 * g4 + 3])}; }
            __syncthreads();
            if (n + 1 < SEGC) load_raw<true>(R, ws, row0 + CHUNK, (seg * SEGC + n + 1) * CHUNK, h, tid);
            const bf16* Gp = (const bf16*)(ws + R_G) + (size_t)(row0 + (tid >> 3)) * 1024 + h * 128 + (tid & 7) * 16;
            const uint4 g0 = *(const uint4*)Gp, g1 = *(const uint4*)(Gp + 8);
            f32x16 X0, X1;
#pragma unroll
            for (int e = 0; e < 16; ++e) { X0[e] = 0.f; X1[e] = 0.f; }
            const LAS bf16* kr = (const LAS bf16*)(lds + L_KR) + r * LS + 8 * hh; const LAS bf16* qr = (const LAS bf16*)(lds + L_QR) + (32 * wi + r) * LS + 8 * hh;
#pragma unroll
            for (int s = 0; s < 4; ++s) { const bf16x8 qb = ld8(qr + 16 * s); X0 = RMFMA(ld8(kr + 16 * s), qb, X0); X1 = RMFMA(ld8(kr + 32 * LS + 16 * s), qb, X1); }
#pragma unroll
            for (int e = 0; e < 16; ++e) { X0[e] *= mk0[e]; X1[e] *= mk1[e]; }
            f32x16 O;
#pragma unroll
            for (int e = 0; e < 16; ++e) O[e] = 0.f;
            const LAS bf16* stb = (const LAS bf16*)(lds + L_ST) + (32 * wd + r) * LS + 8 * hh;
#pragma unroll
            for (int s = 0; s < 4; ++s) O = RMFMA(ld8(qr + 16 * s), ld8(stb + 16 * s), O);
#pragma unroll
            for (int e = 0; e < 16; ++e) O[e] *= qdec[e];
            const LAS bf16* vt = (const LAS bf16*)(lds + L_VT) + (32 * wd + r) * LS + 4 * hh;
#pragma unroll
            for (int s = 0; s < 2; ++s) {
                bf16x8 pa, pb;
                { const unsigned w0 = cvtpk(X0[8 * s], X0[8 * s + 1]), w1 = cvtpk(X0[8 * s + 2], X0[8 * s + 3]), w2 = cvtpk(X0[8 * s + 4], X0[8 * s + 5]), w3 = cvtpk(X0[8 * s + 6], X0[8 * s + 7]);
                  const pg8::u32x4 p = {w0, w1, w2, w3}; pa = __builtin_bit_cast(bf16x8, p); }
                { const unsigned w0 = cvtpk(X1[8 * s], X1[8 * s + 1]), w1 = cvtpk(X1[8 * s + 2], X1[8 * s + 3]), w2 = cvtpk(X1[8 * s + 4], X1[8 * s + 5]), w3 = cvtpk(X1[8 * s + 6], X1[8 * s + 7]);
                  const pg8::u32x4 p = {w0, w1, w2, w3}; pb = __builtin_bit_cast(bf16x8, p); }
                const s16x4 a0 = *(const LAS s16x4*)(vt + 16 * s), a1 = *(const LAS s16x4*)(vt + 16 * s + 8), b0 = *(const LAS s16x4*)(vt + 32 + 16 * s), b1 = *(const LAS s16x4*)(vt + 32 + 16 * s + 8);
                O = RMFMA(pa, __builtin_shufflevector(a0, a1, 0, 1, 2, 3, 4, 5, 6, 7), O);
                O = RMFMA(pb, __builtin_shufflevector(b0, b1, 0, 1, 2, 3, 4, 5, 6, 7), O);
            }
            state_update(ST, lds, wi, wd, r, hh, cd);
            { LAS float* ob = (LAS float*)(lds + L_O) + (32 * wi + 4 * hh) * OS + 32 * wd + r;
#pragma unroll
              for (int e = 0; e < 16; ++e) ob[((e & 3) + 8 * (e >> 2)) * OS] = O[e]; }
            __syncthreads();
            { const int i = tid >> 3, c0 = (tid & 7) * 16; const LAS float* orow = (const LAS float*)(lds + L_O) + i * OS + c0;
              float o[16];
#pragma unroll
              for (int q4 = 0; q4 < 4; ++q4) { const f32x4 t4 = *(const LAS f32x4*)(orow + 4 * q4); o[4 * q4] = t4[0]; o[4 * q4 + 1] = t4[1]; o[4 * q4 + 2] = t4[2]; o[4 * q4 + 3] = t4[3]; }
              float sm = 0.f;
#pragma unroll
              for (int c = 0; c < 16; ++c) sm += o[c];
              sm += xshfl<1>(sm); sm += xshfl<2>(sm); sm += xshfl<4>(sm);
              const float mean = sm * (1.f / 128.f); float qq = 0.f;
#pragma unroll
              for (int c = 0; c < 16; ++c) { o[c] -= mean; qq += o[c] * o[c]; }
              qq += xshfl<1>(qq); qq += xshfl<2>(qq); qq += xshfl<4>(qq);
              const float rstd = rsqrtf(qq * (1.f / 128.f) + HN_EPS);
              const unsigned gw[8] = {g0.x, g0.y, g0.z, g0.w, g1.x, g1.y, g1.z, g1.w}; unsigned ow[8];
#pragma unroll
              for (int e = 0; e < 8; ++e) ow[e] = cvtpk(bflo(gw[e]) * o[2 * e] * rstd, bfhi(gw[e]) * o[2 * e + 1] * rstd);
              bf16* Ap = (bf16*)(ws + R_V) + (size_t)(row0 + i) * 1024 + h * 128 + c0;
              *(uint4*)Ap = make_uint4(ow[0], ow[1], ow[2], ow[3]); *(uint4*)(Ap + 8) = make_uint4(ow[4], ow[5], ow[6], ow[7]); }
        }
    }
    __syncthreads();
}
}

namespace s5 {
using ret::bf16x8; using ret::s16x4; using ret::f32x16; using ret::cvtpk; using ret::crow;
typedef short v4i16_t __attribute__((ext_vector_type(4)));
DEV s16x4 trr(const LAS unsigned char* p) { return __builtin_bit_cast(s16x4, __builtin_amdgcn_ds_read_tr16_b64_v4i16((LAS v4i16_t*)p)); }
struct Cx { float x, y; };
DEV Cx cmul(Cx a, Cx b) { return {a.x * b.x - a.y * b.y, a.x * b.y + a.y * b.x}; }
DEV Cx cfma(Cx a, Cx b, Cx c) { return {a.x * b.x - a.y * b.y + c.x, a.x * b.y + a.y * b.x + c.y}; }
DEV float shx32(float v) { return xshfl<32>(v); }

constexpr int SC = 4, NSG = NCH / SC;
template <bool OUT> DEV void pass(const int wbase, LAS unsigned char* lds, unsigned char* ws, const float* __restrict__ dsk, int layer, int G, int vcu) {
    const int wave = wbase >> 6;
    LAS unsigned char* img = lds + wave * 8192;
    bf16* U = (bf16*)(ws + R_U);
    for (int wi = vcu; wi < BATCH * NSG * (S5G / 8); wi += G) {
        const int lane = pg8::fresh_tid(wbase) & 63, r = lane & 31, hh = lane >> 5;
        const int oct = wi % (S5G / 8), sg = (wi / (S5G / 8)) % NSG, b = wi / ((S5G / 8) * NSG), g = oct * 8 + wave, lg = layer * S5G + g;
        const bf16* BBH = (const bf16*)(ws + TAB_BBH) + (size_t)lg * 128 * 16;
        bf16x8 bbf[4];
#pragma unroll
        for (int nt = 0; nt < 4; ++nt) bbf[nt] = *(const bf16x8*)(BBH + (32 * nt + r) * 16 + 8 * hh);
        Cx a1q[2], c[2];
#pragma unroll
        for (int q = 0; q < 2; ++q) {
            const float2 av = *(const float2*)((const float*)(ws + TAB_AB) + ((size_t)lg * S5N + 32 * q + r) * 2);
            a1q[q] = Cx{av.x, av.y}; c[q] = Cx{0.f, 0.f};
            if (OUT) { Cx ap = a1q[q];
#pragma unroll
                for (int sq = 0; sq < 8; ++sq) ap = cmul(ap, ap);
                const float2* E = (const float2*)(ws + WS_S5E) + ((size_t)(b * NSG) * S5G + g) * S5N + 32 * q + r;
                float2 ev[NSG - 1];
#pragma unroll
                for (int s = 0; s < NSG - 1; ++s) ev[s] = E[(size_t)s * S5G * S5N];
#pragma unroll
                for (int s = 0; s < NSG - 1; ++s) if (s < sg) c[q] = cfma(ap, c[q], Cx{ev[s].x, ev[s].y}); }
        }
        bf16x8 bd; LAS bf16x8* ctl = (LAS bf16x8*)(lds + 65536 + wave * 8192) + lane;
        if (OUT) { const bf16* CTH = (const bf16*)(ws + TAB_CTH) + ((size_t)lg * 16 + (r & 15)) * 128 + 8 * hh;
#pragma unroll
            for (int nt = 0; nt < 4; ++nt)
#pragma unroll
                for (int s = 0; s < 2; ++s) ctl[(nt * 2 + s) * 64] = *(const bf16x8*)(CTH + 32 * nt + 16 * s);
            const float dval = dsk[layer * 512 + g * 16 + (r & 15)];
#pragma unroll
            for (int e = 0; e < 8; ++e) bd[e] = (short)(((r & 15) == 8 * hh + e) ? f2bf(dval) : (bf16)0); }
        const int i16 = lane & 15, q4 = i16 >> 2, p4 = i16 & 3, blk = (lane >> 4) & 1;
        const int rowS = b * SEQ + sg * SC * 64;
        bf16x8 un[2];
#pragma unroll
        for (int th = 0; th < 2; ++th) un[th] = *(const bf16x8*)(U + (size_t)(rowS + 32 * th + r) * 512 + g * 16 + 8 * hh);
#pragma nounroll
        for (int jc = 0; jc < SC; ++jc) {
            const int row0 = rowS + jc * 64;
            bf16x8 ua[2]; ua[0] = un[0]; ua[1] = un[1];
            if (jc + 1 < SC) {
#pragma unroll
                for (int th = 0; th < 2; ++th) un[th] = *(const bf16x8*)(U + (size_t)(row0 + 64 + 32 * th + r) * 512 + g * 16 + 8 * hh); }
#pragma unroll
            for (int th = 0; th < 2; ++th) {
                f32x16 BU[4];
#pragma unroll
                for (int nt = 0; nt < 4; ++nt) { f32x16 z;
#pragma unroll
                    for (int e = 0; e < 16; ++e) z[e] = 0.f;
                    BU[nt] = RMFMA(ua[th], bbf[nt], z); }
#pragma unroll
                for (int q = 0; q < 2; ++q) {
                    const Cx a1 = a1q[q], a2 = cmul(a1, a1), a3 = cmul(a2, a1), a4 = cmul(a2, a2);
                    Cx cc = c[q];
#pragma unroll
                    for (int qb = 0; qb < 4; ++qb) {
                        f32x16& RE = BU[q]; f32x16& IM = BU[2 + q];
                        Cx x = {RE[4 * qb], IM[4 * qb]};
#pragma unroll
                        for (int i = 1; i < 4; ++i) x = cfma(a1, x, Cx{RE[4 * qb + i], IM[4 * qb + i]});
                        const Cx px = {shx32(x.x), shx32(x.y)};
                        const Cx g0 = hh ? px : x, g1 = hh ? x : px;
                        const Cx c0 = cc; cc = cfma(a4, cc, g0); const Cx c1 = cc; cc = cfma(a4, cc, g1);
                        if (OUT) { Cx hx = hh ? c1 : c0;
#pragma unroll
                            for (int i = 0; i < 4; ++i) { hx = cfma(a1, hx, Cx{RE[4 * qb + i], IM[4 * qb + i]}); RE[4 * qb + i] = hx.x; IM[4 * qb + i] = hx.y; } }
                    }
                    c[q] = cc;
                }
                if (OUT) {
                    asm volatile("s_waitcnt lgkmcnt(0)" ::: "memory");
#pragma unroll
                    for (int nt = 0; nt < 4; ++nt)
#pragma unroll
                        for (int g4 = 0; g4 < 4; ++g4) { const f32x16& X = BU[nt];
                            *(LAS pg8::u32x2*)(img + nt * 2048 + r * 64 + 8 * (2 * g4 + hh)) = (pg8::u32x2){cvtpk(X[4 * g4], X[4 * g4 + 1]), cvtpk(X[4 * g4 + 2], X[4 * g4 + 3])}; }
                    asm volatile("s_waitcnt lgkmcnt(0)" ::: "memory");
                    f32x16 Y;
#pragma unroll
                    for (int e = 0; e < 16; ++e) Y[e] = 0.f;
#pragma unroll
                    for (int nt = 0; nt < 4; ++nt)
#pragma unroll
                        for (int s = 0; s < 2; ++s) {
                            const s16x4 lo = trr(img + nt * 2048 + (16 * s + 8 * hh + q4) * 64 + 8 * (4 * blk + p4));
                            const s16x4 hi = trr(img + nt * 2048 + (16 * s + 8 * hh + 4 + q4) * 64 + 8 * (4 * blk + p4));
                            const bf16x8 xa = __builtin_shufflevector(lo, hi, 0, 1, 2, 3, 4, 5, 6, 7);
                            Y = RMFMA(xa, ctl[(nt * 2 + s) * 64], Y);
                        }
                    Y = RMFMA(ua[th], bd, Y);
                    { const int up = r >> 4;
#pragma unroll
                      for (int e = 0; e < 8; ++e) { const float yv = up ? Y[8 + e] : Y[e]; const float u3 = yv * yv * yv;
                          const float zz = yv * __builtin_amdgcn_rcpf(1.f + __expf(-1.5957691216057308f * (yv + 0.044715f * u3)));
                          U[(size_t)(row0 + 32 * th + (e & 3) + 8 * ((e >> 2) + 2 * up) + 4 * hh) * 512 + g * 16 + (r & 15)] = f2bf(zz); } }
                }
            }
        }
        if (!OUT) {
            if (hh == 0) { float2* E = (float2*)(ws + WS_S5E) + ((size_t)(b * NSG + sg) * S5G + g) * S5N + r;
                E[0] = make_float2(c[0].x, c[0].y); E[32] = make_float2(c[1].x, c[1].y); }
        }
    }
    asm volatile("s_waitcnt lgkmcnt(0)" ::: "memory");
    __syncthreads();
}
}

__global__ void __launch_bounds__(NWAVES * 64, 2) mk_fwd(Args args_k) {
    extern __shared__ __attribute__((aligned(16))) unsigned char lds_raw[];
    LAS unsigned char* lds = (LAS unsigned char*)lds_raw;
    volatile LAS unsigned* MISC = (volatile LAS unsigned*)(lds + MISC_OFF);
    const int wbase = __builtin_amdgcn_readfirstlane((int)threadIdx.x) & ~63;
    const int G = gridDim.x;
    unsigned* ctl = (unsigned*)(args_k.ws + WS_CTL);
    { const int tid = pg8::fresh_tid(wbase); for (int u = tid; u < (LDS_BYTES - LDSCTL_OFF) / 4; u += NWAVES * 64) ((LAS unsigned*)(lds + LDSCTL_OFF))[u] = 0u; }
    __syncthreads();
    if (pg8::fresh_tid(wbase) == 0) { const unsigned b0 = blockIdx.x; MISC[8 + 4] = b0; MISC[8 + 5] = (G % 8 == 0) ? (b0 % 8u) * (unsigned)(G / 8) + b0 / 8u : b0; }
    __syncthreads();
    if ((args_k.ph_hi - args_k.ph_lo) > 1) (void)xcd_barrier_post(ctl + CW_BAR + args_k.bar_id * XCD_BAR_WORDS, MISC + 8, pg8::fresh_tid(wbase) == 0);
    const int ph_lo = args_k.ph_lo, ph_hi = args_k.ph_hi;
    bool rep_done = false; (void)rep_done;
    for (int ph = ph_lo; ph < ph_hi; ++ph) {
        const int l = ph > 0 ? (ph - 1) / NPL : 0, k = ph > 0 ? (ph - 1) % NPL : -1;
        unsigned moff = MISC_OFF + 32; asm volatile("" : "+s"(moff));
        const volatile LAS unsigned* MS = (const volatile LAS unsigned*)(lds + moff);
        const bool lok = __builtin_amdgcn_readfirstlane((int)MS[2]) != 0;
        const int bx = __builtin_amdgcn_readfirstlane((int)MS[4]), vcu = __builtin_amdgcn_readfirstlane((int)MS[5]);
        const __attribute__((address_space(4))) Args* ap = (const __attribute__((address_space(4))) Args*)__builtin_amdgcn_kernarg_segment_ptr(); asm volatile("" : "+s"(ap));
        const Args& args = *(const Args*)ap;
        unsigned char* ws = ap->ws;
        float* hA = ap->out; float* hB = (float*)(ws + WS_HB); bf16* hbf = (bf16*)(ws + WS_HBF);
        switch (k) {
        case -1: { ph::ProIn P{args.in[0], args.in[1], args.in[2], args.in[3], args.in[4], args.in[5], args.in[6], args.in[7], args.in[8], args.in[9], args.in[10], args.in[12], args.in[13], args.in[14], args.in[15], args.in[18], args.in[20], args.out};
            ph::prologue(wbase, lds, ws, P, G, vcu); } break;
        case K_PROJ: {
            pg8::Gemm g{hbf, (const bf16*)(ws + W_IN) + (size_t)l * INW * Dm, Dm}; pg8::StaticOrder S; S.init(T, INW, Dm, G, bx);
            epi::EpiProj E{ws}; pg8::gemm_phase<Dm, epi::EpiProj, pg8::StaticOrder, true>(wbase, lds + RING_OFF, lds + PARK_OFF, g, S, E); } break;
        case K_RETA: ret::phase_a(wbase, lds, ws, G, vcu); s5::pass<false>(wbase, lds, ws, nullptr, l, G, vcu); break;
        case K_RETB: ret::phase_b(wbase, lds, ws, G, vcu); s5::pass<true>(wbase, lds, ws, ap->in[11], l, G, vcu); break;
        case K_BRANCH: {
            { pg8::Gemm g{(const bf16*)(ws + R_V), (const bf16*)(ws + W_BRET) + (size_t)l * Dm * RV, RV}; pg8::StaticOrder S; S.init(T, Dm, RV, G, bx);
              epi::EpiRet E{ws}; pg8::gemm_phase<RV, epi::EpiRet, pg8::StaticOrder, true>(wbase, lds + RING_OFF, lds + PARK_OFF, g, S, E); }
            { pg8::Gemm g{(const bf16*)(ws + R_U), (const bf16*)(ws + W_GLU) + (size_t)l * S5W * S5W, S5W}; pg8::StaticOrder S; S.init(T, S5W, S5W, G, bx);
              epi::EpiGlu E{ws}; pg8::gemm_phase<S5W, epi::EpiGlu, pg8::StaticOrder, true>(wbase, lds + RING_OFF, lds + PARK_OFF, g, S, E); } } break;
        case K_S5B: {
            pg8::Gemm g{(const bf16*)(ws + R_S5IN), (const bf16*)(ws + W_BS5) + (size_t)l * Dm * S5W, S5W}; pg8::StaticOrder S; S.init(T, Dm, S5W, G, bx);
            epi::EpiS5b E{ws}; pg8::gemm_phase<S5W, epi::EpiS5b, pg8::StaticOrder, true>(wbase, lds + RING_OFF, lds + PARK_OFF, g, S, E); } break;
        case K_OUT: {
            pg8::Gemm g{(const bf16*)(ws + R_G), (const bf16*)(ws + W_OUT) + (size_t)l * Dm * Dm, Dm}; pg8::StaticOrder S; S.init(T, Dm, Dm, G, bx);
            epi::EpiOut E{hbf, (bf16*)hB}; pg8::gemm_phase<Dm, epi::EpiOut, pg8::StaticOrder, true>(wbase, lds + RING_OFF, lds + PARK_OFF, g, S, E); } break;
        case K_LNROUTE: { ph::RouteIn P{args.in[16] + l * Dm, args.in[17] + l * Dm, args.in[19] + l * MG, args.in[21] + l * NE, args.in[22] + (size_t)l * NE * Dm * FF, args.in[23] + (size_t)l * NE * Dm * FF, args.in[24] + (size_t)l * NE * FF * Dm};
            ph::phase_lnroute(wbase, lds, ws, P, l, G, vcu); } break;
        case K_MOEGU: case K_MOEDN: {
            LAS unsigned* tp = (LAS unsigned*)(lds + LDSCTL_OFF + 512);
            const int tid = pg8::fresh_tid(wbase);
            if (tid < 32) tp[33 + tid] = __hip_atomic_load((unsigned*)(ws + WS_CNT) + l * NE + tid, __ATOMIC_RELAXED, __HIP_MEMORY_SCOPE_AGENT);
            __syncthreads();
            if (tid == 0) { unsigned a = 0; for (int j = 0; j < 32; ++j) { tp[j] = a; a += (tp[33 + j] + 255u) >> 8; } tp[32] = a; }
            __syncthreads();
            const unsigned* LIST = (const unsigned*)(ws + RT_LIST);
            if (k == K_MOEGU) {
                pg8::Gemm g{hbf, (const bf16*)(ws + R_WGU), Dm}; pg8::GroupedOrder S{tp, LIST, 2, G, bx, 1};
                epi::EpiMoeGU E{ws, LIST}; pg8::gemm_phase<Dm, epi::EpiMoeGU, pg8::GroupedOrder, true>(wbase, lds + RING_OFF, lds + PARK_OFF, g, S, E);
                { const int U = 2 * __builtin_amdgcn_readfirstlane((int)tp[32]), R2 = U > G ? (U - G < G ? U - G : G) : 0, W1 = G - R2;
                  if (W1 > 0 && bx >= R2) { const int lane = pg8::fresh_tid(wbase) & 63, wv = wbase >> 6; LAS float* scr = (LAS float*)(lds + wv * 16384); constexpr int I_D = (FF / 64) * (Dm / 32);
                      const float* wd = ap->in[24] + (size_t)l * NE * FF * Dm;
                      for (int it = (bx - R2) * NWAVES + wv; it < NE * I_D; it += W1 * NWAVES) { const int e = it / I_D, r = it % I_D;
                          ph::transpose_item(wd + (size_t)e * FF * Dm, FF, Dm, (bf16*)(ws + R_WDN) + (size_t)e * Dm * FF, 1, 0, scr, r, lane); } }
                  else if (W1 <= 0) { const int lane = pg8::fresh_tid(wbase) & 63, wv = wbase >> 6; LAS float* scr = (LAS float*)(lds + wv * 16384); constexpr int I_D = (FF / 64) * (Dm / 32);
                      const float* wd = ap->in[24] + (size_t)l * NE * FF * Dm;
                      for (int it = bx * NWAVES + wv; it < NE * I_D; it += G * NWAVES) { const int e = it / I_D, r = it % I_D;
                          ph::transpose_item(wd + (size_t)e * FF * Dm, FF, Dm, (bf16*)(ws + R_WDN) + (size_t)e * Dm * FF, 1, 0, scr, r, lane); } }
                  __syncthreads(); }
            } else {
                pg8::Gemm g{(const bf16*)(ws + R_ACT), (const bf16*)(ws + R_WDN), FF}; pg8::GroupedOrder S{tp, LIST, 4, G, bx, 0};
                epi::EpiMoeDN E{ws, LIST}; pg8::gemm_phase<FF, epi::EpiMoeDN, pg8::GroupedOrder, true>(wbase, lds + RING_OFF, lds + PARK_OFF, g, S, E);
            } } break;
        case K_LN2: ph::phase_ln2(wbase, ws, args.in[25] + l * Dm, args.in[26] + l * Dm, l == DEPTH - 1 ? args.out : nullptr, G, vcu); break;
        default: break;
        }
#ifdef PROBE_REP_MASK
        if (((k >= 0 && ((PROBE_REP_MASK >> k) & 1)) || (k < 0 && (PROBE_REP_MASK & 0x8000))) && !rep_done) { rep_done = true; --ph; } else rep_done = false;
#endif
        if (ph + 1 < ph_hi) { XcdBarrier bar; bar.bar = (unsigned*)(ws + WS_CTL) + CW_BAR + ap->bar_id * XCD_BAR_WORDS; bar.x = xb_xcc_id(); bar.st = (volatile LAS unsigned*)(lds + MISC_OFF) + 8;
            const bool local = lok && (k == K_PROJ || k == K_RETA || k == K_RETB || k == K_BRANCH || k == K_S5B || k == K_OUT);
            xcd_barrier(bar, pg8::fresh_tid(wbase) == 0, local); }
    }
}
#ifndef MK_ONE_LAUNCH
#define MK_ONE_LAUNCH 1
#endif
static int g_grid = 0;
static void launch_mk(const Args& base, int lo, int hi, int bar_id, hipStream_t stream) {
    Args a = base; a.ph_lo = lo; a.ph_hi = hi; a.bar_id = bar_id;
    hipLaunchKernelGGL(mk_fwd, dim3(g_grid), dim3(NWAVES * 64), LDS_BYTES, stream, a);
}
extern "C" void kernel_launch(void* const* d_in, const int* in_sizes, int n_in, void* d_out, int out_size, void* d_ws, size_t ws_size, hipStream_t stream) {
    static int ok = 0;
    if (ok == 0) {
        if (n_in != 27 || in_sizes[0] != T * Dm || out_size != T * Dm || ws_size < WS_END) { fprintf(stderr, "kernel_launch: unexpected shapes/ws (%d, %d, %d, %zu < %zu)\n", n_in, n_in > 0 ? in_sizes[0] : -1, out_size, ws_size, (size_t)WS_END); ok = -1; return; }
        int dev = 0, cus = 0;
        if (hipGetDevice(&dev) != hipSuccess || hipDeviceGetAttribute(&cus, hipDeviceAttributeMultiprocessorCount, dev) != hipSuccess) { fprintf(stderr, "kernel_launch: device query failed\n"); ok = -1; return; }
        if (hipFuncSetAttribute((const void*)mk_fwd, hipFuncAttributeMaxDynamicSharedMemorySize, LDS_BYTES) != hipSuccess) { fprintf(stderr, "kernel_launch: LDS attribute failed\n"); ok = -1; return; }
        g_grid = cus;
        ok = 1;
    }
    if (ok < 0) return;
    unsigned char* ws = (unsigned char*)d_ws;
    const float* const* in = (const float* const*)d_in;
    float* hA = (float*)d_out;
    (void)hipMemsetAsync(ws + WS_CTL, 0, 1 * MiB, stream);
    Args base{}; for (int i = 0; i < 27; ++i) base.in[i] = in[i]; base.out = hA; base.ws = ws;
#if MK_ONE_LAUNCH
    launch_mk(base, 0, NPH, 0, stream);
#else
    for (int p = 0; p < NPH; ++p) launch_mk(base, p, p + 1, 0, stream);
#endif
}
```

```cpp
#include <hip/hip_runtime.h>
#include <cstdio>
#include <cstdint>
#include <cmath>

typedef unsigned short bf16;
#define DEV __device__ __forceinline__

constexpr int Dm = 1024, BATCH = 8, SEQ = 2048, T = BATCH * SEQ, DEPTH = 2;
constexpr int CHUNK = 64, NCH = SEQ / CHUNK;
constexpr int RH = 8, RQK = 512, RV = 1024, DK = 64, DV = 128;
constexpr int S5W = 512, S5G = 32, S5GC = 16, S5N = 64;
constexpr int MG = 4, EPG = 8, NE = 32, FF = 256;
constexpr int INW = 5632;
constexpr float LN_EPS = 1e-5f, HN_EPS = 1e-6f;
constexpr float ALPHA = 1.41421356237309515f;

constexpr size_t MiB = 1u << 20;
constexpr size_t WS_CTL = 0;
constexpr size_t WS_CNT = 64 * 1024;
constexpr size_t WS_TAB = 1 * MiB;
constexpr size_t TAB_COS = WS_TAB;
constexpr size_t TAB_SIN = TAB_COS + 2048 * 32 * 4;
constexpr size_t TAB_POWG = TAB_SIN + 2048 * 32 * 4;
constexpr size_t TAB_AB = TAB_POWG + 8 * 80 * 4;
constexpr size_t TAB_BBH = TAB_AB + DEPTH * S5G * S5N * 2 * 4;
constexpr size_t TAB_CTH = TAB_BBH + (size_t)DEPTH * S5G * 128 * 16 * 2;
constexpr size_t TAB_WRT = TAB_CTH + (size_t)DEPTH * S5G * 16 * 128 * 2;
constexpr size_t TAB_WRH = TAB_WRT + (size_t)DEPTH * 36 * Dm * 4;
constexpr size_t TAB_WRL = TAB_WRH + (size_t)DEPTH * 48 * Dm * 2;
constexpr size_t TAB_END = TAB_WRL + (size_t)DEPTH * 48 * Dm * 2;
static_assert(TAB_END <= 3 * MiB, "tables");
constexpr size_t WS_S5E = 3 * MiB;
constexpr size_t WS_ROUTE = 7 * MiB;
constexpr size_t RT_E = WS_ROUTE, RT_C = RT_E + (size_t)T * 2 * 4, RT_LIST = RT_C + (size_t)T * 2 * 4;
static_assert(RT_LIST + (size_t)NE * T * 4 <= 10 * MiB, "route");
constexpr size_t WS_WSM = 10 * MiB;
constexpr size_t W_IN = WS_WSM;
constexpr size_t W_GLU = W_IN + (size_t)DEPTH * INW * Dm * 2;
constexpr size_t W_BRET = W_GLU + (size_t)DEPTH * S5W * S5W * 2;
constexpr size_t W_BS5 = W_BRET + (size_t)DEPTH * Dm * RV * 2;
constexpr size_t W_OUT = W_BS5 + (size_t)DEPTH * Dm * S5W * 2;
constexpr size_t W_END = W_OUT + (size_t)DEPTH * Dm * Dm * 2;
static_assert(W_END <= 44 * MiB, "small weights");
constexpr size_t WS_HB = 44 * MiB;
constexpr size_t WS_HBF = 108 * MiB;
constexpr size_t WS_R1 = 140 * MiB;
constexpr size_t R_Q = WS_R1, R_K = R_Q + 16 * MiB, R_U = R_K + 16 * MiB, R_GR = R_U + 16 * MiB, R_GS = R_GR + 32 * MiB;
constexpr size_t WS_R2 = 252 * MiB;
constexpr size_t R_V = WS_R2, R_G = R_V + 32 * MiB;
constexpr size_t WS_END = 316 * MiB;
constexpr size_t R_S5IN = R_Q;
constexpr size_t R_WGU = WS_R1;
constexpr size_t R_WDN = WS_R1 + 32 * MiB;
constexpr size_t R_ACT = WS_R1 + 48 * MiB;
constexpr size_t R_Y = WS_R2;

DEV float bf2f(bf16 v) { return __uint_as_float((unsigned)v << 16); }
DEV bf16 f2bf(float f) { unsigned u = __float_as_uint(f); return (bf16)((u + 0x7fffu + ((u >> 16) & 1u)) >> 16); }
DEV float sigmoidf_(float x) { return 1.f / (1.f + __expf(-x)); }
DEV float siluf_(float x) { return x * sigmoidf_(x); }
DEV float geluf_(float x) { const float c = 0.7978845608028654f; float t = tanhf(c * (x + 0.044715f * x * x * x)); return 0.5f * x * (1.f + t); }
template <int M> DEV float xshfl(float v) {
    if constexpr (M < 32) return __int_as_float(__builtin_amdgcn_ds_swizzle(__float_as_int(v), 0x1f | (M << 10)));
    else { const unsigned u = __float_as_uint(v); auto rr = __builtin_amdgcn_permlane32_swap(u, u, false, false);
           const bool hi = (__builtin_amdgcn_mbcnt_hi(~0u, __builtin_amdgcn_mbcnt_lo(~0u, 0u)) >= 32u); return __uint_as_float(hi ? rr[0] : rr[1]); }
}
template <int CTRL> DEV float dpp_add(float v) { return v + __int_as_float(__builtin_amdgcn_update_dpp(0, __float_as_int(v), CTRL, 0xf, 0xf, true)); }
DEV float wave_sum(float v) {
    v = dpp_add<0xB1>(v); v = dpp_add<0x4E>(v); v = dpp_add<0x141>(v); v = dpp_add<0x140>(v); v += xshfl<16>(v); v += xshfl<32>(v);
    return v;
}

namespace pg8 {
#define PG8_LAS __attribute__((address_space(3)))
typedef unsigned short bf16_t;
typedef short bf16x8 __attribute__((ext_vector_type(8)));
typedef float f32x4 __attribute__((ext_vector_type(4)));
typedef unsigned u32x4 __attribute__((ext_vector_type(4)));
typedef unsigned u32x2 __attribute__((ext_vector_type(2)));
typedef float f32x2 __attribute__((ext_vector_type(2)));
constexpr int BM = 256, BK = 64, HALF = 128, HTB = HALF * BK * 2  , STAGE_BYTES = 8 * HTB, NXCD = 8, WGM = 8;

__host__ __device__ __forceinline__ int lds_byte(int r, int c) { const int st = (r >> 4) * 2 + (c >> 5), rr = r & 15, cc = c & 31, ob = rr * 64 + cc * 2; return st * 1024 + (ob ^ (((ob >> 9) & 1) << 5)); }
__host__ __device__ __forceinline__ void stage_rc(int b, int& R, int& C) { const int st = b / 1024, sb = b % 1024, swz = sb ^ (((sb >> 9) & 1) << 5); R = (st >> 1) * 16 + swz / 64; C = (st & 1) * 32 + (swz % 64) / 2; }
__host__ __device__ __forceinline__ int perm32(int rho) { const int n = rho >> 4, i = rho & 15; return 8 * (i >> 2) + 4 * n + (i & 3); }

struct Unit { int pm, pn, pnb, e, cnt; };
struct Gemm { const bf16_t* A; const bf16_t* Bt; int K; };

struct StaticOrder {
    int nM, nN, nwg, G, c, K;
    __device__ void init(int M, int N, int K_, int G_, int c_) { nM = M / BM; nN = N / BM; nwg = nM * nN; G = G_; c = c_; K = K_; }
    __device__ bool next(int i, Unit& u) const {
        const long L = (long)i * G + c; if (L >= nwg) return false;
        int wgid = (int)L; { const int q = nwg / NXCD, r = nwg % NXCD, xcd = wgid % NXCD, off = wgid / NXCD; wgid = (xcd < r ? xcd * (q + 1) : r * (q + 1) + (xcd - r) * q) + off; }
        const int nig = WGM * nN, gid = wgid / nig, fm = gid * WGM, gsz = (nM - fm) < WGM ? (nM - fm) : WGM;
        u.pm = fm + ((wgid % nig) % gsz); u.pn = (wgid % nig) / gsz; u.pnb = u.pn; u.e = 0; u.cnt = 0; return true;
    }
    static constexpr bool GATHER = false;
    __device__ __forceinline__ const unsigned* list_ptr(const Unit&, int) const { return nullptr; }
    __device__ __forceinline__ unsigned row_of(unsigned e) const { return e; }
};

__device__ __forceinline__ unsigned cvt_pk_bf16(float lo, float hi) { unsigned r; asm volatile("v_cvt_pk_bf16_f32 %0, %1, %2" : "=v"(r) : "v"(lo), "v"(hi)); return r; }

__device__ __forceinline__ int fresh_tid(int wbase) { int t = wbase + (int)__builtin_amdgcn_mbcnt_hi(~0u, __builtin_amdgcn_mbcnt_lo(~0u, 0u)); asm volatile("" : "+v"(t)); return t; }
template <int K, class Epi, class Sched, bool ALIGN_EPI = false>
__device__ __forceinline__ void gemm_phase(const int wbase, PG8_LAS unsigned char* lds, PG8_LAS unsigned char* park, const Gemm g, const Sched& S, const Epi& E) {
    constexpr bool GA = Sched::GATHER;
    const int wid = wbase >> 6, wr = wid >> 2, wc = wid & 3;
    const int tid = fresh_tid(wbase);
    constexpr int nt = K / BK; static_assert(K % 128 == 0 && K >= 256, "K");
    unsigned voffA[2], voffB[2];
#pragma unroll
    for (int i = 0; i < 2; ++i) { int R, C; stage_rc(tid * 16 + i * 8192, R, C); const int Rb = Epi::PERM ? ((R & ~31) + perm32(R & 31)) : R;
        voffA[i] = (unsigned)(R * K + C) * 2u; voffB[i] = (unsigned)(Rb * K + C) * 2u; }
#define PG8_RC(i, R, C) int R, C; stage_rc(fresh_tid(wbase) * 16 + (i) * 8192, R, C)
    const int kstep = BK * 2;
    const int hstep = HALF * K * 2;
    const int tstep = 2 * hstep;
    const __amdgpu_buffer_rsrc_t rsA = __builtin_amdgcn_make_buffer_rsrc((void*)g.A, 0, 0x7fffffff, 0x00020000);
    const __amdgpu_buffer_rsrc_t rsB = __builtin_amdgcn_make_buffer_rsrc((void*)g.Bt, 0, 0x7fffffff, 0x00020000);
    const unsigned ldsw = (unsigned)wid * 1024u;
    const int aoff = lds_byte(wr * 64 + (tid & 15), ((tid & 63) >> 4) * 8), boff = lds_byte(wc * 32 + (tid & 15), ((tid & 63) >> 4) * 8);
#define PG8_SA(b, h) (((b) * 2 + (h)) * HTB)
#define PG8_SB(b, h) ((4 + (b) * 2 + (h)) * HTB)
#define PG8_STAGE(bufoff, rs, voff, so) do { _Pragma("unroll") for (int _i = 0; _i < 2; ++_i) \
        __builtin_amdgcn_raw_ptr_buffer_load_lds(rs, (PG8_LAS void*)(lds + (bufoff) + ldsw + _i * 8192), 16, (int)(voff)[_i], (int)(so), 0, 0); } while (0)
#define PG8_STAGE_B(bufoff, so) PG8_STAGE(bufoff, rsB, voffB, so)
#define PG8_STAGE_A(bufoff, h, kb) do { if constexpr (GA) { if ((h) == 0) PG8_STAGE(bufoff, rsA, ao0, kb); else PG8_STAGE(bufoff, rsA, ao1, kb); } else { PG8_STAGE(bufoff, rsA, voffA, (kb) + (h) * hstep); } } while (0)
#define PG8_LDA(dst, b, h) do { _Pragma("unroll") for (int m = 0; m < 4; ++m) _Pragma("unroll") for (int k = 0; k < 2; ++k) dst[m][k] = *(const PG8_LAS bf16x8*)(lds + PG8_SA(b, h) + aoff + m * 2048 + k * 1024); } while (0)
#define PG8_LDB(dst, b, h) do { _Pragma("unroll") for (int n = 0; n < 2; ++n) _Pragma("unroll") for (int k = 0; k < 2; ++k) dst[n][k] = *(const PG8_LAS bf16x8*)(lds + PG8_SB(b, h) + boff + n * 2048 + k * 1024); } while (0)
#define PG8_MMA(ai, bj, At, Bt) do { __builtin_amdgcn_s_setprio(1); _Pragma("unroll") for (int m = 0; m < 4; ++m) _Pragma("unroll") for (int n = 0; n < 2; ++n) _Pragma("unroll") for (int k = 0; k < 2; ++k) \
        acc[ai][bj][m][n] = __builtin_amdgcn_mfma_f32_16x16x32_bf16(Bt[n][k], At[m][k], acc[ai][bj][m][n], 0, 0, 0); __builtin_amdgcn_s_setprio(0); } while (0)
#define PG8_WAIT_V(n) asm volatile("s_waitcnt vmcnt(" #n ")" ::: "memory")
#define PG8_WAIT_L(n) asm volatile("s_waitcnt lgkmcnt(" #n ")" ::: "memory")
#define PG8_BAR __builtin_amdgcn_s_barrier()
#define PG8_SCHED __builtin_amdgcn_sched_barrier(0)
    Unit cur, nxt; int ui = 0;
    if (!S.next(0, cur)) return;
    f32x4 acc[2][2][4][2];
#pragma unroll
    for (int a = 0; a < 2; ++a)
#pragma unroll
        for (int b = 0; b < 2; ++b)
#pragma unroll
            for (int m = 0; m < 4; ++m)
#pragma unroll
                for (int n = 0; n < 2; ++n) acc[a][b][m][n] = (f32x4){0.f, 0.f, 0.f, 0.f};
    bf16x8 At[4][2], B0[2][2], B1[2][2];
    unsigned ao0[2] = {0u, 0u}, ao1[2] = {0u, 0u};
    if constexpr (GA) {
#pragma unroll
        for (int i = 0; i < 2; ++i) { PG8_RC(i, R, C); ao0[i] = (S.row_of(*S.list_ptr(cur, R)) * (unsigned)K + (unsigned)C) * 2u; ao1[i] = (S.row_of(*S.list_ptr(cur, HALF + R)) * (unsigned)K + (unsigned)C) * 2u; }
    }
    int cA = GA ? 0 : cur.pm * tstep;
    int cB = cur.pnb * tstep;
    PG8_STAGE_B(PG8_SB(0, 0), cB); PG8_STAGE_B(PG8_SB(0, 1), cB + hstep); PG8_STAGE_A(PG8_SA(0, 0), 0, cA); PG8_STAGE_A(PG8_SA(0, 1), 1, cA);
    if (wr == 1) PG8_BAR;
    PG8_WAIT_V(2); PG8_BAR;
    PG8_STAGE_B(PG8_SB(1, 0), cB + kstep); PG8_STAGE_A(PG8_SA(1, 0), 0, cA + kstep); PG8_STAGE_B(PG8_SB(1, 1), cB + hstep + kstep);
    PG8_WAIT_V(6); PG8_BAR;
    for (;;) {
        const bool has_next = S.next(ui + 1, nxt);
        const int nA = (GA || !has_next) ? cA : nxt.pm * tstep; const int nB = has_next ? nxt.pnb * tstep : cB;
        if constexpr (GA) { if (has_next) {
#pragma unroll
            for (int s = 0; s < 4; ++s) { PG8_RC(s & 1, R, C); (void)C; __builtin_amdgcn_global_load_lds(S.list_ptr(nxt, (s >> 1) * HALF + R), (PG8_LAS unsigned*)(park + s * 2048 + wid * 256), 4, 0, 0); } } }
#define PG8_TRIP(LASTT) do { \
            const int a1 = cA + (t + 1) * kstep; \
            PG8_LDB(B0, 0, 0); PG8_LDB(B1, 0, 1); PG8_SCHED; PG8_LDA(At, 0, 0); PG8_STAGE_A(PG8_SA(1, 1), 1, a1); \
            if constexpr (GA && (LASTT)) { if (has_next) { _Pragma("unroll") for (int i = 0; i < 2; ++i) { PG8_RC(i, R, C); (void)R; const int t4 = fresh_tid(wbase) * 4; \
                ao0[i] = (S.row_of(*(const PG8_LAS unsigned*)(park + (0 + i) * 2048 + t4)) * (unsigned)K + (unsigned)C) * 2u; \
                ao1[i] = (S.row_of(*(const PG8_LAS unsigned*)(park + (2 + i) * 2048 + t4)) * (unsigned)K + (unsigned)C) * 2u; } } } \
            const int a2 = (LASTT) ? nA : cA + (t + 2) * kstep; const int b2 = (LASTT) ? nB : cB + (t + 2) * kstep; \
            const int a3 = a2 + kstep; const int b3 = b2 + kstep; \
            PG8_WAIT_V(8); PG8_WAIT_L(0); PG8_BAR; PG8_MMA(0, 0, At, B0); PG8_MMA(0, 1, At, B1); PG8_BAR; PG8_SCHED; \
            PG8_LDA(At, 0, 1); PG8_STAGE_B(PG8_SB(0, 0), b2); PG8_STAGE_B(PG8_SB(0, 1), b2 + hstep); PG8_STAGE_A(PG8_SA(0, 0), 0, a2); \
            PG8_WAIT_V(8); PG8_WAIT_L(0); PG8_BAR; PG8_MMA(1, 0, At, B0); PG8_MMA(1, 1, At, B1); PG8_BAR; PG8_SCHED; \
            PG8_LDB(B0, 1, 0); PG8_LDB(B1, 1, 1); PG8_SCHED; PG8_LDA(At, 1, 0); PG8_STAGE_A(PG8_SA(0, 1), 1, a2); \
            PG8_WAIT_V(8); PG8_WAIT_L(0); PG8_BAR; PG8_MMA(0, 0, At, B0); PG8_MMA(0, 1, At, B1); PG8_BAR; PG8_SCHED; \
            PG8_LDA(At, 1, 1); PG8_STAGE_B(PG8_SB(1, 0), b3); PG8_STAGE_B(PG8_SB(1, 1), b3 + hstep); PG8_STAGE_A(PG8_SA(1, 0), 0, a3); \
            PG8_WAIT_V(8); PG8_WAIT_L(0); PG8_BAR; PG8_MMA(1, 0, At, B0); PG8_MMA(1, 1, At, B1); PG8_BAR; PG8_SCHED; \
        } while (0)
        int t = 0; int ntm = nt - 2; asm volatile("" : "+s"(ntm));
        for (; t < ntm; t += 2) PG8_TRIP(false);
        PG8_TRIP(true);
#undef PG8_TRIP
        if constexpr (ALIGN_EPI) { if (wr == 0) PG8_BAR; }
        { const int te = fresh_tid(wbase); E(acc, cur, wr, wc, te & 15, (te & 63) >> 4); }
        if (!has_next) break;
#pragma unroll
        for (int a = 0; a < 2; ++a)
#pragma unroll
            for (int b = 0; b < 2; ++b)
#pragma unroll
                for (int m = 0; m < 4; ++m)
#pragma unroll
                    for (int n = 0; n < 2; ++n) acc[a][b][m][n] = (f32x4){0.f, 0.f, 0.f, 0.f};
        cur = nxt; cA = nA; cB = nB; ++ui;
        if constexpr (ALIGN_EPI) { if (wr == 1) PG8_BAR; }
    }
    PG8_WAIT_V(0);
    if constexpr (!ALIGN_EPI) { if (wr == 0) PG8_BAR; }
    PG8_BAR;
#undef PG8_SA
#undef PG8_SB
#undef PG8_STAGE
#undef PG8_STAGE_A
#undef PG8_STAGE_B
#undef PG8_RC
#undef PG8_LDA
#undef PG8_LDB
#undef PG8_MMA
#undef PG8_WAIT_V
#undef PG8_WAIT_L
#undef PG8_BAR
#undef PG8_SCHED
}
}
namespace epi {
using pg8::f32x4; using pg8::u32x4; using pg8::u32x2; using pg8::Unit; using pg8::cvt_pk_bf16;
DEV float fsig(float x) { return __builtin_amdgcn_rcpf(1.f + __expf(-x)); }
DEV void st16(void* p, const u32x4 v) { asm volatile("global_store_dwordx4 %0, %1, off sc1\n\ts_nop 1" :: "v"(p), "v"(v) : "memory"); }
DEV u32x4 pack8(const f32x4 a, const f32x4 b) { u32x4 w; w.x = cvt_pk_bf16(a[0], a[1]); w.y = cvt_pk_bf16(a[2], a[3]); w.z = cvt_pk_bf16(b[0], b[1]); w.w = cvt_pk_bf16(b[2], b[3]); return w; }
DEV void unpack8(const u32x4 w, f32x4& a, f32x4& b) {
    a[0] = __uint_as_float(w.x << 16); a[1] = __uint_as_float(w.x & 0xffff0000u); a[2] = __uint_as_float(w.y << 16); a[3] = __uint_as_float(w.y & 0xffff0000u);
    b[0] = __uint_as_float(w.z << 16); b[1] = __uint_as_float(w.z & 0xffff0000u); b[2] = __uint_as_float(w.w << 16); b[3] = __uint_as_float(w.w & 0xffff0000u); }
#define EPI_FOR8(...) _Pragma("unroll") for (int ai = 0; ai < 2; ++ai) _Pragma("unroll") for (int m = 0; m < 4; ++m) _Pragma("unroll") for (int bj = 0; bj < 2; ++bj) { \
        const int row = u.pm * 256 + ai * 128 + wr * 64 + m * 16 + fr; const int ct = bj * 128 + wc * 32 + 8 * fq; f32x4 v0 = acc[ai][bj][m][0], v1 = acc[ai][bj][m][1]; __VA_ARGS__ }

struct EpiProj {
    static constexpr bool PERM = true;
    unsigned char* ws;
    DEV void operator()(const f32x4 (&acc)[2][2][4][2], const Unit& u, int wr, int wc, int fr, int fq) const {
        const int pn = u.pn; bf16* base; int ld, c0, act; float sc = 1.f;
        if (pn < 2) { base = (bf16*)(ws + R_Q); ld = 512; c0 = pn * 256; act = 0; }
        else if (pn < 4) { base = (bf16*)(ws + R_K); ld = 512; c0 = (pn - 2) * 256; act = 0; sc = 0.125f; }
        else if (pn < 8) { base = (bf16*)(ws + R_V); ld = 1024; c0 = (pn - 4) * 256; act = 0; }
        else if (pn < 12) { base = (bf16*)(ws + R_G); ld = 1024; c0 = (pn - 8) * 256; act = 1; }
        else if (pn < 14) { base = (bf16*)(ws + R_U); ld = 512; c0 = (pn - 12) * 256; act = 0; }
        else if (pn < 18) { base = (bf16*)(ws + R_GR); ld = 1024; c0 = (pn - 14) * 256; act = 2; }
        else { base = (bf16*)(ws + R_GS); ld = 1024; c0 = (pn - 18) * 256; act = 2; }
        EPI_FOR8(
            if (act == 1) { _Pragma("unroll") for (int j = 0; j < 4; ++j) { v0[j] = v0[j] * fsig(v0[j]); v1[j] = v1[j] * fsig(v1[j]); } }
            else if (act == 2) { _Pragma("unroll") for (int j = 0; j < 4; ++j) { v0[j] = fsig(v0[j]); v1[j] = fsig(v1[j]); } }
            else { v0 = v0 * sc; v1 = v1 * sc; }
            st16(base + (size_t)row * ld + c0 + ct, pack8(v0, v1)); )
    }
};
#define EPI_OFF(m, bj, LD) ((size_t)(u.pm * 256 + ai * 128 + wr * 64 + (m) * 16 + fr) * (LD) + u.pn * 256 + (bj) * 128 + wc * 32 + 8 * fq)
struct EpiRet {
    static constexpr bool PERM = true;
    unsigned char* ws;
    DEV void operator()(const f32x4 (&acc)[2][2][4][2], const Unit& u, int wr, int wc, int fr, int fq) const {
        const bf16* GR = (const bf16*)(ws + R_GR); bf16* O = (bf16*)(ws + R_G);
#pragma unroll
        for (int ai = 0; ai < 2; ++ai) { u32x4 gv[4][2];
#pragma unroll
            for (int m = 0; m < 4; ++m)
#pragma unroll
                for (int bj = 0; bj < 2; ++bj) gv[m][bj] = *(const u32x4*)(GR + EPI_OFF(m, bj, 1024));
#pragma unroll
            for (int m = 0; m < 4; ++m)
#pragma unroll
                for (int bj = 0; bj < 2; ++bj) { f32x4 g0, g1; unpack8(gv[m][bj], g0, g1); st16(O + EPI_OFF(m, bj, 1024), pack8(acc[ai][bj][m][0] * g0, acc[ai][bj][m][1] * g1)); } }
    }
};
struct EpiGlu {
    static constexpr bool PERM = true;
    unsigned char* ws;
    DEV void operator()(const f32x4 (&acc)[2][2][4][2], const Unit& u, int wr, int wc, int fr, int fq) const {
        const bf16* Z = (const bf16*)(ws + R_U); bf16* O = (bf16*)(ws + R_S5IN);
#pragma unroll
        for (int ai = 0; ai < 2; ++ai) { u32x4 zv[4][2];
#pragma unroll
            for (int m = 0; m < 4; ++m)
#pragma unroll
                for (int bj = 0; bj < 2; ++bj) zv[m][bj] = *(const u32x4*)(Z + EPI_OFF(m, bj, 512));
#pragma unroll
            for (int m = 0; m < 4; ++m)
#pragma unroll
                for (int bj = 0; bj < 2; ++bj) { f32x4 z0, z1, v0 = acc[ai][bj][m][0], v1 = acc[ai][bj][m][1]; unpack8(zv[m][bj], z0, z1);
#pragma unroll
                    for (int q = 0; q < 4; ++q) { v0[q] = z0[q] * fsig(v0[q]); v1[q] = z1[q] * fsig(v1[q]); }
                    st16(O + EPI_OFF(m, bj, 512), pack8(v0, v1)); } }
    }
};
struct EpiS5b {
    static constexpr bool PERM = true;
    unsigned char* ws;
    DEV void operator()(const f32x4 (&acc)[2][2][4][2], const Unit& u, int wr, int wc, int fr, int fq) const {
        const bf16* GS = (const bf16*)(ws + R_GS); bf16* O = (bf16*)(ws + R_G);
#pragma unroll
        for (int ai = 0; ai < 2; ++ai) { u32x4 gv[4][2], pv[4][2];
#pragma unroll
            for (int m = 0; m < 4; ++m)
#pragma unroll
                for (int bj = 0; bj < 2; ++bj) { gv[m][bj] = *(const u32x4*)(GS + EPI_OFF(m, bj, 1024)); pv[m][bj] = *(const u32x4*)(O + EPI_OFF(m, bj, 1024)); }
#pragma unroll
            for (int m = 0; m < 4; ++m)
#pragma unroll
                for (int bj = 0; bj < 2; ++bj) { f32x4 g0, g1, p0, p1; unpack8(gv[m][bj], g0, g1); unpack8(pv[m][bj], p0, p1);
                    st16(O + EPI_OFF(m, bj, 1024), pack8(p0 + acc[ai][bj][m][0] * g0, p1 + acc[ai][bj][m][1] * g1)); } }
    }
};
struct EpiOut {
    static constexpr bool PERM = true;
    const bf16* hres; bf16* out;
    DEV void operator()(const f32x4 (&acc)[2][2][4][2], const Unit& u, int wr, int wc, int fr, int fq) const {
#pragma unroll
        for (int ai = 0; ai < 2; ++ai) { u32x4 hv[4][2];
#pragma unroll
            for (int m = 0; m < 4; ++m)
#pragma unroll
                for (int bj = 0; bj < 2; ++bj) hv[m][bj] = *(const u32x4*)(hres + EPI_OFF(m, bj, Dm));
#pragma unroll
            for (int m = 0; m < 4; ++m)
#pragma unroll
                for (int bj = 0; bj < 2; ++bj) { f32x4 h0, h1; unpack8(hv[m][bj], h0, h1); st16(out + EPI_OFF(m, bj, Dm), pack8(h0 * ALPHA + acc[ai][bj][m][0], h1 * ALPHA + acc[ai][bj][m][1])); } }
    }
};
}
namespace pg8 {
struct GroupedOrder {
    static constexpr bool GATHER = true;
    const PG8_LAS unsigned* tp; const unsigned* list; int NT, G, c, shift;
    __device__ bool next(int i, Unit& u) const {
        const unsigned total = (unsigned)__builtin_amdgcn_readfirstlane((int)tp[32]) * (unsigned)NT; const unsigned L = (unsigned)i * (unsigned)G + (unsigned)c;
        if (L >= total) return false;
        const unsigned mt = L / (unsigned)NT; int e = 0;
#pragma unroll
        for (int j = 1; j < 32; ++j) e += (mt >= tp[j]) ? 1 : 0;
        e = __builtin_amdgcn_readfirstlane(e);
        u.e = e; u.pm = (int)mt - __builtin_amdgcn_readfirstlane((int)tp[e]); u.pn = (int)(L % (unsigned)NT); u.pnb = e * NT + u.pn; u.cnt = __builtin_amdgcn_readfirstlane((int)tp[33 + e]); return true;
    }
    __device__ __forceinline__ const unsigned* list_ptr(const Unit& u, int r) const { int rr = u.pm * BM + r; rr = rr < u.cnt ? rr : u.cnt - 1; return list + (size_t)u.e * T + rr; }
    __device__ __forceinline__ unsigned row_of(unsigned e) const { return e >> shift; }
};
}
namespace epi {
struct EpiMoeGU {
    static constexpr bool PERM = true;
    unsigned char* ws; const unsigned* list;
    DEV void operator()(const f32x4 (&acc)[2][2][4][2], const Unit& u, int wr, int wc, int fr, int fq) const {
        bf16* ACT = (bf16*)(ws + R_ACT);
        unsigned pp[2][4];
#pragma unroll
        for (int ai = 0; ai < 2; ++ai)
#pragma unroll
            for (int m = 0; m < 4; ++m) { int r = u.pm * 256 + ai * 128 + wr * 64 + m * 16 + fr; r = r < u.cnt ? r : u.cnt - 1; pp[ai][m] = list[(size_t)u.e * T + r]; }
#pragma unroll
        for (int ai = 0; ai < 2; ++ai)
#pragma unroll
            for (int m = 0; m < 4; ++m) { const int r = u.pm * 256 + ai * 128 + wr * 64 + m * 16 + fr;
                if (r < u.cnt) { const unsigned p = pp[ai][m];
#pragma unroll
                    for (int bj = 0; bj < 2; ++bj) { const int f0 = u.pn * 128 + bj * 64 + wc * 16 + 4 * fq; const f32x4 v0 = acc[ai][bj][m][0], v1 = acc[ai][bj][m][1];
                        const float a0 = v0[0] * fsig(v0[0]) * v0[1], a1 = v0[2] * fsig(v0[2]) * v0[3], a2 = v1[0] * fsig(v1[0]) * v1[1], a3 = v1[2] * fsig(v1[2]) * v1[3];
                        u32x2 w; w.x = cvt_pk_bf16(a0, a1); w.y = cvt_pk_bf16(a2, a3); *(u32x2*)(ACT + (size_t)p * 256 + f0) = w; } } }
    }
};
struct EpiMoeDN {
    static constexpr bool PERM = true;
    unsigned char* ws; const unsigned* list;
    DEV void operator()(const f32x4 (&acc)[2][2][4][2], const Unit& u, int wr, int wc, int fr, int fq) const {
        bf16* Y = (bf16*)(ws + R_Y); const float* TC = (const float*)(ws + RT_C);
        unsigned pp[2][4]; float cw[2][4];
#pragma unroll
        for (int ai = 0; ai < 2; ++ai)
#pragma unroll
            for (int m = 0; m < 4; ++m) { int r = u.pm * 256 + ai * 128 + wr * 64 + m * 16 + fr; r = r < u.cnt ? r : u.cnt - 1; pp[ai][m] = list[(size_t)u.e * T + r]; }
#pragma unroll
        for (int ai = 0; ai < 2; ++ai)
#pragma unroll
            for (int m = 0; m < 4; ++m) cw[ai][m] = TC[pp[ai][m]];
#pragma unroll
        for (int ai = 0; ai < 2; ++ai)
#pragma unroll
            for (int m = 0; m < 4; ++m) { const int r = u.pm * 256 + ai * 128 + wr * 64 + m * 16 + fr;
                if (r < u.cnt) { const unsigned p = pp[ai][m]; const float c = cw[ai][m];
#pragma unroll
                    for (int bj = 0; bj < 2; ++bj) { const int d0 = u.pn * 256 + bj * 128 + wc * 32 + 8 * fq;
                        st16(Y + (size_t)p * Dm + d0, pack8(acc[ai][bj][m][0] * c, acc[ai][bj][m][1] * c)); } } }
    }
};
}
#define GAS __attribute__((address_space(1)))
#define LAS __attribute__((address_space(3)))
constexpr int NWAVES = 8;
constexpr int RING_OFF = 0, RING_BYTES = 131072;
constexpr int LDSCTL_OFF = RING_BYTES, MISC_OFF = LDSCTL_OFF + 320, PARK_OFF = RING_BYTES + 1024;
constexpr int LDS_BYTES = 147456;
constexpr int CW_TMO = 0, CW_CODE = 1, CW_BAR = 4096;

#define XB_TMO      128
#define XB_XCNT(j)  (256  + 64 * (j))
#define XB_XSUB(j)  (1280 + 64 * (j))
#define XB_XGEN(j)  (2304 + 64 * (j))
#define XB_TOP      3328
#define XB_TOPGEN   3392
#define XCD_BAR_WORDS 3456
#define XB_SPIN_CAP (1u << 18)
__device__ __forceinline__ unsigned xb_ld(unsigned* p)              { return __hip_atomic_load(p, __ATOMIC_RELAXED, __HIP_MEMORY_SCOPE_AGENT); }
__device__ __forceinline__ unsigned xb_add(unsigned* p, unsigned v) { return __hip_atomic_fetch_add(p, v, __ATOMIC_RELAXED, __HIP_MEMORY_SCOPE_AGENT); }
__device__ __forceinline__ unsigned xb_xcc_id() { return (unsigned)__builtin_amdgcn_s_getreg((3 << 11) | 20) & 0xFu; }
#define XB_SPIN(cond, bar) do { unsigned _sp = 0; while (cond) { __builtin_amdgcn_s_sleep(1); \
    if ((++_sp & 255u) == 0u) { if (xb_ld(&(bar)[XB_TMO])) break; if (_sp > XB_SPIN_CAP) { atomicAdd(&(bar)[XB_TMO], 1u); break; } } } } while (0)
struct XcdBarrier { unsigned* bar; unsigned x; volatile LAS unsigned* st; };
__device__ __forceinline__ XcdBarrier xcd_barrier_post(unsigned* bar, volatile LAS unsigned* st, bool t0) {
    XcdBarrier b; b.bar = bar; b.x = xb_xcc_id(); b.st = st;
    if (t0) st[3] = xb_add(&bar[XB_XCNT(b.x)], 1u);
    return b;
}
__device__ __forceinline__ void xcd_barrier_complete(unsigned* bar, unsigned x, unsigned& nloc, unsigned& nx) {
    const unsigned G = gridDim.x * gridDim.y * gridDim.z;
    unsigned sum, cnt, mine, sp = 0u;
    for (;;) {
        sum = 0u; cnt = 0u; mine = 0u;
#pragma unroll
        for (unsigned j = 0; j < 16; ++j) { const unsigned c = xb_ld(&bar[XB_XCNT(j)]); sum += c; cnt += (c > 0u) ? 1u : 0u; mine = (j == x) ? c : mine; }
        if (sum == G) break;
        __builtin_amdgcn_s_sleep(1);
        if ((++sp & 255u) == 0u) { if (xb_ld(&bar[XB_TMO])) break; if (sp > XB_SPIN_CAP) { atomicAdd(&bar[XB_TMO], 1u); break; } }
    }
    nloc = mine > 0u ? mine : 1u; nx = cnt > 0u ? cnt : 1u;
}
__device__ __forceinline__ void xcd_barrier(const XcdBarrier& b, bool t0, bool local) {
    asm volatile("s_waitcnt vmcnt(0)" ::: "memory");
    __syncthreads();
    if (t0) {
        unsigned* bar = b.bar;
        __builtin_amdgcn_s_waitcnt(0);
        unsigned nloc = b.st[0], nx = b.st[1];
        if (nloc == 0u) { xcd_barrier_complete(bar, b.x, nloc, nx); b.st[0] = nloc; b.st[1] = nx;
            const unsigned G = gridDim.x; unsigned even = (nx == 8u && (G & 7u) == 0u) ? 1u : 0u;
#pragma unroll
            for (unsigned j = 0; j < 8; ++j) even &= (xb_ld(&bar[XB_XCNT(j)]) == G / 8u) ? 1u : 0u;
            b.st[2] = even;
            if (even) { const unsigned rk = b.st[3]; b.st[4] = rk * 8u + b.x; b.st[5] = b.x * (G / 8u) + rk; } }
        const unsigned old = xb_add(&bar[XB_XSUB(b.x)], 1u);
        const unsigned gen = old / nloc;
        if (old + 1u == (gen + 1u) * nloc) {
            if (!local) {
            __builtin_amdgcn_fence(__ATOMIC_RELEASE, "agent");
            asm volatile("s_waitcnt vmcnt(0)" ::: "memory");
            const unsigned og = xb_add(&bar[XB_TOP], 1u);
            const unsigned tg = og / nx;
            if (og + 1u == (tg + 1u) * nx) xb_add(&bar[XB_TOPGEN], 1u);
            else XB_SPIN(xb_ld(&bar[XB_TOPGEN]) == tg, bar);
            }
            __builtin_amdgcn_fence(__ATOMIC_ACQUIRE, "agent");
            xb_add(&bar[XB_XGEN(b.x)], 1u);
            asm volatile("s_waitcnt vmcnt(0)" ::: "memory");
        } else {
            XB_SPIN(xb_ld(&bar[XB_XGEN(b.x)]) == gen, bar);
            __builtin_amdgcn_fence(__ATOMIC_ACQUIRE, "agent");
            asm volatile("s_waitcnt vmcnt(0)" ::: "memory");
        }
    }
    __syncthreads();
}

struct Args { const float* in[27]; float* out; unsigned char* ws; int ph_lo, ph_hi, bar_id, pad; };
constexpr int NPL = 10, NPH = 1 + DEPTH * NPL;
enum { K_PROJ = 0, K_RETA = 1, K_RETB = 2, K_BRANCH = 3, K_S5B = 4, K_OUT = 5, K_LNROUTE = 6, K_MOEGU = 7, K_MOEDN = 8, K_LN2 = 9 };
namespace ph {
#define LDSW() asm volatile("s_waitcnt lgkmcnt(0)" ::: "memory")
DEV int lane_id(int wbase) { return pg8::fresh_tid(wbase) & 63; }
DEV unsigned pk2(float lo, float hi) { return (unsigned)f2bf(lo) | ((unsigned)f2bf(hi) << 16); }
DEV void transpose_item(const float* __restrict__ W, int K, int N, bf16* __restrict__ WT, int rmul, int radd, LAS float* scr, int item, int lane) {
    const int nblk = N / 32, kb = item / nblk, nb = item % nblk, k0 = 64 * kb, n0 = 32 * nb;
#pragma unroll 8
    for (int i = 0; i < 32; ++i) { const int kk = 2 * i + (lane >> 5); scr[kk * 33 + (lane & 31)] = W[(size_t)(k0 + kk) * N + n0 + (lane & 31)]; }
    LDSW(); asm volatile("" ::: "memory");
    const int c = lane & 7;
#pragma unroll
    for (int j = 0; j < 4; ++j) { const int n = (lane >> 3) + 8 * j; const LAS float* s = scr + (8 * c) * 33 + n;
        uint4 o; o.x = pk2(s[0 * 33], s[1 * 33]); o.y = pk2(s[2 * 33], s[3 * 33]); o.z = pk2(s[4 * 33], s[5 * 33]); o.w = pk2(s[6 * 33], s[7 * 33]);
        *(uint4*)(WT + (size_t)((n0 + n) * rmul + radd) * K + k0 + 8 * c) = o; }
    LDSW(); asm volatile("" ::: "memory");
}
DEV void ln_row(const float* pre, const bf16* preb, float scale, const bf16* y2, const float* __restrict__ g, const float* __restrict__ b, float* of, bf16* ob, int lane, float (&v)[16]) {
    float s = 0.f;
    if (pre) {
#pragma unroll
        for (int j = 0; j < 4; ++j) { const float4 x = *(const float4*)(pre + j * 256 + lane * 4); v[4 * j] = x.x * scale; v[4 * j + 1] = x.y * scale; v[4 * j + 2] = x.z * scale; v[4 * j + 3] = x.w * scale; }
    } else {
#pragma unroll
        for (int j = 0; j < 4; ++j) { const uint2 a = *(const uint2*)(preb + j * 256 + lane * 4);
            v[4 * j] = __uint_as_float(a.x << 16) * scale; v[4 * j + 1] = __uint_as_float(a.x & 0xffff0000u) * scale; v[4 * j + 2] = __uint_as_float(a.y << 16) * scale; v[4 * j + 3] = __uint_as_float(a.y & 0xffff0000u) * scale; }
    }
    if (y2) {
#pragma unroll
        for (int j = 0; j < 4; ++j) { const uint2 a = *(const uint2*)(y2 + j * 256 + lane * 4), c = *(const uint2*)(y2 + Dm + j * 256 + lane * 4);
            v[4 * j] += __uint_as_float(a.x << 16) + __uint_as_float(c.x << 16); v[4 * j + 1] += __uint_as_float(a.x & 0xffff0000u) + __uint_as_float(c.x & 0xffff0000u);
            v[4 * j + 2] += __uint_as_float(a.y << 16) + __uint_as_float(c.y << 16); v[4 * j + 3] += __uint_as_float(a.y & 0xffff0000u) + __uint_as_float(c.y & 0xffff0000u); }
    }
#pragma unroll
    for (int i = 0; i < 16; ++i) s += v[i];
    const float mean = wave_sum(s) * (1.f / Dm); float q = 0.f;
#pragma unroll
    for (int i = 0; i < 16; ++i) { v[i] -= mean; q += v[i] * v[i]; }
    const float rstd = rsqrtf(wave_sum(q) * (1.f / Dm) + LN_EPS);
#pragma unroll
    for (int j = 0; j < 4; ++j) { const float4 gg = *(const float4*)(g + j * 256 + lane * 4), bb = *(const float4*)(b + j * 256 + lane * 4);
        float4 o; o.x = v[4 * j] * rstd * gg.x + bb.x; o.y = v[4 * j + 1] * rstd * gg.y + bb.y; o.z = v[4 * j + 2] * rstd * gg.z + bb.z; o.w = v[4 * j + 3] * rstd * gg.w + bb.w;
        v[4 * j] = o.x; v[4 * j + 1] = o.y; v[4 * j + 2] = o.z; v[4 * j + 3] = o.w;
        if (of) *(float4*)(of + j * 256 + lane * 4) = o;
        uint2 w; w.x = pk2(o.x, o.y); w.y = pk2(o.z, o.w); *(uint2*)(ob + j * 256 + lane * 4) = w; }
}

struct ProIn { const float *x, *lng, *lnb, *w_in, *lam_re, *lam_im, *log_step, *b_re, *b_im, *c_re, *c_im, *w_glu, *w_bret, *w_bs5, *w_out, *w_rg, *w_re; float* out; };
DEV void prologue(const int wbase, LAS unsigned char* lds, unsigned char* ws, const ProIn P, int G, int vcu) {
    const int wave = wbase >> 6, lane = lane_id(wbase), tid = wbase + lane;
    LAS float* scr = (LAS float*)(lds + wave * 16384);
    const int gw = vcu * NWAVES + wave, NGW = G * NWAVES;
    constexpr int I_IN = (Dm / 64) * (INW / 32), I_GLU = (S5W / 64) * (S5W / 32), I_BRET = (RV / 64) * (Dm / 32), I_BS5 = (S5W / 64) * (Dm / 32), I_OUT = (Dm / 64) * (Dm / 32);
    constexpr int I_L = I_IN + I_GLU + I_BRET + I_BS5 + I_OUT;
    for (int it = gw; it < DEPTH * I_L; it += NGW) {
        const int l = it / I_L; int r = it % I_L;
        if (r < I_IN) { transpose_item(P.w_in + (size_t)l * Dm * INW, Dm, INW, (bf16*)(ws + W_IN) + (size_t)l * INW * Dm, 1, 0, scr, r, lane); continue; } r -= I_IN;
        if (r < I_GLU) { transpose_item(P.w_glu + (size_t)l * S5W * S5W, S5W, S5W, (bf16*)(ws + W_GLU) + (size_t)l * S5W * S5W, 1, 0, scr, r, lane); continue; } r -= I_GLU;
        if (r < I_BRET) { transpose_item(P.w_bret + (size_t)l * RV * Dm, RV, Dm, (bf16*)(ws + W_BRET) + (size_t)l * Dm * RV, 1, 0, scr, r, lane); continue; } r -= I_BRET;
        if (r < I_BS5) { transpose_item(P.w_bs5 + (size_t)l * S5W * Dm, S5W, Dm, (bf16*)(ws + W_BS5) + (size_t)l * Dm * S5W, 1, 0, scr, r, lane); continue; } r -= I_BS5;
        transpose_item(P.w_out + (size_t)l * Dm * Dm, Dm, Dm, (bf16*)(ws + W_OUT) + (size_t)l * Dm * Dm, 1, 0, scr, r, lane);
    }
    const int gt = vcu * (NWAVES * 64) + tid, NGT = G * NWAVES * 64;
    float* COS = (float*)(ws + TAB_COS); float* SIN = (float*)(ws + TAB_SIN); float* POWG = (float*)(ws + TAB_POWG);
    float* AB = (float*)(ws + TAB_AB); bf16* BBH = (bf16*)(ws + TAB_BBH); bf16* CTH = (bf16*)(ws + TAB_CTH); float* WRT = (float*)(ws + TAB_WRT);
    for (int gid = gt; gid < 2048 * 32; gid += NGT) { const int pos = gid >> 5, i = gid & 31; const float inv = exp2f(-(float)i * (13.287712379549449f / 32.0f)); const float ang = (float)pos * inv;
        COS[gid] = cosf(ang); SIN[gid] = sinf(ang); }
    for (int gid = gt; gid < 8 * 80; gid += NGT) { const int h = gid / 80, n = gid % 80; const float lg = log1pf(-exp2f(-5.0f - (float)h)); POWG[gid] = expf(lg * (float)n); }
    for (int gid = gt; gid < DEPTH * S5G * S5N; gid += NGT) {
        const int g = (gid / S5N) % S5G, l = gid / (S5G * S5N);
        float lr = P.lam_re[gid]; if (lr > -1e-4f) lr = -1e-4f; const float li = P.lam_im[gid];
        const float step = expf(P.log_step[l * S5G + g]);
        const float em1 = expm1f(lr * step), mag = em1 + 1.f, ang = li * step, cs = cosf(ang), sn = sinf(ang), sh = sinf(0.5f * ang);
        const float abr = mag * cs, abi = mag * sn;
        const float nre = em1 * cs - 2.f * sh * sh;
        const float den = lr * lr + li * li;
        const float zr = (nre * lr + abi * li) / den, zi = (abi * lr - nre * li) / den;
        AB[gid * 2] = abr; AB[gid * 2 + 1] = abi;
        const int n = gid % S5N, lg = gid / S5N;
        for (int c = 0; c < 16; ++c) { const float br = P.b_re[(size_t)gid * 16 + c], bi = P.b_im[(size_t)gid * 16 + c];
            BBH[((size_t)lg * 128 + n) * 16 + c] = f2bf(zr * br - zi * bi); BBH[((size_t)lg * 128 + 64 + n) * 16 + c] = f2bf(zr * bi + zi * br); }
    }
    for (int gid = gt; gid < DEPTH * S5G * 16 * 128; gid += NGT) { const int np = gid & 127, lgc = gid >> 7;
        CTH[gid] = f2bf(np < 64 ? P.c_re[(size_t)lgc * 64 + np] : -P.c_im[(size_t)lgc * 64 + np - 64]); }
    for (int gid = gt; gid < DEPTH * 36 * Dm; gid += NGT) { const int kk = gid % Dm, j = (gid / Dm) % 36, l = gid / (36 * Dm);
        WRT[gid] = j < 4 ? P.w_rg[((size_t)l * Dm + kk) * MG + j] : P.w_re[((size_t)l * Dm + kk) * NE + (j - 4)]; }
    { bf16* WRH = (bf16*)(ws + TAB_WRH); bf16* WRL = (bf16*)(ws + TAB_WRL);
      for (int gid = gt; gid < DEPTH * 48 * Dm; gid += NGT) { const int kk = gid % Dm, j = (gid / Dm) % 48, l = gid / (48 * Dm);
          const float w = j < 4 ? P.w_rg[((size_t)l * Dm + kk) * MG + j] : (j < 36 ? P.w_re[((size_t)l * Dm + kk) * NE + (j - 4)] : 0.f);
          const bf16 hi = f2bf(w); WRH[gid] = hi; WRL[gid] = f2bf(w - bf2f(hi)); } }
    float v[16];
    for (int m = gw; m < T; m += NGW) ln_row(P.x + (size_t)m * Dm, nullptr, 1.f, nullptr, P.lng, P.lnb, nullptr, (bf16*)(ws + WS_HBF) + (size_t)m * Dm, lane, v);
}

struct RouteIn { const float *lng, *lnb, *brg, *bre, *wg, *wu, *wd; };
DEV void phase_lnroute(const int wbase, LAS unsigned char* lds, unsigned char* ws, const RouteIn P, int layer, int G, int vcu) {
    const int wave = wbase >> 6, lane = lane_id(wbase);
    const int gw = vcu * NWAVES + wave, NGW = G * NWAVES;
    const bf16* preb = (const bf16*)(ws + WS_HB); bf16* ob = (bf16*)(ws + WS_HBF);
    const float* WRT = (const float*)(ws + TAB_WRT) + (size_t)layer * 36 * Dm;
    const float* brg = P.brg; const float* bre = P.bre;
    int* TE = (int*)(ws + RT_E); float* TC = (float*)(ws + RT_C); int* LIST = (int*)(ws + RT_LIST); unsigned* CNT = (unsigned*)(ws + WS_CNT) + layer * NE;
    typedef short bf16x8 __attribute__((ext_vector_type(8))); typedef float f32x4 __attribute__((ext_vector_type(4)));
    constexpr int AS = 2064, A_LO = 16 * AS, PL_OFF = 2 * 16 * AS, LG_OFF = PL_OFF + 8 * 16 * 48 * 4, RT_OFF = LG_OFF + 16 * 48 * 4, CAP = 128;
    LAS unsigned* lcnt = (LAS unsigned*)(lds + RT_OFF); LAS unsigned* gbase = lcnt + 32; LAS int* le1 = (LAS int*)(gbase + 32); LAS int* le2 = le1 + CAP;
    LAS unsigned* lr1 = (LAS unsigned*)(le2 + CAP); LAS unsigned* lr2 = lr1 + CAP; LAS float* lc1 = (LAS float*)(lr2 + CAP); LAS float* lc2 = lc1 + CAP; LAS int* lrow = (LAS int*)(lc2 + CAP);
    static_assert(RT_OFF + 64 * 4 + 7 * CAP * 4 <= RING_BYTES, "lnroute LDS");
    const int tid = wbase + lane, fr = lane & 15, fq = lane >> 4;
    bf16x8 bh[3][4], bl[3][4];
    { const bf16* WRH = (const bf16*)(ws + TAB_WRH) + (size_t)layer * 48 * Dm; const bf16* WRL = (const bf16*)(ws + TAB_WRL) + (size_t)layer * 48 * Dm;
#pragma unroll
      for (int nt = 0; nt < 3; ++nt)
#pragma unroll
          for (int ks = 0; ks < 4; ++ks) { const size_t o = (size_t)(16 * nt + fr) * Dm + wave * 128 + ks * 32 + 8 * fq; bh[nt][ks] = *(const bf16x8*)(WRH + o); bl[nt][ks] = *(const bf16x8*)(WRL + o); } }
    if (tid < 32) lcnt[tid] = 0u;
    int nent = 0;
    __syncthreads();
    const bool contig = ((T / 16) % G) == 0; const int nbw = contig ? (T / 16) / G : ((T / 16) + G - 1) / G;
    for (int ib = 0; ib < nbw; ++ib) { const int blk = contig ? vcu * nbw + ib : vcu + ib * G; if (blk >= T / 16) break;
#pragma unroll
        for (int jr = 0; jr < 2; ++jr) { const int lr = 2 * wave + jr, row = blk * 16 + lr;
            float v[16];
            ln_row(nullptr, preb + (size_t)row * Dm, 1.f, nullptr, P.lng, P.lnb, nullptr, ob + (size_t)row * Dm, lane, v);
#pragma unroll
            for (int j = 0; j < 4; ++j) { unsigned hw[2], lw[2];
#pragma unroll
                for (int e2 = 0; e2 < 2; ++e2) { const float x0 = v[4 * j + 2 * e2], x1 = v[4 * j + 2 * e2 + 1]; const bf16 h0 = f2bf(x0), h1 = f2bf(x1);
                    hw[e2] = (unsigned)h0 | ((unsigned)h1 << 16); lw[e2] = (unsigned)f2bf(x0 - bf2f(h0)) | ((unsigned)f2bf(x1 - bf2f(h1)) << 16); }
                *(LAS pg8::u32x2*)(lds + lr * AS + (j * 256 + lane * 4) * 2) = (pg8::u32x2){hw[0], hw[1]};
                *(LAS pg8::u32x2*)(lds + A_LO + lr * AS + (j * 256 + lane * 4) * 2) = (pg8::u32x2){lw[0], lw[1]}; } }
        __syncthreads();
        f32x4 acc[3];
#pragma unroll
        for (int nt = 0; nt < 3; ++nt) acc[nt] = (f32x4){0.f, 0.f, 0.f, 0.f};
#pragma unroll
        for (int ks = 0; ks < 4; ++ks) { const int ao = fr * AS + (wave * 128 + ks * 32 + 8 * fq) * 2;
            const bf16x8 ah = *(const LAS bf16x8*)(lds + ao), al = *(const LAS bf16x8*)(lds + A_LO + ao);
#pragma unroll
            for (int nt = 0; nt < 3; ++nt) { acc[nt] = __builtin_amdgcn_mfma_f32_16x16x32_bf16(ah, bh[nt][ks], acc[nt], 0, 0, 0);
                acc[nt] = __builtin_amdgcn_mfma_f32_16x16x32_bf16(al, bh[nt][ks], acc[nt], 0, 0, 0); acc[nt] = __builtin_amdgcn_mfma_f32_16x16x32_bf16(ah, bl[nt][ks], acc[nt], 0, 0, 0); } }
        { LAS float* PL = (LAS float*)(lds + PL_OFF) + wave * 16 * 48;
#pragma unroll
          for (int nt = 0; nt < 3; ++nt)
#pragma unroll
              for (int rg = 0; rg < 4; ++rg) PL[(4 * fq + rg) * 48 + 16 * nt + fr] = acc[nt][rg]; }
        __syncthreads();
        for (int idx = tid; idx < 16 * 48; idx += NWAVES * 64) { const LAS float* PL = (const LAS float*)(lds + PL_OFF) + idx; float s = 0.f;
#pragma unroll
            for (int w = 0; w < 8; ++w) s += PL[w * 16 * 48];
            ((LAS float*)(lds + LG_OFF))[idx] = s; }
        __syncthreads();
        if (tid < 16) { const LAS float* LG = (const LAS float*)(lds + LG_OFF) + tid * 48; const int row = blk * 16 + tid;
            float lg[4];
#pragma unroll
            for (int kk = 0; kk < 4; ++kk) lg[kk] = LG[kk] + brg[kk];
            int gi = 0; float gm = lg[0];
#pragma unroll
            for (int kk = 1; kk < 4; ++kk) if (lg[kk] > gm) { gm = lg[kk]; gi = kk; }
            float den = 0.f;
#pragma unroll
            for (int kk = 0; kk < 4; ++kk) den += __expf(lg[kk] - gm);
            const float gtop = 1.f / den;
            int i1 = 0, i2 = 0; float m1 = -INFINITY, m2 = -INFINITY;
            for (int kk = 0; kk < 8; ++kk) { const float x = LG[4 + gi * 8 + kk] + bre[gi * 8 + kk];
                if (x > m1) { m2 = m1; i2 = i1; m1 = x; i1 = kk; } else if (x > m2) { m2 = x; i2 = kk; } }
            const float p2 = __expf(m2 - m1);
            const float w1 = 1.f / (1.f + p2), w2 = p2 / (1.f + p2);
            const int e1 = gi * 8 + i1, e2 = gi * 8 + i2, li = nent + tid;
            le1[li] = e1; le2[li] = e2; lc1[li] = gtop * w1; lc2[li] = gtop * w2; lrow[li] = row;
            lr1[li] = __hip_atomic_fetch_add(lcnt + e1, 1u, __ATOMIC_RELAXED, __HIP_MEMORY_SCOPE_WORKGROUP); lr2[li] = __hip_atomic_fetch_add(lcnt + e2, 1u, __ATOMIC_RELAXED, __HIP_MEMORY_SCOPE_WORKGROUP); }
        nent += 16;
        const bool last = (ib + 1 >= nbw) || (!contig && blk + G >= T / 16);
        if (nent == CAP || last) {
            __syncthreads();
            if (tid < 32) { const unsigned c = lcnt[tid]; gbase[tid] = c ? atomicAdd(&CNT[tid], c) : 0u; }
            __syncthreads();
            if (tid < nent) { const int row = lrow[tid], e1 = le1[tid], e2 = le2[tid];
                TE[row * 2] = e1; TE[row * 2 + 1] = e2; TC[row * 2] = lc1[tid]; TC[row * 2 + 1] = lc2[tid];
                LIST[(size_t)e1 * T + gbase[e1] + lr1[tid]] = row * 2; LIST[(size_t)e2 * T + gbase[e2] + lr2[tid]] = row * 2 + 1; }
            __syncthreads();
            if (tid < 32) lcnt[tid] = 0u;
            nent = 0;
        }
        __syncthreads();
    }
    LAS float* scr = (LAS float*)(lds + wave * 16384);
    constexpr int I_G = (Dm / 64) * (FF / 32);
    for (int it = gw; it < NE * 2 * I_G; it += NGW) {
        const int e = it / (2 * I_G); int r = it % (2 * I_G);
        if (r < I_G) { transpose_item(P.wg + (size_t)e * Dm * FF, Dm, FF, (bf16*)(ws + R_WGU) + (size_t)e * 512 * Dm, 2, 0, scr, r, lane); continue; } r -= I_G;
        transpose_item(P.wu + (size_t)e * Dm * FF, Dm, FF, (bf16*)(ws + R_WGU) + (size_t)e * 512 * Dm, 2, 1, scr, r, lane);
    }
}
DEV void phase_ln2(const int wbase, unsigned char* ws, const float* lng, const float* lnb, float* out, int G, int vcu) {
    const int wave = wbase >> 6, lane = lane_id(wbase);
    const int gw = vcu * NWAVES + wave, NGW = G * NWAVES;
    float v[16];
    for (int row = gw; row < T; row += NGW)
        ln_row(nullptr, (const bf16*)(ws + WS_HBF) + (size_t)row * Dm, ALPHA, (const bf16*)(ws + R_Y) + (size_t)(2 * row) * Dm, lng, lnb, out ? out + (size_t)row * Dm : nullptr, (bf16*)(ws + WS_HBF) + (size_t)row * Dm, lane, v);
}
}

namespace ret {
typedef short bf16x8 __attribute__((ext_vector_type(8)));
typedef short s16x4 __attribute__((ext_vector_type(4)));
typedef float f32x16 __attribute__((ext_vector_type(16)));
typedef float f32x4 __attribute__((ext_vector_type(4)));
typedef float f32x2_t __attribute__((ext_vector_type(2))); typedef __bf16 bf16x2_t __attribute__((ext_vector_type(2)));
DEV unsigned cvtpk(float lo, float hi) { f32x2_t v = {lo, hi}; bf16x2_t b = __builtin_convertvector(v, bf16x2_t); return __builtin_bit_cast(unsigned, b); }
#define RMFMA(a, b, c) __builtin_amdgcn_mfma_f32_32x32x16_bf16((a), (b), (c), 0, 0, 0)
constexpr int LS = 72;
constexpr int L_KR = 0, L_QR = 9216, L_KDT = 18432, L_VT = 27648, L_ST = 46080, L_O = 64512, OS = 132, L_END = L_O + 64 * OS * 4;
static_assert(L_END <= RING_BYTES, "retention LDS");
constexpr int SEGC = 8, NSEG = NCH / SEGC;
DEV int crow(int reg, int h) { return (reg & 3) + 8 * (reg >> 2) + 4 * h; }
DEV float bflo(unsigned w) { return __uint_as_float(w << 16); }
DEV float bfhi(unsigned w) { return __uint_as_float(w & 0xffff0000u); }

struct Raw { uint2 k1, k2, q1, q2; float4 cs, sn; uint4 v0, v1; };
template <bool WITH_Q> DEV void load_raw(Raw& R, const unsigned char* ws, int row0, int pos0, int h, int tid) {
    const int j = tid >> 3, c0 = (tid & 7) * 4;
    const bf16* K = (const bf16*)(ws + R_K) + (size_t)(row0 + j) * 512 + h * 64 + c0;
    R.k1 = *(const uint2*)K; R.k2 = *(const uint2*)(K + 32);
    if (WITH_Q) { const bf16* Q = (const bf16*)(ws + R_Q) + (size_t)(row0 + j) * 512 + h * 64 + c0; R.q1 = *(const uint2*)Q; R.q2 = *(const uint2*)(Q + 32); }
    R.cs = *(const float4*)((const float*)(ws + TAB_COS) + (pos0 + j) * 32 + c0); R.sn = *(const float4*)((const float*)(ws + TAB_SIN) + (pos0 + j) * 32 + c0);
    const bf16* V = (const bf16*)(ws + R_V) + (size_t)(row0 + j) * 1024 + h * 128 + (tid & 7) * 16;
    R.v0 = *(const uint4*)V; R.v1 = *(const uint4*)(V + 8);
}
DEV void rot4(const uint2 x1, const uint2 x2, const float4 cs, const float4 sn, float (&r1)[4], float (&r2)[4]) {
    const float a[4] = {bflo(x1.x), bfhi(x1.x), bflo(x1.y), bfhi(x1.y)}, b[4] = {bflo(x2.x), bfhi(x2.x), bflo(x2.y), bfhi(x2.y)};
    const float c[4] = {cs.x, cs.y, cs.z, cs.w}, s[4] = {sn.x, sn.y, sn.z, sn.w};
#pragma unroll
    for (int e = 0; e < 4; ++e) { r1[e] = a[e] * c[e] - b[e] * s[e]; r2[e] = a[e] * s[e] + b[e] * c[e]; }
}
template <bool WITH_Q> DEV void stage(LAS unsigned char* lds, const Raw& R, int tid, float kd) {
    const int j = tid >> 3, c0 = (tid & 7) * 4;
    float r1[4], r2[4];
    rot4(R.k1, R.k2, R.cs, R.sn, r1, r2);
    if (WITH_Q) { LAS bf16* kr = (LAS bf16*)(lds + L_KR) + j * LS + c0;
        *(LAS pg8::u32x2*)kr = (pg8::u32x2){cvtpk(r1[0], r1[1]), cvtpk(r1[2], r1[3])}; *(LAS pg8::u32x2*)(kr + 32) = (pg8::u32x2){cvtpk(r2[0], r2[1]), cvtpk(r2[2], r2[3])}; }
    LAS bf16* kdt = (LAS bf16*)(lds + L_KDT) + c0 * LS + j;
#pragma unroll
    for (int e = 0; e < 4; ++e) { kdt[e * LS] = f2bf(r1[e] * kd); kdt[(32 + e) * LS] = f2bf(r2[e] * kd); }
    if (WITH_Q) { rot4(R.q1, R.q2, R.cs, R.sn, r1, r2); LAS bf16* qr = (LAS bf16*)(lds + L_QR) + j * LS + c0;
        *(LAS pg8::u32x2*)qr = (pg8::u32x2){cvtpk(r1[0], r1[1]), cvtpk(r1[2], r1[3])}; *(LAS pg8::u32x2*)(qr + 32) = (pg8::u32x2){cvtpk(r2[0], r2[1]), cvtpk(r2[2], r2[3])}; }
    LAS bf16* vt = (LAS bf16*)(lds + L_VT) + ((tid & 7) * 16) * LS + j;
    const unsigned vw[8] = {R.v0.x, R.v0.y, R.v0.z, R.v0.w, R.v1.x, R.v1.y, R.v1.z, R.v1.w};
#pragma unroll
    for (int e = 0; e < 8; ++e) { vt[(2 * e) * LS] = (bf16)(vw[e] & 0xffffu); vt[(2 * e + 1) * LS] = (bf16)(vw[e] >> 16); }
}
DEV bf16x8 ld8(const LAS bf16* p) { return *(const LAS bf16x8*)p; }
DEV void state_update(f32x16& ST, const LAS unsigned char* lds, int wi, int wd, int r, int hh, float cd) {
#pragma unroll
    for (int e = 0; e < 16; ++e) ST[e] *= cd;
    const LAS bf16* a = (const LAS bf16*)(lds + L_KDT) + (32 * wi + r) * LS + 8 * hh; const LAS bf16* b = (const LAS bf16*)(lds + L_VT) + (32 * wd + r) * LS + 8 * hh;
#pragma unroll
    for (int s = 0; s < 4; ++s) ST = RMFMA(ld8(a + 16 * s), ld8(b + 16 * s), ST);
}

DEV void phase_a(const int wbase, LAS unsigned char* lds, unsigned char* ws, int G, int vcu) {
    const int wave = wbase >> 6, tid = pg8::fresh_tid(wbase), lane = tid & 63, r = lane & 31, hh = lane >> 5, wi = wave >> 2, wd = wave & 3;
    for (int item = vcu; item < BATCH * RH * NSEG; item += G) {
        const int seg = item % NSEG, h = (item / NSEG) % RH, b = item / (NSEG * RH);
        const float lg2g = log1pf(-__builtin_amdgcn_exp2f(-5.0f - (float)h)) * 1.4426950408889634f, cd = __builtin_amdgcn_exp2f(64.f * lg2g);
        f32x16 ST;
#pragma unroll
        for (int e = 0; e < 16; ++e) ST[e] = 0.f;
        const float kdj = __builtin_amdgcn_exp2f((float)(63 - (tid >> 3)) * lg2g);
        Raw R; load_raw<false>(R, ws, b * SEQ + seg * SEGC * CHUNK, seg * SEGC * CHUNK, h, tid);
#pragma nounroll
        for (int n = 0; n < SEGC; ++n) {
            __syncthreads();
            stage<false>(lds, R, tid, kdj);
            __syncthreads();
            if (n + 1 < SEGC) load_raw<false>(R, ws, b * SEQ + (seg * SEGC + n + 1) * CHUNK, (seg * SEGC + n + 1) * CHUNK, h, tid);
            state_update(ST, lds, wi, wd, r, hh, cd);
        }
        float* TOT = (float*)(ws + WS_HB) + (size_t)item * 8192 + wave * 1024 + lane;
#pragma unroll
        for (int e = 0; e < 16; ++e) TOT[e * 64] = ST[e];
    }
    __syncthreads();
}
DEV void phase_b(const int wbase, LAS unsigned char* lds, unsigned char* ws, int G, int vcu) {
    const int wave = wbase >> 6, tid = pg8::fresh_tid(wbase), lane = tid & 63, r = lane & 31, hh = lane >> 5, wi = wave >> 2, wd = wave & 3;
    for (int item = vcu; item < BATCH * RH * NSEG; item += G) {
        const int seg = item % NSEG, h = (item / NSEG) % RH, b = item / (NSEG * RH);
        const float lg2g = log1pf(-__builtin_amdgcn_exp2f(-5.0f - (float)h)) * 1.4426950408889634f, cd = __builtin_amdgcn_exp2f(64.f * lg2g), cd8 = __builtin_amdgcn_exp2f(64.f * SEGC * lg2g);
        f32x16 ST;
#pragma unroll
        for (int e = 0; e < 16; ++e) ST[e] = 0.f;
#pragma nounroll
        for (int s = 0; s < seg; ++s) { const float* TOT = (const float*)(ws + WS_HB) + (size_t)(item - seg + s) * 8192 + wave * 1024 + lane;
#pragma unroll
            for (int e = 0; e < 16; ++e) ST[e] = cd8 * ST[e] + TOT[e * 64]; }
        const float kdj = __builtin_amdgcn_exp2f((float)(63 - (tid >> 3)) * lg2g);
        Raw R; load_raw<true>(R, ws, b * SEQ + seg * SEGC * CHUNK, seg * SEGC * CHUNK, h, tid);
        float mk0[16], mk1[16], qdec[16];
        { const int lq = pg8::fresh_tid(wbase) & 63, iq = 32 * wi + (lq & 31), hq = lq >> 5;
#pragma unroll
          for (int e = 0; e < 16; ++e) { const int j0 = crow(e, hq), d0 = iq > j0 ? iq - j0 : j0 - iq, d1 = iq > j0 + 32 ? iq - j0 - 32 : j0 + 32 - iq;
              mk0[e] = __builtin_amdgcn_exp2f((float)d0 * lg2g); mk1[e] = __builtin_amdgcn_exp2f((float)d1 * lg2g); qdec[e] = __builtin_amdgcn_exp2f((float)(32 * wi + j0 + 1) * lg2g); } }
#pragma nounroll
        for (int n = 0; n < SEGC; ++n) {
            const int row0 = b * SEQ + (seg * SEGC + n) * CHUNK;
            stage<true>(lds, R, tid, kdj);
            { LAS bf16* st = (LAS bf16*)(lds + L_ST) + (32 * wd + r) * LS + 32 * wi + 4 * hh;
#pragma unroll
              for (int g4 = 0; g4 < 4; ++g4) *(LAS pg8::u32x2*)(st + 8 * g4) = (pg8::u32x2){cvtpk(ST[4 * g4], ST[4 * g4 + 1]), cvtpk(ST[4 * g4 + 2], ST[4 * g4 + 3])}; }
            __syncthreads();
            if (n + 1 < SEGC) load_raw<true>(R, ws, row0 + CHUNK, (seg * SEGC + n + 1) * CHUNK, h, tid);
            const bf16* Gp = (const bf16*)(ws + R_G) + (size_t)(row0 + (tid >> 3)) * 1024 + h * 128 + (tid & 7) * 16;
            const uint4 g0 = *(const uint4*)Gp, g1 = *(const uint4*)(Gp + 8);
            f32x16 X0, X1;
#pragma unroll
            for (int e = 0; e < 16; ++e) { X0[e] = 0.f; X1[e] = 0.f; }
            const LAS bf16* kr = (const LAS bf16*)(lds + L_KR) + r * LS + 8 * hh; const LAS bf16* qr = (const LAS bf16*)(lds + L_QR) + (32 * wi + r) * LS + 8 * hh;
#pragma unroll
            for (int s = 0; s < 4; ++s) { const bf16x8 qb = ld8(qr + 16 * s); X0 = RMFMA(ld8(kr + 16 * s), qb, X0); X1 = RMFMA(ld8(kr + 32 * LS + 16 * s), qb, X1); }
#pragma unroll
            for (int e = 0; e < 16; ++e) { X0[e] *= mk0[e]; X1[e] *= mk1[e]; }
            f32x16 O;
#pragma unroll
            for (int e = 0; e < 16; ++e) O[e] = 0.f;
            const LAS bf16* stb = (const LAS bf16*)(lds + L_ST) + (32 * wd + r) * LS + 8 * hh;
#pragma unroll
            for (int s = 0; s < 4; ++s) O = RMFMA(ld8(qr + 16 * s), ld8(stb + 16 * s), O);
#pragma unroll
            for (int e = 0; e < 16; ++e) O[e] *= qdec[e];
            const LAS bf16* vt = (const LAS bf16*)(lds + L_VT) + (32 * wd + r) * LS + 4 * hh;
#pragma unroll
            for (int s = 0; s < 2; ++s) {
                bf16x8 pa, pb;
                { const unsigned w0 = cvtpk(X0[8 * s], X0[8 * s + 1]), w1 = cvtpk(X0[8 * s + 2], X0[8 * s + 3]), w2 = cvtpk(X0[8 * s + 4], X0[8 * s + 5]), w3 = cvtpk(X0[8 * s + 6], X0[8 * s + 7]);
                  const pg8::u32x4 p = {w0, w1, w2, w3}; pa = __builtin_bit_cast(bf16x8, p); }
                { const unsigned w0 = cvtpk(X1[8 * s], X1[8 * s + 1]), w1 = cvtpk(X1[8 * s + 2], X1[8 * s + 3]), w2 = cvtpk(X1[8 * s + 4], X1[8 * s + 5]), w3 = cvtpk(X1[8 * s + 6], X1[8 * s + 7]);
                  const pg8::u32x4 p = {w0, w1, w2, w3}; pb = __builtin_bit_cast(bf16x8, p); }
                const s16x4 a0 = *(const LAS s16x4*)(vt + 16 * s), a1 = *(const LAS s16x4*)(vt + 16 * s + 8), b0 = *(const LAS s16x4*)(vt + 32 + 16 * s), b1 = *(const LAS s16x4*)(vt + 32 + 16 * s + 8);
                O = RMFMA(pa, __builtin_shufflevector(a0, a1, 0, 1, 2, 3, 4, 5, 6, 7), O);
                O = RMFMA(pb, __builtin_shufflevector(b0, b1, 0, 1, 2, 3, 4, 5, 6, 7), O);
            }
            state_update(ST, lds, wi, wd, r, hh, cd);
            { LAS float* ob = (LAS float*)(lds + L_O) + (32 * wi + 4 * hh) * OS + 32 * wd + r;
#pragma unroll
              for (int e = 0; e < 16; ++e) ob[((e & 3) + 8 * (e >> 2)) * OS] = O[e]; }
            __syncthreads();
            { const int i = tid >> 3, c0 = (tid & 7) * 16; const LAS float* orow = (const LAS float*)(lds + L_O) + i * OS + c0;
              float o[16];
#pragma unroll
              for (int q4 = 0; q4 < 4; ++q4) { const f32x4 t4 = *(const LAS f32x4*)(orow + 4 * q4); o[4 * q4] = t4[0]; o[4 * q4 + 1] = t4[1]; o[4 * q4 + 2] = t4[2]; o[4 * q4 + 3] = t4[3]; }
              float sm = 0.f;
#pragma unroll
              for (int c = 0; c < 16; ++c) sm += o[c];
              sm += xshfl<1>(sm); sm += xshfl<2>(sm); sm += xshfl<4>(sm);
              const float mean = sm * (1.f / 128.f); float qq = 0.f;
#pragma unroll
              for (int c = 0; c < 16; ++c) { o[c] -= mean; qq += o[c] * o[c]; }
              qq += xshfl<1>(qq); qq += xshfl<2>(qq); qq += xshfl<4>(qq);
              const float rstd = rsqrtf(qq * (1.f / 128.f) + HN_EPS);
              const unsigned gw[8] = {g0.x, g0.y, g0.z, g0.w, g1.x, g1.y, g1.z, g1.w}; unsigned ow[8];
#pragma unroll
              for (int e = 0; e < 8; ++e) ow[e] = cvtpk(bflo(gw[e]) * o[2 * e] * rstd, bfhi(gw[e]) * o[2 * e + 1] * rstd);
              bf16* Ap = (bf16*)(ws + R_V) + (size_t)(row0 + i) * 1024 + h * 128 + c0;
              *(uint4*)Ap = make_uint4(ow[0], ow[1], ow[2], ow[3]); *(uint4*)(Ap + 8) = make_uint4(ow[4], ow[5], ow[6], ow[7]); }
        }
    }
    __syncthreads();
}
}

namespace s5 {
using ret::bf16x8; using ret::s16x4; using ret::f32x16; using ret::cvtpk; using ret::crow;
typedef short v4i16_t __attribute__((ext_vector_type(4)));
DEV s16x4 trr(const LAS unsigned char* p) { return __builtin_bit_cast(s16x4, __builtin_amdgcn_ds_read_tr16_b64_v4i16((LAS v4i16_t*)p)); }
struct Cx { float x, y; };
DEV Cx cmul(Cx a, Cx b) { return {a.x * b.x - a.y * b.y, a.x * b.y + a.y * b.x}; }
DEV Cx cfma(Cx a, Cx b, Cx c) { return {a.x * b.x - a.y * b.y + c.x, a.x * b.y + a.y * b.x + c.y}; }
DEV float shx32(float v) { return xshfl<32>(v); }

constexpr int SC = 4, NSG = NCH / SC;
template <bool OUT> DEV void pass(const int wbase, LAS unsigned char* lds, unsigned char* ws, const float* __restrict__ dsk, int layer, int G, int vcu) {
    const int wave = wbase >> 6;
    LAS unsigned char* img = lds + wave * 8192;
    bf16* U = (bf16*)(ws + R_U);
    for (int wi = vcu; wi < BATCH * NSG * (S5G / 8); wi += G) {
        const int lane = pg8::fresh_tid(wbase) & 63, r = lane & 31, hh = lane >> 5;
        const int oct = wi % (S5G / 8), sg = (wi / (S5G / 8)) % NSG, b = wi / ((S5G / 8) * NSG), g = oct * 8 + wave, lg = layer * S5G + g;
        const bf16* BBH = (const bf16*)(ws + TAB_BBH) + (size_t)lg * 128 * 16;
        bf16x8 bbf[4];
#pragma unroll
        for (int nt = 0; nt < 4; ++nt) bbf[nt] = *(const bf16x8*)(BBH + (32 * nt + r) * 16 + 8 * hh);
        Cx a1q[2], c[2];
#pragma unroll
        for (int q = 0; q < 2; ++q) {
            const float2 av = *(const float2*)((const float*)(ws + TAB_AB) + ((size_t)lg * S5N + 32 * q + r) * 2);
            a1q[q] = Cx{av.x, av.y}; c[q] = Cx{0.f, 0.f};
            if (OUT) { Cx ap = a1q[q];
#pragma unroll
                for (int sq = 0; sq < 8; ++sq) ap = cmul(ap, ap);
                const float2* E = (const float2*)(ws + WS_S5E) + ((size_t)(b * NSG) * S5G + g) * S5N + 32 * q + r;
                float2 ev[NSG - 1];
#pragma unroll
                for (int s = 0; s < NSG - 1; ++s) ev[s] = E[(size_t)s * S5G * S5N];
#pragma unroll
                for (int s = 0; s < NSG - 1; ++s) if (s < sg) c[q] = cfma(ap, c[q], Cx{ev[s].x, ev[s].y}); }
        }
        bf16x8 bd; LAS bf16x8* ctl = (LAS bf16x8*)(lds + 65536 + wave * 8192) + lane;
        if (OUT) { const bf16* CTH = (const bf16*)(ws + TAB_CTH) + ((size_t)lg * 16 + (r & 15)) * 128 + 8 * hh;
#pragma unroll
            for (int nt = 0; nt < 4; ++nt)
#pragma unroll
                for (int s = 0; s < 2; ++s) ctl[(nt * 2 + s) * 64] = *(const bf16x8*)(CTH + 32 * nt + 16 * s);
            const float dval = dsk[layer * 512 + g * 16 + (r & 15)];
#pragma unroll
            for (int e = 0; e < 8; ++e) bd[e] = (short)(((r & 15) == 8 * hh + e) ? f2bf(dval) : (bf16)0); }
        const int i16 = lane & 15, q4 = i16 >> 2, p4 = i16 & 3, blk = (lane >> 4) & 1;
        const int rowS = b * SEQ + sg * SC * 64;
        bf16x8 un[2];
#pragma unroll
        for (int th = 0; th < 2; ++th) un[th] = *(const bf16x8*)(U + (size_t)(rowS + 32 * th + r) * 512 + g * 16 + 8 * hh);
#pragma nounroll
        for (int jc = 0; jc < SC; ++jc) {
            const int row0 = rowS + jc * 64;
            bf16x8 ua[2]; ua[0] = un[0]; ua[1] = un[1];
            if (jc + 1 < SC) {
#pragma unroll
                for (int th = 0; th < 2; ++th) un[th] = *(const bf16x8*)(U + (size_t)(row0 + 64 + 32 * th + r) * 512 + g * 16 + 8 * hh); }
#pragma unroll
            for (int th = 0; th < 2; ++th) {
                f32x16 BU[4];
#pragma unroll
                for (int nt = 0; nt < 4; ++nt) { f32x16 z;
#pragma unroll
                    for (int e = 0; e < 16; ++e) z[e] = 0.f;
                    BU[nt] = RMFMA(ua[th], bbf[nt], z); }
#pragma unroll
                for (int q = 0; q < 2; ++q) {
                    const Cx a1 = a1q[q], a2 = cmul(a1, a1), a3 = cmul(a2, a1), a4 = cmul(a2, a2);
                    Cx cc = c[q];
#pragma unroll
                    for (int qb = 0; qb < 4; ++qb) {
                        f32x16& RE = BU[q]; f32x16& IM = BU[2 + q];
                        Cx x = {RE[4 * qb], IM[4 * qb]};
#pragma unroll
                        for (int i = 1; i < 4; ++i) x = cfma(a1, x, Cx{RE[4 * qb + i], IM[4 * qb + i]});
                        const Cx px = {shx32(x.x), shx32(x.y)};
                        const Cx g0 = hh ? px : x, g1 = hh ? x : px;
                        const Cx c0 = cc; cc = cfma(a4, cc, g0); const Cx c1 = cc; cc = cfma(a4, cc, g1);
                        if (OUT) { Cx hx = hh ? c1 : c0;
#pragma unroll
                            for (int i = 0; i < 4; ++i) { hx = cfma(a1, hx, Cx{RE[4 * qb + i], IM[4 * qb + i]}); RE[4 * qb + i] = hx.x; IM[4 * qb + i] = hx.y; } }
                    }
                    c[q] = cc;
                }
                if (OUT) {
                    asm volatile("s_waitcnt lgkmcnt(0)" ::: "memory");
#pragma unroll
                    for (int nt = 0; nt < 4; ++nt)
#pragma unroll
                        for (int g4 = 0; g4 < 4; ++g4) { const f32x16& X = BU[nt];
                            *(LAS pg8::u32x2*)(img + nt * 2048 + r * 64 + 8 * (2 * g4 + hh)) = (pg8::u32x2){cvtpk(X[4 * g4], X[4 * g4 + 1]), cvtpk(X[4 * g4 + 2], X[4 * g4 + 3])}; }
                    asm volatile("s_waitcnt lgkmcnt(0)" ::: "memory");
                    f32x16 Y;
#pragma unroll
                    for (int e = 0; e < 16; ++e) Y[e] = 0.f;
#pragma unroll
                    for (int nt = 0; nt < 4; ++nt)
#pragma unroll
                        for (int s = 0; s < 2; ++s) {
                            const s16x4 lo = trr(img + nt * 2048 + (16 * s + 8 * hh + q4) * 64 + 8 * (4 * blk + p4));
                            const s16x4 hi = trr(img + nt * 2048 + (16 * s + 8 * hh + 4 + q4) * 64 + 8 * (4 * blk + p4));
                            const bf16x8 xa = __builtin_shufflevector(lo, hi, 0, 1, 2, 3, 4, 5, 6, 7);
                            Y = RMFMA(xa, ctl[(nt * 2 + s) * 64], Y);
                        }
                    Y = RMFMA(ua[th], bd, Y);
                    { const int up = r >> 4;
#pragma unroll
                      for (int e = 0; e < 8; ++e) { const float yv = up ? Y[8 + e] : Y[e]; const float u3 = yv * yv * yv;
                          const float zz = yv * __builtin_amdgcn_rcpf(1.f + __expf(-1.5957691216057308f * (yv + 0.044715f * u3)));
                          U[(size_t)(row0 + 32 * th + (e & 3) + 8 * ((e >> 2) + 2 * up) + 4 * hh) * 512 + g * 16 + (r & 15)] = f2bf(zz); } }
                }
            }
        }
        if (!OUT) {
            if (hh == 0) { float2* E = (float2*)(ws + WS_S5E) + ((size_t)(b * NSG + sg) * S5G + g) * S5N + r;
                E[0] = make_float2(c[0].x, c[0].y); E[32] = make_float2(c[1].x, c[1].y); }
        }
    }
    asm volatile("s_waitcnt lgkmcnt(0)" ::: "memory");
    __syncthreads();
}
}

__global__ void __launch_bounds__(NWAVES * 64, 2) mk_fwd(Args args_k) {
    extern __shared__ __attribute__((aligned(16))) unsigned char lds_raw[];
    LAS unsigned char* lds = (LAS unsigned char*)lds_raw;
    volatile LAS unsigned* MISC = (volatile LAS unsigned*)(lds + MISC_OFF);
    const int wbase = __builtin_amdgcn_readfirstlane((int)threadIdx.x) & ~63;
    const int G = gridDim.x;
    unsigned* ctl = (unsigned*)(args_k.ws + WS_CTL);
    { const int tid = pg8::fresh_tid(wbase); for (int u = tid; u < (LDS_BYTES - LDSCTL_OFF) / 4; u += NWAVES * 64) ((LAS unsigned*)(lds + LDSCTL_OFF))[u] = 0u; }
    __syncthreads();
    if (pg8::fresh_tid(wbase) == 0) { const unsigned b0 = blockIdx.x; MISC[8 + 4] = b0; MISC[8 + 5] = (G % 8 == 0) ? (b0 % 8u) * (unsigned)(G / 8) + b0 / 8u : b0; }
    __syncthreads();
    if ((args_k.ph_hi - args_k.ph_lo) > 1) (void)xcd_barrier_post(ctl + CW_BAR + args_k.bar_id * XCD_BAR_WORDS, MISC + 8, pg8::fresh_tid(wbase) == 0);
    const int ph_lo = args_k.ph_lo, ph_hi = args_k.ph_hi;
    bool rep_done = false; (void)rep_done;
    for (int ph = ph_lo; ph < ph_hi; ++ph) {
        const int l = ph > 0 ? (ph - 1) / NPL : 0, k = ph > 0 ? (ph - 1) % NPL : -1;
        unsigned moff = MISC_OFF + 32; asm volatile("" : "+s"(moff));
        const volatile LAS unsigned* MS = (const volatile LAS unsigned*)(lds + moff);
        const bool lok = __builtin_amdgcn_readfirstlane((int)MS[2]) != 0;
        const int bx = __builtin_amdgcn_readfirstlane((int)MS[4]), vcu = __builtin_amdgcn_readfirstlane((int)MS[5]);
        const __attribute__((address_space(4))) Args* ap = (const __attribute__((address_space(4))) Args*)__builtin_amdgcn_kernarg_segment_ptr(); asm volatile("" : "+s"(ap));
        const Args& args = *(const Args*)ap;
        unsigned char* ws = ap->ws;
        float* hA = ap->out; float* hB = (float*)(ws + WS_HB); bf16* hbf = (bf16*)(ws + WS_HBF);
        switch (k) {
        case -1: { ph::ProIn P{args.in[0], args.in[1], args.in[2], args.in[3], args.in[4], args.in[5], args.in[6], args.in[7], args.in[8], args.in[9], args.in[10], args.in[12], args.in[13], args.in[14], args.in[15], args.in[18], args.in[20], args.out};
            ph::prologue(wbase, lds, ws, P, G, vcu); } break;
        case K_PROJ: {
            pg8::Gemm g{hbf, (const bf16*)(ws + W_IN) + (size_t)l * INW * Dm, Dm}; pg8::StaticOrder S; S.init(T, INW, Dm, G, bx);
            epi::EpiProj E{ws}; pg8::gemm_phase<Dm, epi::EpiProj, pg8::StaticOrder, true>(wbase, lds + RING_OFF, lds + PARK_OFF, g, S, E); } break;
        case K_RETA: ret::phase_a(wbase, lds, ws, G, vcu); s5::pass<false>(wbase, lds, ws, nullptr, l, G, vcu); break;
        case K_RETB: ret::phase_b(wbase, lds, ws, G, vcu); s5::pass<true>(wbase, lds, ws, ap->in[11], l, G, vcu); break;
        case K_BRANCH: {
            { pg8::Gemm g{(const bf16*)(ws + R_V), (const bf16*)(ws + W_BRET) + (size_t)l * Dm * RV, RV}; pg8::StaticOrder S; S.init(T, Dm, RV, G, bx);
              epi::EpiRet E{ws}; pg8::gemm_phase<RV, epi::EpiRet, pg8::StaticOrder, true>(wbase, lds + RING_OFF, lds + PARK_OFF, g, S, E); }
            { pg8::Gemm g{(const bf16*)(ws + R_U), (const bf16*)(ws + W_GLU) + (size_t)l * S5W * S5W, S5W}; pg8::StaticOrder S; S.init(T, S5W, S5W, G, bx);
              epi::EpiGlu E{ws}; pg8::gemm_phase<S5W, epi::EpiGlu, pg8::StaticOrder, true>(wbase, lds + RING_OFF, lds + PARK_OFF, g, S, E); } } break;
        case K_S5B: {
            pg8::Gemm g{(const bf16*)(ws + R_S5IN), (const bf16*)(ws + W_BS5) + (size_t)l * Dm * S5W, S5W}; pg8::StaticOrder S; S.init(T, Dm, S5W, G, bx);
            epi::EpiS5b E{ws}; pg8::gemm_phase<S5W, epi::EpiS5b, pg8::StaticOrder, true>(wbase, lds + RING_OFF, lds + PARK_OFF, g, S, E); } break;
        case K_OUT: {
            pg8::Gemm g{(const bf16*)(ws + R_G), (const bf16*)(ws + W_OUT) + (size_t)l * Dm * Dm, Dm}; pg8::StaticOrder S; S.init(T, Dm, Dm, G, bx);
            epi::EpiOut E{hbf, (bf16*)hB}; pg8::gemm_phase<Dm, epi::EpiOut, pg8::StaticOrder, true>(wbase, lds + RING_OFF, lds + PARK_OFF, g, S, E); } break;
        case K_LNROUTE: { ph::RouteIn P{args.in[16] + l * Dm, args.in[17] + l * Dm, args.in[19] + l * MG, args.in[21] + l * NE, args.in[22] + (size_t)l * NE * Dm * FF, args.in[23] + (size_t)l * NE * Dm * FF, args.in[24] + (size_t)l * NE * FF * Dm};
            ph::phase_lnroute(wbase, lds, ws, P, l, G, vcu); } break;
        case K_MOEGU: case K_MOEDN: {
            LAS unsigned* tp = (LAS unsigned*)(lds + LDSCTL_OFF + 512);
            const int tid = pg8::fresh_tid(wbase);
            if (tid < 32) tp[33 + tid] = __hip_atomic_load((unsigned*)(ws + WS_CNT) + l * NE + tid, __ATOMIC_RELAXED, __HIP_MEMORY_SCOPE_AGENT);
            __syncthreads();
            if (tid == 0) { unsigned a = 0; for (int j = 0; j < 32; ++j) { tp[j] = a; a += (tp[33 + j] + 255u) >> 8; } tp[32] = a; }
            __syncthreads();
            const unsigned* LIST = (const unsigned*)(ws + RT_LIST);
            if (k == K_MOEGU) {
                pg8::Gemm g{hbf, (const bf16*)(ws + R_WGU), Dm}; pg8::GroupedOrder S{tp, LIST, 2, G, vcu, 1};
                epi::EpiMoeGU E{ws, LIST}; pg8::gemm_phase<Dm, epi::EpiMoeGU, pg8::GroupedOrder, true>(wbase, lds + RING_OFF, lds + PARK_OFF, g, S, E);
                { const int U = 2 * __builtin_amdgcn_readfirstlane((int)tp[32]), R2 = U > G ? (U - G < G ? U - G : G) : 0, W1 = G - R2;
                  if (W1 > 0 && vcu >= R2) { const int lane = pg8::fresh_tid(wbase) & 63, wv = wbase >> 6; LAS float* scr = (LAS float*)(lds + wv * 16384); constexpr int I_D = (FF / 64) * (Dm / 32);
                      const float* wd = ap->in[24] + (size_t)l * NE * FF * Dm;
                      for (int it = (vcu - R2) * NWAVES + wv; it < NE * I_D; it += W1 * NWAVES) { const int e = it / I_D, r = it % I_D;
                          ph::transpose_item(wd + (size_t)e * FF * Dm, FF, Dm, (bf16*)(ws + R_WDN) + (size_t)e * Dm * FF, 1, 0, scr, r, lane); } }
                  else if (W1 <= 0) { const int lane = pg8::fresh_tid(wbase) & 63, wv = wbase >> 6; LAS float* scr = (LAS float*)(lds + wv * 16384); constexpr int I_D = (FF / 64) * (Dm / 32);
                      const float* wd = ap->in[24] + (size_t)l * NE * FF * Dm;
                      for (int it = bx * NWAVES + wv; it < NE * I_D; it += G * NWAVES) { const int e = it / I_D, r = it % I_D;
                          ph::transpose_item(wd + (size_t)e * FF * Dm, FF, Dm, (bf16*)(ws + R_WDN) + (size_t)e * Dm * FF, 1, 0, scr, r, lane); } }
                  __syncthreads(); }
            } else {
                pg8::Gemm g{(const bf16*)(ws + R_ACT), (const bf16*)(ws + R_WDN), FF}; pg8::GroupedOrder S{tp, LIST, 4, G, vcu, 0};
                epi::EpiMoeDN E{ws, LIST}; pg8::gemm_phase<FF, epi::EpiMoeDN, pg8::GroupedOrder, true>(wbase, lds + RING_OFF, lds + PARK_OFF, g, S, E);
            } } break;
        case K_LN2: ph::phase_ln2(wbase, ws, args.in[25] + l * Dm, args.in[26] + l * Dm, l == DEPTH - 1 ? args.out : nullptr, G, vcu); break;
        default: break;
        }
#ifdef PROBE_REP_MASK
        if (((k >= 0 && ((PROBE_REP_MASK >> k) & 1)) || (k < 0 && (PROBE_REP_MASK & 0x8000))) && !rep_done) { rep_done = true; --ph; } else rep_done = false;
#endif
        if (ph + 1 < ph_hi) { XcdBarrier bar; bar.bar = (unsigned*)(ws + WS_CTL) + CW_BAR + ap->bar_id * XCD_BAR_WORDS; bar.x = xb_xcc_id(); bar.st = (volatile LAS unsigned*)(lds + MISC_OFF) + 8;
            const bool local = lok && (k == K_PROJ || k == K_RETA || k == K_RETB || k == K_BRANCH || k == K_S5B || k == K_OUT);
            xcd_barrier(bar, pg8::fresh_tid(wbase) == 0, local); }
    }
}
#ifndef MK_ONE_LAUNCH
#define MK_ONE_LAUNCH 1
#endif
static int g_grid = 0;
static void launch_mk(const Args& base, int lo, int hi, int bar_id, hipStream_t stream) {
    Args a = base; a.ph_lo = lo; a.ph_hi = hi; a.bar_id = bar_id;
    hipLaunchKernelGGL(mk_fwd, dim3(g_grid), dim3(NWAVES * 64), LDS_BYTES, stream, a);
}
extern "C" void kernel_launch(void* const* d_in, const int* in_sizes, int n_in, void* d_out, int out_size, void* d_ws, size_t ws_size, hipStream_t stream) {
    static int ok = 0;
    if (ok == 0) {
        if (n_in != 27 || in_sizes[0] != T * Dm || out_size != T * Dm || ws_size < WS_END) { fprintf(stderr, "kernel_launch: unexpected shapes/ws (%d, %d, %d, %zu < %zu)\n", n_in, n_in > 0 ? in_sizes[0] : -1, out_size, ws_size, (size_t)WS_END); ok = -1; return; }
        int dev = 0, cus = 0;
        if (hipGetDevice(&dev) != hipSuccess || hipDeviceGetAttribute(&cus, hipDeviceAttributeMultiprocessorCount, dev) != hipSuccess) { fprintf(stderr, "kernel_launch: device query failed\n"); ok = -1; return; }
        if (hipFuncSetAttribute((const void*)mk_fwd, hipFuncAttributeMaxDynamicSharedMemorySize, LDS_BYTES) != hipSuccess) { fprintf(stderr, "kernel_launch: LDS attribute failed\n"); ok = -1; return; }
        g_grid = cus;
        ok = 1;
    }
    if (ok < 0) return;
    unsigned char* ws = (unsigned char*)d_ws;
    const float* const* in = (const float* const*)d_in;
    float* hA = (float*)d_out;
    (void)hipMemsetAsync(ws + WS_CTL, 0, 1 * MiB, stream);
    Args base{}; for (int i = 0; i < 27; ++i) base.in[i] = in[i]; base.out = hA; base.ws = ws;
#if MK_ONE_LAUNCH
    launch_mk(base, 0, NPH, 0, stream);
#else
    for (int p = 0; p < NPH; ++p) launch_mk(base, p, p + 1, 0, stream);
#endif
}
```

```cpp
#include <hip/hip_runtime.h>
#include <cstdio>
#include <cstdint>
#include <cmath>

typedef unsigned short bf16;
#define DEV __device__ __forceinline__

constexpr int Dm = 1024, BATCH = 8, SEQ = 2048, T = BATCH * SEQ, DEPTH = 2;
constexpr int CHUNK = 64, NCH = SEQ / CHUNK;
constexpr int RH = 8, RQK = 512, RV = 1024, DK = 64, DV = 128;
constexpr int S5W = 512, S5G = 32, S5GC = 16, S5N = 64;
constexpr int MG = 4, EPG = 8, NE = 32, FF = 256;
constexpr int INW = 5632;
constexpr float LN_EPS = 1e-5f, HN_EPS = 1e-6f;
constexpr float ALPHA = 1.41421356237309515f;

constexpr size_t MiB = 1u << 20;
constexpr size_t WS_CTL = 0;
constexpr size_t WS_CNT = 64 * 1024;
constexpr size_t WS_TAB = 1 * MiB;
constexpr size_t TAB_COS = WS_TAB;
constexpr size_t TAB_SIN = TAB_COS + 2048 * 32 * 4;
constexpr size_t TAB_POWG = TAB_SIN + 2048 * 32 * 4;
constexpr size_t TAB_AB = TAB_POWG + 8 * 80 * 4;
constexpr size_t TAB_BBH = TAB_AB + DEPTH * S5G * S5N * 2 * 4;
constexpr size_t TAB_CTH = TAB_BBH + (size_t)DEPTH * S5G * 128 * 16 * 2;
constexpr size_t TAB_WRT = TAB_CTH + (size_t)DEPTH * S5G * 16 * 128 * 2;
constexpr size_t TAB_WRH = TAB_WRT + (size_t)DEPTH * 36 * Dm * 4;
constexpr size_t TAB_WRL = TAB_WRH + (size_t)DEPTH * 48 * Dm * 2;
constexpr size_t TAB_END = TAB_WRL + (size_t)DEPTH * 48 * Dm * 2;
static_assert(TAB_END <= 3 * MiB, "tables");
constexpr size_t WS_S5E = 3 * MiB;
constexpr size_t WS_ROUTE = 7 * MiB;
constexpr size_t RT_E = WS_ROUTE, RT_C = RT_E + (size_t)T * 2 * 4, RT_LIST = RT_C + (size_t)T * 2 * 4;
static_assert(RT_LIST + (size_t)NE * T * 4 <= 10 * MiB, "route");
constexpr size_t WS_WSM = 10 * MiB;
constexpr size_t W_IN = WS_WSM;
constexpr size_t W_GLU = W_IN + (size_t)DEPTH * INW * Dm * 2;
constexpr size_t W_BRET = W_GLU + (size_t)DEPTH * S5W * S5W * 2;
constexpr size_t W_BS5 = W_BRET + (size_t)DEPTH * Dm * RV * 2;
constexpr size_t W_OUT = W_BS5 + (size_t)DEPTH * Dm * S5W * 2;
constexpr size_t W_END = W_OUT + (size_t)DEPTH * Dm * Dm * 2;
static_assert(W_END <= 44 * MiB, "small weights");
constexpr size_t WS_HB = 44 * MiB;
constexpr size_t WS_HBF = 108 * MiB;
constexpr size_t WS_R1 = 140 * MiB;
constexpr size_t R_Q = WS_R1, R_K = R_Q + 16 * MiB, R_U = R_K + 16 * MiB, R_GR = R_U + 16 * MiB, R_GS = R_GR + 32 * MiB;
constexpr size_t WS_R2 = 252 * MiB;
constexpr size_t R_V = WS_R2, R_G = R_V + 32 * MiB;
constexpr size_t WS_END = 316 * MiB;
constexpr size_t R_S5IN = R_Q;
constexpr size_t R_WGU = WS_R1;
constexpr size_t R_WDN = WS_R1 + 32 * MiB;
constexpr size_t R_ACT = WS_R1 + 48 * MiB;
constexpr size_t R_Y = WS_R2;

DEV float bf2f(bf16 v) { return __uint_as_float((unsigned)v << 16); }
DEV bf16 f2bf(float f) { unsigned u = __float_as_uint(f); return (bf16)((u + 0x7fffu + ((u >> 16) & 1u)) >> 16); }
DEV float sigmoidf_(float x) { return 1.f / (1.f + __expf(-x)); }
DEV float siluf_(float x) { return x * sigmoidf_(x); }
DEV float geluf_(float x) { const float c = 0.7978845608028654f; float t = tanhf(c * (x + 0.044715f * x * x * x)); return 0.5f * x * (1.f + t); }
template <int M> DEV float xshfl(float v) {
    if constexpr (M < 32) return __int_as_float(__builtin_amdgcn_ds_swizzle(__float_as_int(v), 0x1f | (M << 10)));
    else { const unsigned u = __float_as_uint(v); auto rr = __builtin_amdgcn_permlane32_swap(u, u, false, false);
           const bool hi = (__builtin_amdgcn_mbcnt_hi(~0u, __builtin_amdgcn_mbcnt_lo(~0u, 0u)) >= 32u); return __uint_as_float(hi ? rr[0] : rr[1]); }
}
template <int CTRL> DEV float dpp_add(float v) { return v + __int_as_float(__builtin_amdgcn_update_dpp(0, __float_as_int(v), CTRL, 0xf, 0xf, true)); }
DEV float wave_sum(float v) {
    v = dpp_add<0xB1>(v); v = dpp_add<0x4E>(v); v = dpp_add<0x141>(v); v = dpp_add<0x140>(v); v += xshfl<16>(v); v += xshfl<32>(v);
    return v;
}

namespace pg8 {
#define PG8_LAS __attribute__((address_space(3)))
typedef unsigned short bf16_t;
typedef short bf16x8 __attribute__((ext_vector_type(8)));
typedef float f32x4 __attribute__((ext_vector_type(4)));
typedef unsigned u32x4 __attribute__((ext_vector_type(4)));
typedef unsigned u32x2 __attribute__((ext_vector_type(2)));
typedef float f32x2 __attribute__((ext_vector_type(2)));
constexpr int BM = 256, BK = 64, HALF = 128, HTB = HALF * BK * 2  , STAGE_BYTES = 8 * HTB, NXCD = 8, WGM = 8;

__host__ __device__ __forceinline__ int lds_byte(int r, int c) { const int st = (r >> 4) * 2 + (c >> 5), rr = r & 15, cc = c & 31, ob = rr * 64 + cc * 2; return st * 1024 + (ob ^ (((ob >> 9) & 1) << 5)); }
__host__ __device__ __forceinline__ void stage_rc(int b, int& R, int& C) { const int st = b / 1024, sb = b % 1024, swz = sb ^ (((sb >> 9) & 1) << 5); R = (st >> 1) * 16 + swz / 64; C = (st & 1) * 32 + (swz % 64) / 2; }
__host__ __device__ __forceinline__ int perm32(int rho) { const int n = rho >> 4, i = rho & 15; return 8 * (i >> 2) + 4 * n + (i & 3); }

struct Unit { int pm, pn, pnb, e, cnt; };
struct Gemm { const bf16_t* A; const bf16_t* Bt; int K; };

struct StaticOrder {
    int nM, nN, nwg, G, c, K, pn0;
    __device__ void init(int M, int N, int K_, int G_, int c_, int pn0_ = 0) { nM = M / BM; nN = N / BM; nwg = nM * nN; G = G_; c = c_; K = K_; pn0 = pn0_; }
    __device__ bool next(int i, Unit& u) const {
        const long L = (long)i * G + c; if (L >= nwg) return false;
        int wgid = (int)L; { const int q = nwg / NXCD, r = nwg % NXCD, xcd = wgid % NXCD, off = wgid / NXCD; wgid = (xcd < r ? xcd * (q + 1) : r * (q + 1) + (xcd - r) * q) + off; }
        const int nig = WGM * nN, gid = wgid / nig, fm = gid * WGM, gsz = (nM - fm) < WGM ? (nM - fm) : WGM;
        u.pm = fm + ((wgid % nig) % gsz); u.pn = pn0 + (wgid % nig) / gsz; u.pnb = u.pn; u.e = 0; u.cnt = 0; return true;
    }
    static constexpr bool GATHER = false;
    __device__ __forceinline__ const unsigned* list_ptr(const Unit&, int) const { return nullptr; }
    __device__ __forceinline__ unsigned row_of(unsigned e) const { return e; }
};

__device__ __forceinline__ unsigned cvt_pk_bf16(float lo, float hi) { unsigned r; asm volatile("v_cvt_pk_bf16_f32 %0, %1, %2" : "=v"(r) : "v"(lo), "v"(hi)); return r; }

__device__ __forceinline__ int fresh_tid(int wbase) { int t = wbase + (int)__builtin_amdgcn_mbcnt_hi(~0u, __builtin_amdgcn_mbcnt_lo(~0u, 0u)); asm volatile("" : "+v"(t)); return t; }
template <int K, class Epi, class Sched, bool ALIGN_EPI = false>
__device__ __forceinline__ void gemm_phase(const int wbase, PG8_LAS unsigned char* lds, PG8_LAS unsigned char* park, const Gemm g, const Sched& S, const Epi& E) {
    constexpr bool GA = Sched::GATHER;
    const int wid = wbase >> 6, wr = wid >> 2, wc = wid & 3;
    const int tid = fresh_tid(wbase);
    constexpr int nt = K / BK; static_assert(K % 128 == 0 && K >= 256, "K");
    unsigned voffA[2], voffB[2];
#pragma unroll
    for (int i = 0; i < 2; ++i) { int R, C; stage_rc(tid * 16 + i * 8192, R, C); const int Rb = Epi::PERM ? ((R & ~31) + perm32(R & 31)) : R;
        voffA[i] = (unsigned)(R * K + C) * 2u; voffB[i] = (unsigned)(Rb * K + C) * 2u; }
#define PG8_RC(i, R, C) int R, C; stage_rc(fresh_tid(wbase) * 16 + (i) * 8192, R, C)
    const int kstep = BK * 2;
    const int hstep = HALF * K * 2;
    const int tstep = 2 * hstep;
    const __amdgpu_buffer_rsrc_t rsA = __builtin_amdgcn_make_buffer_rsrc((void*)g.A, 0, 0x7fffffff, 0x00020000);
    const __amdgpu_buffer_rsrc_t rsB = __builtin_amdgcn_make_buffer_rsrc((void*)g.Bt, 0, 0x7fffffff, 0x00020000);
    const unsigned ldsw = (unsigned)wid * 1024u;
    const int aoff = lds_byte(wr * 64 + (tid & 15), ((tid & 63) >> 4) * 8), boff = lds_byte(wc * 32 + (tid & 15), ((tid & 63) >> 4) * 8);
#define PG8_SA(b, h) (((b) * 2 + (h)) * HTB)
#define PG8_SB(b, h) ((4 + (b) * 2 + (h)) * HTB)
#define PG8_STAGE(bufoff, rs, voff, so) do { _Pragma("unroll") for (int _i = 0; _i < 2; ++_i) \
        __builtin_amdgcn_raw_ptr_buffer_load_lds(rs, (PG8_LAS void*)(lds + (bufoff) + ldsw + _i * 8192), 16, (int)(voff)[_i], (int)(so), 0, 0); } while (0)
#define PG8_STAGE_B(bufoff, so) PG8_STAGE(bufoff, rsB, voffB, so)
#define PG8_STAGE_A(bufoff, h, kb) do { if constexpr (GA) { if ((h) == 0) PG8_STAGE(bufoff, rsA, ao0, kb); else PG8_STAGE(bufoff, rsA, ao1, kb); } else { PG8_STAGE(bufoff, rsA, voffA, (kb) + (h) * hstep); } } while (0)
#define PG8_LDA(dst, b, h) do { _Pragma("unroll") for (int m = 0; m < 4; ++m) _Pragma("unroll") for (int k = 0; k < 2; ++k) dst[m][k] = *(const PG8_LAS bf16x8*)(lds + PG8_SA(b, h) + aoff + m * 2048 + k * 1024); } while (0)
#define PG8_LDB(dst, b, h) do { _Pragma("unroll") for (int n = 0; n < 2; ++n) _Pragma("unroll") for (int k = 0; k < 2; ++k) dst[n][k] = *(const PG8_LAS bf16x8*)(lds + PG8_SB(b, h) + boff + n * 2048 + k * 1024); } while (0)
#define PG8_MMA(ai, bj, At, Bt) do { __builtin_amdgcn_s_setprio(1); _Pragma("unroll") for (int m = 0; m < 4; ++m) _Pragma("unroll") for (int n = 0; n < 2; ++n) _Pragma("unroll") for (int k = 0; k < 2; ++k) \
        acc[ai][bj][m][n] = __builtin_amdgcn_mfma_f32_16x16x32_bf16(Bt[n][k], At[m][k], acc[ai][bj][m][n], 0, 0, 0); __builtin_amdgcn_s_setprio(0); } while (0)
#define PG8_WAIT_V(n) asm volatile("s_waitcnt vmcnt(" #n ")" ::: "memory")
#define PG8_WAIT_L(n) asm volatile("s_waitcnt lgkmcnt(" #n ")" ::: "memory")
#define PG8_BAR __builtin_amdgcn_s_barrier()
#define PG8_SCHED __builtin_amdgcn_sched_barrier(0)
    Unit cur, nxt; int ui = 0;
    if (!S.next(0, cur)) return;
    f32x4 acc[2][2][4][2];
#pragma unroll
    for (int a = 0; a < 2; ++a)
#pragma unroll
        for (int b = 0; b < 2; ++b)
#pragma unroll
            for (int m = 0; m < 4; ++m)
#pragma unroll
                for (int n = 0; n < 2; ++n) acc[a][b][m][n] = (f32x4){0.f, 0.f, 0.f, 0.f};
    bf16x8 At[4][2], B0[2][2], B1[2][2];
    unsigned ao0[2] = {0u, 0u}, ao1[2] = {0u, 0u};
    if constexpr (GA) {
#pragma unroll
        for (int i = 0; i < 2; ++i) { PG8_RC(i, R, C); ao0[i] = (S.row_of(*S.list_ptr(cur, R)) * (unsigned)K + (unsigned)C) * 2u; ao1[i] = (S.row_of(*S.list_ptr(cur, HALF + R)) * (unsigned)K + (unsigned)C) * 2u; }
    }
    int cA = GA ? 0 : cur.pm * tstep;
    int cB = cur.pnb * tstep;
    PG8_STAGE_B(PG8_SB(0, 0), cB); PG8_STAGE_B(PG8_SB(0, 1), cB + hstep); PG8_STAGE_A(PG8_SA(0, 0), 0, cA); PG8_STAGE_A(PG8_SA(0, 1), 1, cA);
    if (wr == 1) PG8_BAR;
    PG8_WAIT_V(2); PG8_BAR;
    PG8_STAGE_B(PG8_SB(1, 0), cB + kstep); PG8_STAGE_A(PG8_SA(1, 0), 0, cA + kstep); PG8_STAGE_B(PG8_SB(1, 1), cB + hstep + kstep);
    PG8_WAIT_V(6); PG8_BAR;
    for (;;) {
        const bool has_next = S.next(ui + 1, nxt);
        const int nA = (GA || !has_next) ? cA : nxt.pm * tstep; const int nB = has_next ? nxt.pnb * tstep : cB;
        if constexpr (GA) { if (has_next) {
#pragma unroll
            for (int s = 0; s < 4; ++s) { PG8_RC(s & 1, R, C); (void)C; __builtin_amdgcn_global_load_lds(S.list_ptr(nxt, (s >> 1) * HALF + R), (PG8_LAS unsigned*)(park + s * 2048 + wid * 256), 4, 0, 0); } } }
#define PG8_TRIP(LASTT) do { \
            const int a1 = cA + (t + 1) * kstep; \
            PG8_LDB(B0, 0, 0); PG8_LDB(B1, 0, 1); PG8_SCHED; PG8_LDA(At, 0, 0); PG8_STAGE_A(PG8_SA(1, 1), 1, a1); \
            if constexpr (GA && (LASTT)) { if (has_next) { _Pragma("unroll") for (int i = 0; i < 2; ++i) { PG8_RC(i, R, C); (void)R; const int t4 = fresh_tid(wbase) * 4; \
                ao0[i] = (S.row_of(*(const PG8_LAS unsigned*)(park + (0 + i) * 2048 + t4)) * (unsigned)K + (unsigned)C) * 2u; \
                ao1[i] = (S.row_of(*(const PG8_LAS unsigned*)(park + (2 + i) * 2048 + t4)) * (unsigned)K + (unsigned)C) * 2u; } } } \
            const int a2 = (LASTT) ? nA : cA + (t + 2) * kstep; const int b2 = (LASTT) ? nB : cB + (t + 2) * kstep; \
            const int a3 = a2 + kstep; const int b3 = b2 + kstep; \
            PG8_WAIT_V(8); PG8_WAIT_L(0); PG8_BAR; PG8_MMA(0, 0, At, B0); PG8_MMA(0, 1, At, B1); PG8_BAR; PG8_SCHED; \
            PG8_LDA(At, 0, 1); PG8_STAGE_B(PG8_SB(0, 0), b2); PG8_STAGE_B(PG8_SB(0, 1), b2 + hstep); PG8_STAGE_A(PG8_SA(0, 0), 0, a2); \
            PG8_WAIT_V(8); PG8_WAIT_L(0); PG8_BAR; PG8_MMA(1, 0, At, B0); PG8_MMA(1, 1, At, B1); PG8_BAR; PG8_SCHED; \
            PG8_LDB(B0, 1, 0); PG8_LDB(B1, 1, 1); PG8_SCHED; PG8_LDA(At, 1, 0); PG8_STAGE_A(PG8_SA(0, 1), 1, a2); \
            PG8_WAIT_V(8); PG8_WAIT_L(0); PG8_BAR; PG8_MMA(0, 0, At, B0); PG8_MMA(0, 1, At, B1); PG8_BAR; PG8_SCHED; \
            PG8_LDA(At, 1, 1); PG8_STAGE_B(PG8_SB(1, 0), b3); PG8_STAGE_B(PG8_SB(1, 1), b3 + hstep); PG8_STAGE_A(PG8_SA(1, 0), 0, a3); \
            PG8_WAIT_V(8); PG8_WAIT_L(0); PG8_BAR; PG8_MMA(1, 0, At, B0); PG8_MMA(1, 1, At, B1); PG8_BAR; PG8_SCHED; \
        } while (0)
        int t = 0; int ntm = nt - 2; asm volatile("" : "+s"(ntm));
        for (; t < ntm; t += 2) PG8_TRIP(false);
        PG8_TRIP(true);
#undef PG8_TRIP
        if constexpr (ALIGN_EPI) { if (wr == 0) PG8_BAR; }
        { const int te = fresh_tid(wbase); E(acc, cur, wr, wc, te & 15, (te & 63) >> 4); }
        if (!has_next) break;
#pragma unroll
        for (int a = 0; a < 2; ++a)
#pragma unroll
            for (int b = 0; b < 2; ++b)
#pragma unroll
                for (int m = 0; m < 4; ++m)
#pragma unroll
                    for (int n = 0; n < 2; ++n) acc[a][b][m][n] = (f32x4){0.f, 0.f, 0.f, 0.f};
        cur = nxt; cA = nA; cB = nB; ++ui;
        if constexpr (ALIGN_EPI) { if (wr == 1) PG8_BAR; }
    }
    PG8_WAIT_V(0);
    if constexpr (!ALIGN_EPI) { if (wr == 0) PG8_BAR; }
    PG8_BAR;
#undef PG8_SA
#undef PG8_SB
#undef PG8_STAGE
#undef PG8_STAGE_A
#undef PG8_STAGE_B
#undef PG8_RC
#undef PG8_LDA
#undef PG8_LDB
#undef PG8_MMA
#undef PG8_WAIT_V
#undef PG8_WAIT_L
#undef PG8_BAR
#undef PG8_SCHED
}
}
namespace epi {
using pg8::f32x4; using pg8::u32x4; using pg8::u32x2; using pg8::Unit; using pg8::cvt_pk_bf16;
DEV float fsig(float x) { return __builtin_amdgcn_rcpf(1.f + __expf(-x)); }
DEV void st16(void* p, const u32x4 v) { asm volatile("global_store_dwordx4 %0, %1, off sc1\n\ts_nop 1" :: "v"(p), "v"(v) : "memory"); }
DEV u32x4 pack8(const f32x4 a, const f32x4 b) { u32x4 w; w.x = cvt_pk_bf16(a[0], a[1]); w.y = cvt_pk_bf16(a[2], a[3]); w.z = cvt_pk_bf16(b[0], b[1]); w.w = cvt_pk_bf16(b[2], b[3]); return w; }
DEV void unpack8(const u32x4 w, f32x4& a, f32x4& b) {
    a[0] = __uint_as_float(w.x << 16); a[1] = __uint_as_float(w.x & 0xffff0000u); a[2] = __uint_as_float(w.y << 16); a[3] = __uint_as_float(w.y & 0xffff0000u);
    b[0] = __uint_as_float(w.z << 16); b[1] = __uint_as_float(w.z & 0xffff0000u); b[2] = __uint_as_float(w.w << 16); b[3] = __uint_as_float(w.w & 0xffff0000u); }
#define EPI_FOR8(...) _Pragma("unroll") for (int ai = 0; ai < 2; ++ai) _Pragma("unroll") for (int m = 0; m < 4; ++m) _Pragma("unroll") for (int bj = 0; bj < 2; ++bj) { \
        const int row = u.pm * 256 + ai * 128 + wr * 64 + m * 16 + fr; const int ct = bj * 128 + wc * 32 + 8 * fq; f32x4 v0 = acc[ai][bj][m][0], v1 = acc[ai][bj][m][1]; __VA_ARGS__ }

struct EpiProj {
    static constexpr bool PERM = true;
    unsigned char* ws;
    DEV void operator()(const f32x4 (&acc)[2][2][4][2], const Unit& u, int wr, int wc, int fr, int fq) const {
        const int pn = u.pn; bf16* base; int ld, c0, act; float sc = 1.f;
        if (pn < 2) { base = (bf16*)(ws + R_Q); ld = 512; c0 = pn * 256; act = 0; }
        else if (pn < 4) { base = (bf16*)(ws + R_K); ld = 512; c0 = (pn - 2) * 256; act = 0; sc = 0.125f; }
        else if (pn < 8) { base = (bf16*)(ws + R_V); ld = 1024; c0 = (pn - 4) * 256; act = 0; }
        else if (pn < 12) { base = (bf16*)(ws + R_G); ld = 1024; c0 = (pn - 8) * 256; act = 1; }
        else if (pn < 14) { base = (bf16*)(ws + R_U); ld = 512; c0 = (pn - 12) * 256; act = 0; }
        else if (pn < 18) { base = (bf16*)(ws + R_GR); ld = 1024; c0 = (pn - 14) * 256; act = 2; }
        else { base = (bf16*)(ws + R_GS); ld = 1024; c0 = (pn - 18) * 256; act = 2; }
        EPI_FOR8(
            if (act == 1) { _Pragma("unroll") for (int j = 0; j < 4; ++j) { v0[j] = v0[j] * fsig(v0[j]); v1[j] = v1[j] * fsig(v1[j]); } }
            else if (act == 2) { _Pragma("unroll") for (int j = 0; j < 4; ++j) { v0[j] = fsig(v0[j]); v1[j] = fsig(v1[j]); } }
            else { v0 = v0 * sc; v1 = v1 * sc; }
            st16(base + (size_t)row * ld + c0 + ct, pack8(v0, v1)); )
    }
};
#define EPI_OFF(m, bj, LD) ((size_t)(u.pm * 256 + ai * 128 + wr * 64 + (m) * 16 + fr) * (LD) + u.pn * 256 + (bj) * 128 + wc * 32 + 8 * fq)
struct EpiRet {
    static constexpr bool PERM = true;
    unsigned char* ws;
    DEV void operator()(const f32x4 (&acc)[2][2][4][2], const Unit& u, int wr, int wc, int fr, int fq) const {
        const bf16* GR = (const bf16*)(ws + R_GR); bf16* O = (bf16*)(ws + R_G);
#pragma unroll
        for (int ai = 0; ai < 2; ++ai) { u32x4 gv[4][2];
#pragma unroll
            for (int m = 0; m < 4; ++m)
#pragma unroll
                for (int bj = 0; bj < 2; ++bj) gv[m][bj] = *(const u32x4*)(GR + EPI_OFF(m, bj, 1024));
#pragma unroll
            for (int m = 0; m < 4; ++m)
#pragma unroll
                for (int bj = 0; bj < 2; ++bj) { f32x4 g0, g1; unpack8(gv[m][bj], g0, g1); st16(O + EPI_OFF(m, bj, 1024), pack8(acc[ai][bj][m][0] * g0, acc[ai][bj][m][1] * g1)); } }
    }
};
struct EpiGlu {
    static constexpr bool PERM = true;
    unsigned char* ws;
    DEV void operator()(const f32x4 (&acc)[2][2][4][2], const Unit& u, int wr, int wc, int fr, int fq) const {
        const bf16* Z = (const bf16*)(ws + R_U); bf16* O = (bf16*)(ws + R_S5IN);
#pragma unroll
        for (int ai = 0; ai < 2; ++ai) { u32x4 zv[4][2];
#pragma unroll
            for (int m = 0; m < 4; ++m)
#pragma unroll
                for (int bj = 0; bj < 2; ++bj) zv[m][bj] = *(const u32x4*)(Z + EPI_OFF(m, bj, 512));
#pragma unroll
            for (int m = 0; m < 4; ++m)
#pragma unroll
                for (int bj = 0; bj < 2; ++bj) { f32x4 z0, z1, v0 = acc[ai][bj][m][0], v1 = acc[ai][bj][m][1]; unpack8(zv[m][bj], z0, z1);
#pragma unroll
                    for (int q = 0; q < 4; ++q) { v0[q] = z0[q] * fsig(v0[q]); v1[q] = z1[q] * fsig(v1[q]); }
                    st16(O + EPI_OFF(m, bj, 512), pack8(v0, v1)); } }
    }
};
struct EpiS5b {
    static constexpr bool PERM = true;
    unsigned char* ws;
    DEV void operator()(const f32x4 (&acc)[2][2][4][2], const Unit& u, int wr, int wc, int fr, int fq) const {
        const bf16* GS = (const bf16*)(ws + R_GS); bf16* O = (bf16*)(ws + R_G);
#pragma unroll
        for (int ai = 0; ai < 2; ++ai) { u32x4 gv[4][2], pv[4][2];
#pragma unroll
            for (int m = 0; m < 4; ++m)
#pragma unroll
                for (int bj = 0; bj < 2; ++bj) { gv[m][bj] = *(const u32x4*)(GS + EPI_OFF(m, bj, 1024)); pv[m][bj] = *(const u32x4*)(O + EPI_OFF(m, bj, 1024)); }
#pragma unroll
            for (int m = 0; m < 4; ++m)
#pragma unroll
                for (int bj = 0; bj < 2; ++bj) { f32x4 g0, g1, p0, p1; unpack8(gv[m][bj], g0, g1); unpack8(pv[m][bj], p0, p1);
                    st16(O + EPI_OFF(m, bj, 1024), pack8(p0 + acc[ai][bj][m][0] * g0, p1 + acc[ai][bj][m][1] * g1)); } }
    }
};
struct EpiOut {
    static constexpr bool PERM = true;
    const bf16* hres; bf16* out;
    DEV void operator()(const f32x4 (&acc)[2][2][4][2], const Unit& u, int wr, int wc, int fr, int fq) const {
#pragma unroll
        for (int ai = 0; ai < 2; ++ai) { u32x4 hv[4][2];
#pragma unroll
            for (int m = 0; m < 4; ++m)
#pragma unroll
                for (int bj = 0; bj < 2; ++bj) hv[m][bj] = *(const u32x4*)(hres + EPI_OFF(m, bj, Dm));
#pragma unroll
            for (int m = 0; m < 4; ++m)
#pragma unroll
                for (int bj = 0; bj < 2; ++bj) { f32x4 h0, h1; unpack8(hv[m][bj], h0, h1); st16(out + EPI_OFF(m, bj, Dm), pack8(h0 * ALPHA + acc[ai][bj][m][0], h1 * ALPHA + acc[ai][bj][m][1])); } }
    }
};
}
namespace pg8 {
struct GroupedOrder {
    static constexpr bool GATHER = true;
    const PG8_LAS unsigned* tp; const unsigned* list; int NT, G, c, shift;
    __device__ bool next(int i, Unit& u) const {
        const unsigned total = (unsigned)__builtin_amdgcn_readfirstlane((int)tp[32]) * (unsigned)NT; const unsigned L = (unsigned)i * (unsigned)G + (unsigned)c;
        if (L >= total) return false;
        const unsigned mt = L / (unsigned)NT; int e = 0;
#pragma unroll
        for (int j = 1; j < 32; ++j) e += (mt >= tp[j]) ? 1 : 0;
        e = __builtin_amdgcn_readfirstlane(e);
        u.e = e; u.pm = (int)mt - __builtin_amdgcn_readfirstlane((int)tp[e]); u.pn = (int)(L % (unsigned)NT); u.pnb = e * NT + u.pn; u.cnt = __builtin_amdgcn_readfirstlane((int)tp[33 + e]); return true;
    }
    __device__ __forceinline__ const unsigned* list_ptr(const Unit& u, int r) const { int rr = u.pm * BM + r; rr = rr < u.cnt ? rr : u.cnt - 1; return list + (size_t)u.e * T + rr; }
    __device__ __forceinline__ unsigned row_of(unsigned e) const { return e >> shift; }
};
}
namespace epi {
struct EpiMoeGU {
    static constexpr bool PERM = true;
    unsigned char* ws; const unsigned* list;
    DEV void operator()(const f32x4 (&acc)[2][2][4][2], const Unit& u, int wr, int wc, int fr, int fq) const {
        bf16* ACT = (bf16*)(ws + R_ACT);
        unsigned pp[2][4];
#pragma unroll
        for (int ai = 0; ai < 2; ++ai)
#pragma unroll
            for (int m = 0; m < 4; ++m) { int r = u.pm * 256 + ai * 128 + wr * 64 + m * 16 + fr; r = r < u.cnt ? r : u.cnt - 1; pp[ai][m] = list[(size_t)u.e * T + r]; }
#pragma unroll
        for (int ai = 0; ai < 2; ++ai)
#pragma unroll
            for (int m = 0; m < 4; ++m) { const int r = u.pm * 256 + ai * 128 + wr * 64 + m * 16 + fr;
                if (r < u.cnt) { const unsigned p = pp[ai][m];
#pragma unroll
                    for (int bj = 0; bj < 2; ++bj) { const int f0 = u.pn * 128 + bj * 64 + wc * 16 + 4 * fq; const f32x4 v0 = acc[ai][bj][m][0], v1 = acc[ai][bj][m][1];
                        const float a0 = v0[0] * fsig(v0[0]) * v0[1], a1 = v0[2] * fsig(v0[2]) * v0[3], a2 = v1[0] * fsig(v1[0]) * v1[1], a3 = v1[2] * fsig(v1[2]) * v1[3];
                        u32x2 w; w.x = cvt_pk_bf16(a0, a1); w.y = cvt_pk_bf16(a2, a3); *(u32x2*)(ACT + (size_t)p * 256 + f0) = w; } } }
    }
};
struct EpiMoeDN {
    static constexpr bool PERM = true;
    unsigned char* ws; const unsigned* list;
    DEV void operator()(const f32x4 (&acc)[2][2][4][2], const Unit& u, int wr, int wc, int fr, int fq) const {
        bf16* Y = (bf16*)(ws + R_Y); const float* TC = (const float*)(ws + RT_C);
        unsigned pp[2][4]; float cw[2][4];
#pragma unroll
        for (int ai = 0; ai < 2; ++ai)
#pragma unroll
            for (int m = 0; m < 4; ++m) { int r = u.pm * 256 + ai * 128 + wr * 64 + m * 16 + fr; r = r < u.cnt ? r : u.cnt - 1; pp[ai][m] = list[(size_t)u.e * T + r]; }
#pragma unroll
        for (int ai = 0; ai < 2; ++ai)
#pragma unroll
            for (int m = 0; m < 4; ++m) cw[ai][m] = TC[pp[ai][m]];
#pragma unroll
        for (int ai = 0; ai < 2; ++ai)
#pragma unroll
            for (int m = 0; m < 4; ++m) { const int r = u.pm * 256 + ai * 128 + wr * 64 + m * 16 + fr;
                if (r < u.cnt) { const unsigned p = pp[ai][m]; const float c = cw[ai][m];
#pragma unroll
                    for (int bj = 0; bj < 2; ++bj) { const int d0 = u.pn * 256 + bj * 128 + wc * 32 + 8 * fq;
                        st16(Y + (size_t)p * Dm + d0, pack8(acc[ai][bj][m][0] * c, acc[ai][bj][m][1] * c)); } } }
    }
};
}
#define GAS __attribute__((address_space(1)))
#define LAS __attribute__((address_space(3)))
constexpr int NWAVES = 8;
constexpr int RING_OFF = 0, RING_BYTES = 131072;
constexpr int LDSCTL_OFF = RING_BYTES, MISC_OFF = LDSCTL_OFF + 320, PARK_OFF = RING_BYTES + 1024;
constexpr int LDS_BYTES = 147456;
constexpr int CW_TMO = 0, CW_CODE = 1, CW_BAR = 4096;

#define XB_TMO      128
#define XB_XCNT(j)  (256  + 64 * (j))
#define XB_XSUB(j)  (1280 + 64 * (j))
#define XB_XGEN(j)  (2304 + 64 * (j))
#define XB_TOP      3328
#define XB_TOPGEN   3392
#define XCD_BAR_WORDS 3456
#define XB_SPIN_CAP (1u << 18)
__device__ __forceinline__ unsigned xb_ld(unsigned* p)              { return __hip_atomic_load(p, __ATOMIC_RELAXED, __HIP_MEMORY_SCOPE_AGENT); }
__device__ __forceinline__ unsigned xb_add(unsigned* p, unsigned v) { return __hip_atomic_fetch_add(p, v, __ATOMIC_RELAXED, __HIP_MEMORY_SCOPE_AGENT); }
__device__ __forceinline__ unsigned xb_xcc_id() { return (unsigned)__builtin_amdgcn_s_getreg((3 << 11) | 20) & 0xFu; }
#define XB_SPIN(cond, bar) do { unsigned _sp = 0; while (cond) { __builtin_amdgcn_s_sleep(1); \
    if ((++_sp & 255u) == 0u) { if (xb_ld(&(bar)[XB_TMO])) break; if (_sp > XB_SPIN_CAP) { atomicAdd(&(bar)[XB_TMO], 1u); break; } } } } while (0)
struct XcdBarrier { unsigned* bar; unsigned x; volatile LAS unsigned* st; };
__device__ __forceinline__ XcdBarrier xcd_barrier_post(unsigned* bar, volatile LAS unsigned* st, bool t0) {
    XcdBarrier b; b.bar = bar; b.x = xb_xcc_id(); b.st = st;
    if (t0) st[3] = xb_add(&bar[XB_XCNT(b.x)], 1u);
    return b;
}
__device__ __forceinline__ void xcd_barrier_complete(unsigned* bar, unsigned x, unsigned& nloc, unsigned& nx) {
    const unsigned G = gridDim.x * gridDim.y * gridDim.z;
    unsigned sum, cnt, mine, sp = 0u;
    for (;;) {
        sum = 0u; cnt = 0u; mine = 0u;
#pragma unroll
        for (unsigned j = 0; j < 16; ++j) { const unsigned c = xb_ld(&bar[XB_XCNT(j)]); sum += c; cnt += (c > 0u) ? 1u : 0u; mine = (j == x) ? c : mine; }
        if (sum == G) break;
        __builtin_amdgcn_s_sleep(1);
        if ((++sp & 255u) == 0u) { if (xb_ld(&bar[XB_TMO])) break; if (sp > XB_SPIN_CAP) { atomicAdd(&bar[XB_TMO], 1u); break; } }
    }
    nloc = mine > 0u ? mine : 1u; nx = cnt > 0u ? cnt : 1u;
}
__device__ __forceinline__ void xcd_barrier(const XcdBarrier& b, bool t0, bool local) {
    asm volatile("s_waitcnt vmcnt(0)" ::: "memory");
    __syncthreads();
    if (t0) {
        unsigned* bar = b.bar;
        __builtin_amdgcn_s_waitcnt(0);
        unsigned nloc = b.st[0], nx = b.st[1];
        if (nloc == 0u) { xcd_barrier_complete(bar, b.x, nloc, nx); b.st[0] = nloc; b.st[1] = nx;
            const unsigned G = gridDim.x; unsigned even = (nx == 8u && (G & 7u) == 0u) ? 1u : 0u;
#pragma unroll
            for (unsigned j = 0; j < 8; ++j) even &= (xb_ld(&bar[XB_XCNT(j)]) == G / 8u) ? 1u : 0u;
            b.st[2] = even;
            if (even) { const unsigned rk = b.st[3]; b.st[4] = rk * 8u + b.x; b.st[5] = b.x * (G / 8u) + rk; } }
        const unsigned old = xb_add(&bar[XB_XSUB(b.x)], 1u);
        const unsigned gen = old / nloc;
        if (old + 1u == (gen + 1u) * nloc) {
            if (!local) {
            __builtin_amdgcn_fence(__ATOMIC_RELEASE, "agent");
            asm volatile("s_waitcnt vmcnt(0)" ::: "memory");
            const unsigned og = xb_add(&bar[XB_TOP], 1u);
            const unsigned tg = og / nx;
            if (og + 1u == (tg + 1u) * nx) xb_add(&bar[XB_TOPGEN], 1u);
            else XB_SPIN(xb_ld(&bar[XB_TOPGEN]) == tg, bar);
            }
            __builtin_amdgcn_fence(__ATOMIC_ACQUIRE, "agent");
            xb_add(&bar[XB_XGEN(b.x)], 1u);
            asm volatile("s_waitcnt vmcnt(0)" ::: "memory");
        } else {
            XB_SPIN(xb_ld(&bar[XB_XGEN(b.x)]) == gen, bar);
            __builtin_amdgcn_fence(__ATOMIC_ACQUIRE, "agent");
            asm volatile("s_waitcnt vmcnt(0)" ::: "memory");
        }
    }
    __syncthreads();
}

struct Args { const float* in[27]; float* out; unsigned char* ws; int ph_lo, ph_hi, bar_id, pad; };
constexpr int NPL = 10, NPH = 1 + DEPTH * NPL;
enum { K_PROJ = 0, K_RETA = 1, K_RETB = 2, K_BRANCH = 3, K_S5B = 4, K_OUT = 5, K_LNROUTE = 6, K_MOEGU = 7, K_MOEDN = 8, K_LN2 = 9 };
namespace ph {
#define LDSW() asm volatile("s_waitcnt lgkmcnt(0)" ::: "memory")
DEV int lane_id(int wbase) { return pg8::fresh_tid(wbase) & 63; }
DEV unsigned pk2(float lo, float hi) { return (unsigned)f2bf(lo) | ((unsigned)f2bf(hi) << 16); }
DEV void transpose_item(const float* __restrict__ W, int K, int N, bf16* __restrict__ WT, int rmul, int radd, LAS float* scr, int item, int lane) {
    const int nblk = N / 32, kb = item / nblk, nb = item % nblk, k0 = 64 * kb, n0 = 32 * nb;
#pragma unroll 8
    for (int i = 0; i < 32; ++i) { const int kk = 2 * i + (lane >> 5); scr[kk * 33 + (lane & 31)] = W[(size_t)(k0 + kk) * N + n0 + (lane & 31)]; }
    LDSW(); asm volatile("" ::: "memory");
    const int c = lane & 7;
#pragma unroll
    for (int j = 0; j < 4; ++j) { const int n = (lane >> 3) + 8 * j; const LAS float* s = scr + (8 * c) * 33 + n;
        uint4 o; o.x = pk2(s[0 * 33], s[1 * 33]); o.y = pk2(s[2 * 33], s[3 * 33]); o.z = pk2(s[4 * 33], s[5 * 33]); o.w = pk2(s[6 * 33], s[7 * 33]);
        *(uint4*)(WT + (size_t)((n0 + n) * rmul + radd) * K + k0 + 8 * c) = o; }
    LDSW(); asm volatile("" ::: "memory");
}
DEV void ln_row(const float* pre, const bf16* preb, float scale, const bf16* y2, const float* __restrict__ g, const float* __restrict__ b, float* of, bf16* ob, int lane, float (&v)[16]) {
    float s = 0.f;
    if (pre) {
#pragma unroll
        for (int j = 0; j < 4; ++j) { const float4 x = *(const float4*)(pre + j * 256 + lane * 4); v[4 * j] = x.x * scale; v[4 * j + 1] = x.y * scale; v[4 * j + 2] = x.z * scale; v[4 * j + 3] = x.w * scale; }
    } else {
#pragma unroll
        for (int j = 0; j < 4; ++j) { const uint2 a = *(const uint2*)(preb + j * 256 + lane * 4);
            v[4 * j] = __uint_as_float(a.x << 16) * scale; v[4 * j + 1] = __uint_as_float(a.x & 0xffff0000u) * scale; v[4 * j + 2] = __uint_as_float(a.y << 16) * scale; v[4 * j + 3] = __uint_as_float(a.y & 0xffff0000u) * scale; }
    }
    if (y2) {
#pragma unroll
        for (int j = 0; j < 4; ++j) { const uint2 a = *(const uint2*)(y2 + j * 256 + lane * 4), c = *(const uint2*)(y2 + Dm + j * 256 + lane * 4);
            v[4 * j] += __uint_as_float(a.x << 16) + __uint_as_float(c.x << 16); v[4 * j + 1] += __uint_as_float(a.x & 0xffff0000u) + __uint_as_float(c.x & 0xffff0000u);
            v[4 * j + 2] += __uint_as_float(a.y << 16) + __uint_as_float(c.y << 16); v[4 * j + 3] += __uint_as_float(a.y & 0xffff0000u) + __uint_as_float(c.y & 0xffff0000u); }
    }
#pragma unroll
    for (int i = 0; i < 16; ++i) s += v[i];
    const float mean = wave_sum(s) * (1.f / Dm); float q = 0.f;
#pragma unroll
    for (int i = 0; i < 16; ++i) { v[i] -= mean; q += v[i] * v[i]; }
    const float rstd = rsqrtf(wave_sum(q) * (1.f / Dm) + LN_EPS);
#pragma unroll
    for (int j = 0; j < 4; ++j) { const float4 gg = *(const float4*)(g + j * 256 + lane * 4), bb = *(const float4*)(b + j * 256 + lane * 4);
        float4 o; o.x = v[4 * j] * rstd * gg.x + bb.x; o.y = v[4 * j + 1] * rstd * gg.y + bb.y; o.z = v[4 * j + 2] * rstd * gg.z + bb.z; o.w = v[4 * j + 3] * rstd * gg.w + bb.w;
        v[4 * j] = o.x; v[4 * j + 1] = o.y; v[4 * j + 2] = o.z; v[4 * j + 3] = o.w;
        if (of) *(float4*)(of + j * 256 + lane * 4) = o;
        uint2 w; w.x = pk2(o.x, o.y); w.y = pk2(o.z, o.w); *(uint2*)(ob + j * 256 + lane * 4) = w; }
}

struct ProIn { const float *x, *lng, *lnb, *w_in, *lam_re, *lam_im, *log_step, *b_re, *b_im, *c_re, *c_im, *w_glu, *w_bret, *w_bs5, *w_out, *w_rg, *w_re; float* out; };
DEV void prologue(const int wbase, LAS unsigned char* lds, unsigned char* ws, const ProIn P, int G, int vcu) {
    const int wave = wbase >> 6, lane = lane_id(wbase), tid = wbase + lane;
    LAS float* scr = (LAS float*)(lds + wave * 16384);
    const int gw = vcu * NWAVES + wave, NGW = G * NWAVES;
    constexpr int I_IN = (Dm / 64) * (INW / 32), I_GLU = (S5W / 64) * (S5W / 32), I_BRET = (RV / 64) * (Dm / 32), I_BS5 = (S5W / 64) * (Dm / 32), I_OUT = (Dm / 64) * (Dm / 32);
    constexpr int I_L = I_IN + I_GLU + I_BRET + I_BS5 + I_OUT;
    for (int it = gw; it < DEPTH * I_L; it += NGW) {
        const int l = it / I_L; int r = it % I_L;
        if (r < I_IN) { transpose_item(P.w_in + (size_t)l * Dm * INW, Dm, INW, (bf16*)(ws + W_IN) + (size_t)l * INW * Dm, 1, 0, scr, r, lane); continue; } r -= I_IN;
        if (r < I_GLU) { transpose_item(P.w_glu + (size_t)l * S5W * S5W, S5W, S5W, (bf16*)(ws + W_GLU) + (size_t)l * S5W * S5W, 1, 0, scr, r, lane); continue; } r -= I_GLU;
        if (r < I_BRET) { transpose_item(P.w_bret + (size_t)l * RV * Dm, RV, Dm, (bf16*)(ws + W_BRET) + (size_t)l * Dm * RV, 1, 0, scr, r, lane); continue; } r -= I_BRET;
        if (r < I_BS5) { transpose_item(P.w_bs5 + (size_t)l * S5W * Dm, S5W, Dm, (bf16*)(ws + W_BS5) + (size_t)l * Dm * S5W, 1, 0, scr, r, lane); continue; } r -= I_BS5;
        transpose_item(P.w_out + (size_t)l * Dm * Dm, Dm, Dm, (bf16*)(ws + W_OUT) + (size_t)l * Dm * Dm, 1, 0, scr, r, lane);
    }
    const int gt = vcu * (NWAVES * 64) + tid, NGT = G * NWAVES * 64;
    float* COS = (float*)(ws + TAB_COS); float* SIN = (float*)(ws + TAB_SIN); float* POWG = (float*)(ws + TAB_POWG);
    float* AB = (float*)(ws + TAB_AB); bf16* BBH = (bf16*)(ws + TAB_BBH); bf16* CTH = (bf16*)(ws + TAB_CTH); float* WRT = (float*)(ws + TAB_WRT);
    for (int gid = gt; gid < 2048 * 32; gid += NGT) { const int pos = gid >> 5, i = gid & 31; const float inv = exp2f(-(float)i * (13.287712379549449f / 32.0f)); const float ang = (float)pos * inv;
        COS[gid] = cosf(ang); SIN[gid] = sinf(ang); }
    for (int gid = gt; gid < 8 * 80; gid += NGT) { const int h = gid / 80, n = gid % 80; const float lg = log1pf(-exp2f(-5.0f - (float)h)); POWG[gid] = expf(lg * (float)n); }
    for (int gid = gt; gid < DEPTH * S5G * S5N; gid += NGT) {
        const int g = (gid / S5N) % S5G, l = gid / (S5G * S5N);
        float lr = P.lam_re[gid]; if (lr > -1e-4f) lr = -1e-4f; const float li = P.lam_im[gid];
        const float step = expf(P.log_step[l * S5G + g]);
        const float em1 = expm1f(lr * step), mag = em1 + 1.f, ang = li * step, cs = cosf(ang), sn = sinf(ang), sh = sinf(0.5f * ang);
        const float abr = mag * cs, abi = mag * sn;
        const float nre = em1 * cs - 2.f * sh * sh;
        const float den = lr * lr + li * li;
        const float zr = (nre * lr + abi * li) / den, zi = (abi * lr - nre * li) / den;
        AB[gid * 2] = abr; AB[gid * 2 + 1] = abi;
        const int n = gid % S5N, lg = gid / S5N;
        for (int c = 0; c < 16; ++c) { const float br = P.b_re[(size_t)gid * 16 + c], bi = P.b_im[(size_t)gid * 16 + c];
            BBH[((size_t)lg * 128 + n) * 16 + c] = f2bf(zr * br - zi * bi); BBH[((size_t)lg * 128 + 64 + n) * 16 + c] = f2bf(zr * bi + zi * br); }
    }
    for (int gid = gt; gid < DEPTH * S5G * 16 * 128; gid += NGT) { const int np = gid & 127, lgc = gid >> 7;
        CTH[gid] = f2bf(np < 64 ? P.c_re[(size_t)lgc * 64 + np] : -P.c_im[(size_t)lgc * 64 + np - 64]); }
    for (int gid = gt; gid < DEPTH * 36 * Dm; gid += NGT) { const int kk = gid % Dm, j = (gid / Dm) % 36, l = gid / (36 * Dm);
        WRT[gid] = j < 4 ? P.w_rg[((size_t)l * Dm + kk) * MG + j] : P.w_re[((size_t)l * Dm + kk) * NE + (j - 4)]; }
    { bf16* WRH = (bf16*)(ws + TAB_WRH); bf16* WRL = (bf16*)(ws + TAB_WRL);
      for (int gid = gt; gid < DEPTH * 48 * Dm; gid += NGT) { const int kk = gid % Dm, j = (gid / Dm) % 48, l = gid / (48 * Dm);
          const float w = j < 4 ? P.w_rg[((size_t)l * Dm + kk) * MG + j] : (j < 36 ? P.w_re[((size_t)l * Dm + kk) * NE + (j - 4)] : 0.f);
          const bf16 hi = f2bf(w); WRH[gid] = hi; WRL[gid] = f2bf(w - bf2f(hi)); } }
    float v[16];
    for (int m = gw; m < T; m += NGW) ln_row(P.x + (size_t)m * Dm, nullptr, 1.f, nullptr, P.lng, P.lnb, nullptr, (bf16*)(ws + WS_HBF) + (size_t)m * Dm, lane, v);
}

struct RouteIn { const float *lng, *lnb, *brg, *bre, *wg, *wu, *wd; };
DEV void phase_lnroute(const int wbase, LAS unsigned char* lds, unsigned char* ws, const RouteIn P, int layer, int G, int vcu) {
    const int wave = wbase >> 6, lane = lane_id(wbase);
    const int gw = vcu * NWAVES + wave, NGW = G * NWAVES;
    const bf16* preb = (const bf16*)(ws + WS_HB); bf16* ob = (bf16*)(ws + WS_HBF);
    const float* WRT = (const float*)(ws + TAB_WRT) + (size_t)layer * 36 * Dm;
    const float* brg = P.brg; const float* bre = P.bre;
    int* TE = (int*)(ws + RT_E); float* TC = (float*)(ws + RT_C); int* LIST = (int*)(ws + RT_LIST); unsigned* CNT = (unsigned*)(ws + WS_CNT) + layer * NE;
    typedef short bf16x8 __attribute__((ext_vector_type(8))); typedef float f32x4 __attribute__((ext_vector_type(4)));
    constexpr int AS = 2064, A_LO = 16 * AS, PL_OFF = 2 * 16 * AS, LG_OFF = PL_OFF + 8 * 16 * 48 * 4, RT_OFF = LG_OFF + 16 * 48 * 4, CAP = 128;
    LAS unsigned* lcnt = (LAS unsigned*)(lds + RT_OFF); LAS unsigned* gbase = lcnt + 32; LAS int* le1 = (LAS int*)(gbase + 32); LAS int* le2 = le1 + CAP;
    LAS unsigned* lr1 = (LAS unsigned*)(le2 + CAP); LAS unsigned* lr2 = lr1 + CAP; LAS float* lc1 = (LAS float*)(lr2 + CAP); LAS float* lc2 = lc1 + CAP; LAS int* lrow = (LAS int*)(lc2 + CAP);
    static_assert(RT_OFF + 64 * 4 + 7 * CAP * 4 <= RING_BYTES, "lnroute LDS");
    const int tid = wbase + lane, fr = lane & 15, fq = lane >> 4;
    bf16x8 bh[3][4], bl[3][4];
    { const bf16* WRH = (const bf16*)(ws + TAB_WRH) + (size_t)layer * 48 * Dm; const bf16* WRL = (const bf16*)(ws + TAB_WRL) + (size_t)layer * 48 * Dm;
#pragma unroll
      for (int nt = 0; nt < 3; ++nt)
#pragma unroll
          for (int ks = 0; ks < 4; ++ks) { const size_t o = (size_t)(16 * nt + fr) * Dm + wave * 128 + ks * 32 + 8 * fq; bh[nt][ks] = *(const bf16x8*)(WRH + o); bl[nt][ks] = *(const bf16x8*)(WRL + o); } }
    if (tid < 32) lcnt[tid] = 0u;
    int nent = 0;
    __syncthreads();
    const bool contig = ((T / 16) % G) == 0; const int nbw = contig ? (T / 16) / G : ((T / 16) + G - 1) / G;
    for (int ib = 0; ib < nbw; ++ib) { const int blk = contig ? vcu * nbw + ib : vcu + ib * G; if (blk >= T / 16) break;
#pragma unroll
        for (int jr = 0; jr < 2; ++jr) { const int lr = 2 * wave + jr, row = blk * 16 + lr;
            float v[16];
            ln_row(nullptr, preb + (size_t)row * Dm, 1.f, nullptr, P.lng, P.lnb, nullptr, ob + (size_t)row * Dm, lane, v);
#pragma unroll
            for (int j = 0; j < 4; ++j) { unsigned hw[2], lw[2];
#pragma unroll
                for (int e2 = 0; e2 < 2; ++e2) { const float x0 = v[4 * j + 2 * e2], x1 = v[4 * j + 2 * e2 + 1]; const bf16 h0 = f2bf(x0), h1 = f2bf(x1);
                    hw[e2] = (unsigned)h0 | ((unsigned)h1 << 16); lw[e2] = (unsigned)f2bf(x0 - bf2f(h0)) | ((unsigned)f2bf(x1 - bf2f(h1)) << 16); }
                *(LAS pg8::u32x2*)(lds + lr * AS + (j * 256 + lane * 4) * 2) = (pg8::u32x2){hw[0], hw[1]};
                *(LAS pg8::u32x2*)(lds + A_LO + lr * AS + (j * 256 + lane * 4) * 2) = (pg8::u32x2){lw[0], lw[1]}; } }
        __syncthreads();
        f32x4 acc[3];
#pragma unroll
        for (int nt = 0; nt < 3; ++nt) acc[nt] = (f32x4){0.f, 0.f, 0.f, 0.f};
#pragma unroll
        for (int ks = 0; ks < 4; ++ks) { const int ao = fr * AS + (wave * 128 + ks * 32 + 8 * fq) * 2;
            const bf16x8 ah = *(const LAS bf16x8*)(lds + ao), al = *(const LAS bf16x8*)(lds + A_LO + ao);
#pragma unroll
            for (int nt = 0; nt < 3; ++nt) { acc[nt] = __builtin_amdgcn_mfma_f32_16x16x32_bf16(ah, bh[nt][ks], acc[nt], 0, 0, 0);
                acc[nt] = __builtin_amdgcn_mfma_f32_16x16x32_bf16(al, bh[nt][ks], acc[nt], 0, 0, 0); acc[nt] = __builtin_amdgcn_mfma_f32_16x16x32_bf16(ah, bl[nt][ks], acc[nt], 0, 0, 0); } }
        { LAS float* PL = (LAS float*)(lds + PL_OFF) + wave * 16 * 48;
#pragma unroll
          for (int nt = 0; nt < 3; ++nt)
#pragma unroll
              for (int rg = 0; rg < 4; ++rg) PL[(4 * fq + rg) * 48 + 16 * nt + fr] = acc[nt][rg]; }
        __syncthreads();
        for (int idx = tid; idx < 16 * 48; idx += NWAVES * 64) { const LAS float* PL = (const LAS float*)(lds + PL_OFF) + idx; float s = 0.f;
#pragma unroll
            for (int w = 0; w < 8; ++w) s += PL[w * 16 * 48];
            ((LAS float*)(lds + LG_OFF))[idx] = s; }
        __syncthreads();
        if (tid < 16) { const LAS float* LG = (const LAS float*)(lds + LG_OFF) + tid * 48; const int row = blk * 16 + tid;
            float lg[4];
#pragma unroll
            for (int kk = 0; kk < 4; ++kk) lg[kk] = LG[kk] + brg[kk];
            int gi = 0; float gm = lg[0];
#pragma unroll
            for (int kk = 1; kk < 4; ++kk) if (lg[kk] > gm) { gm = lg[kk]; gi = kk; }
            float den = 0.f;
#pragma unroll
            for (int kk = 0; kk < 4; ++kk) den += __expf(lg[kk] - gm);
            const float gtop = 1.f / den;
            int i1 = 0, i2 = 0; float m1 = -INFINITY, m2 = -INFINITY;
            for (int kk = 0; kk < 8; ++kk) { const float x = LG[4 + gi * 8 + kk] + bre[gi * 8 + kk];
                if (x > m1) { m2 = m1; i2 = i1; m1 = x; i1 = kk; } else if (x > m2) { m2 = x; i2 = kk; } }
            const float p2 = __expf(m2 - m1);
            const float w1 = 1.f / (1.f + p2), w2 = p2 / (1.f + p2);
            const int e1 = gi * 8 + i1, e2 = gi * 8 + i2, li = nent + tid;
            le1[li] = e1; le2[li] = e2; lc1[li] = gtop * w1; lc2[li] = gtop * w2; lrow[li] = row;
            lr1[li] = __hip_atomic_fetch_add(lcnt + e1, 1u, __ATOMIC_RELAXED, __HIP_MEMORY_SCOPE_WORKGROUP); lr2[li] = __hip_atomic_fetch_add(lcnt + e2, 1u, __ATOMIC_RELAXED, __HIP_MEMORY_SCOPE_WORKGROUP); }
        nent += 16;
        const bool last = (ib + 1 >= nbw) || (!contig && blk + G >= T / 16);
        if (nent == CAP || last) {
            __syncthreads();
            if (tid < 32) { const unsigned c = lcnt[tid]; gbase[tid] = c ? atomicAdd(&CNT[tid], c) : 0u; }
            __syncthreads();
            if (tid < nent) { const int row = lrow[tid], e1 = le1[tid], e2 = le2[tid];
                TE[row * 2] = e1; TE[row * 2 + 1] = e2; TC[row * 2] = lc1[tid]; TC[row * 2 + 1] = lc2[tid];
                LIST[(size_t)e1 * T + gbase[e1] + lr1[tid]] = row * 2; LIST[(size_t)e2 * T + gbase[e2] + lr2[tid]] = row * 2 + 1; }
            __syncthreads();
            if (tid < 32) lcnt[tid] = 0u;
            nent = 0;
        }
        __syncthreads();
    }
    LAS float* scr = (LAS float*)(lds + wave * 16384);
    constexpr int I_G = (Dm / 64) * (FF / 32);
    for (int it = gw; it < NE * 2 * I_G; it += NGW) {
        const int e = it / (2 * I_G); int r = it % (2 * I_G);
        if (r < I_G) { transpose_item(P.wg + (size_t)e * Dm * FF, Dm, FF, (bf16*)(ws + R_WGU) + (size_t)e * 512 * Dm, 2, 0, scr, r, lane); continue; } r -= I_G;
        transpose_item(P.wu + (size_t)e * Dm * FF, Dm, FF, (bf16*)(ws + R_WGU) + (size_t)e * 512 * Dm, 2, 1, scr, r, lane);
    }
}
DEV void phase_ln2(const int wbase, unsigned char* ws, const float* lng, const float* lnb, float* out, int G, int vcu) {
    const int wave = wbase >> 6, lane = lane_id(wbase);
    const int gw = vcu * NWAVES + wave, NGW = G * NWAVES;
    float v[16];
    for (int row = gw; row < T; row += NGW)
        ln_row(nullptr, (const bf16*)(ws + WS_HBF) + (size_t)row * Dm, ALPHA, (const bf16*)(ws + R_Y) + (size_t)(2 * row) * Dm, lng, lnb, out ? out + (size_t)row * Dm : nullptr, (bf16*)(ws + WS_HBF) + (size_t)row * Dm, lane, v);
}
}

namespace ret {
typedef short bf16x8 __attribute__((ext_vector_type(8)));
typedef short s16x4 __attribute__((ext_vector_type(4)));
typedef float f32x16 __attribute__((ext_vector_type(16)));
typedef float f32x4 __attribute__((ext_vector_type(4)));
typedef float f32x2_t __attribute__((ext_vector_type(2))); typedef __bf16 bf16x2_t __attribute__((ext_vector_type(2)));
DEV unsigned cvtpk(float lo, float hi) { f32x2_t v = {lo, hi}; bf16x2_t b = __builtin_convertvector(v, bf16x2_t); return __builtin_bit_cast(unsigned, b); }
#define RMFMA(a, b, c) __builtin_amdgcn_mfma_f32_32x32x16_bf16((a), (b), (c), 0, 0, 0)
constexpr int LS = 72;
constexpr int L_KR = 0, L_QR = 9216, L_KDT = 18432, L_VT = 27648, L_ST = 46080, L_O = 64512, OS = 132, L_END = L_O + 64 * OS * 4;
static_assert(L_END <= RING_BYTES, "retention LDS");
constexpr int SEGC = 8, NSEG = NCH / SEGC;
DEV int crow(int reg, int h) { return (reg & 3) + 8 * (reg >> 2) + 4 * h; }
DEV float bflo(unsigned w) { return __uint_as_float(w << 16); }
DEV float bfhi(unsigned w) { return __uint_as_float(w & 0xffff0000u); }

struct Raw { uint2 k1, k2, q1, q2; float4 cs, sn; uint4 v0, v1; };
template <bool WITH_Q> DEV void load_raw(Raw& R, const unsigned char* ws, int row0, int pos0, int h, int tid) {
    const int j = tid >> 3, c0 = (tid & 7) * 4;
    const bf16* K = (const bf16*)(ws + R_K) + (size_t)(row0 + j) * 512 + h * 64 + c0;
    R.k1 = *(const uint2*)K; R.k2 = *(const uint2*)(K + 32);
    if (WITH_Q) { const bf16* Q = (const bf16*)(ws + R_Q) + (size_t)(row0 + j) * 512 + h * 64 + c0; R.q1 = *(const uint2*)Q; R.q2 = *(const uint2*)(Q + 32); }
    R.cs = *(const float4*)((const float*)(ws + TAB_COS) + (pos0 + j) * 32 + c0); R.sn = *(const float4*)((const float*)(ws + TAB_SIN) + (pos0 + j) * 32 + c0);
    const bf16* V = (const bf16*)(ws + R_V) + (size_t)(row0 + j) * 1024 + h * 128 + (tid & 7) * 16;
    R.v0 = *(const uint4*)V; R.v1 = *(const uint4*)(V + 8);
}
DEV void rot4(const uint2 x1, const uint2 x2, const float4 cs, const float4 sn, float (&r1)[4], float (&r2)[4]) {
    const float a[4] = {bflo(x1.x), bfhi(x1.x), bflo(x1.y), bfhi(x1.y)}, b[4] = {bflo(x2.x), bfhi(x2.x), bflo(x2.y), bfhi(x2.y)};
    const float c[4] = {cs.x, cs.y, cs.z, cs.w}, s[4] = {sn.x, sn.y, sn.z, sn.w};
#pragma unroll
    for (int e = 0; e < 4; ++e) { r1[e] = a[e] * c[e] - b[e] * s[e]; r2[e] = a[e] * s[e] + b[e] * c[e]; }
}
template <bool WITH_Q> DEV void stage(LAS unsigned char* lds, const Raw& R, int tid, float kd) {
    const int j = tid >> 3, c0 = (tid & 7) * 4;
    float r1[4], r2[4];
    rot4(R.k1, R.k2, R.cs, R.sn, r1, r2);
    if (WITH_Q) { LAS bf16* kr = (LAS bf16*)(lds + L_KR) + j * LS + c0;
        *(LAS pg8::u32x2*)kr = (pg8::u32x2){cvtpk(r1[0], r1[1]), cvtpk(r1[2], r1[3])}; *(LAS pg8::u32x2*)(kr + 32) = (pg8::u32x2){cvtpk(r2[0], r2[1]), cvtpk(r2[2], r2[3])}; }
    LAS bf16* kdt = (LAS bf16*)(lds + L_KDT) + c0 * LS + j;
#pragma unroll
    for (int e = 0; e < 4; ++e) { kdt[e * LS] = f2bf(r1[e] * kd); kdt[(32 + e) * LS] = f2bf(r2[e] * kd); }
    if (WITH_Q) { rot4(R.q1, R.q2, R.cs, R.sn, r1, r2); LAS bf16* qr = (LAS bf16*)(lds + L_QR) + j * LS + c0;
        *(LAS pg8::u32x2*)qr = (pg8::u32x2){cvtpk(r1[0], r1[1]), cvtpk(r1[2], r1[3])}; *(LAS pg8::u32x2*)(qr + 32) = (pg8::u32x2){cvtpk(r2[0], r2[1]), cvtpk(r2[2], r2[3])}; }
    LAS bf16* vt = (LAS bf16*)(lds + L_VT) + ((tid & 7) * 16) * LS + j;
    const unsigned vw[8] = {R.v0.x, R.v0.y, R.v0.z, R.v0.w, R.v1.x, R.v1.y, R.v1.z, R.v1.w};
#pragma unroll
    for (int e = 0; e < 8; ++e) { vt[(2 * e) * LS] = (bf16)(vw[e] & 0xffffu); vt[(2 * e + 1) * LS] = (bf16)(vw[e] >> 16); }
}
DEV bf16x8 ld8(const LAS bf16* p) { return *(const LAS bf16x8*)p; }
DEV void state_update(f32x16& ST, const LAS unsigned char* lds, int wi, int wd, int r, int hh, float cd) {
#pragma unroll
    for (int e = 0; e < 16; ++e) ST[e] *= cd;
    const LAS bf16* a = (const LAS bf16*)(lds + L_KDT) + (32 * wi + r) * LS + 8 * hh; const LAS bf16* b = (const LAS bf16*)(lds + L_VT) + (32 * wd + r) * LS + 8 * hh;
#pragma unroll
    for (int s = 0; s < 4; ++s) ST = RMFMA(ld8(a + 16 * s), ld8(b + 16 * s), ST);
}

DEV void phase_a(const int wbase, LAS unsigned char* lds, unsigned char* ws, int G, int vcu) {
    const int wave = wbase >> 6, tid = pg8::fresh_tid(wbase), lane = tid & 63, r = lane & 31, hh = lane >> 5, wi = wave >> 2, wd = wave & 3;
    for (int item = vcu; item < BATCH * RH * NSEG; item += G) {
        const int seg = item % NSEG, h = (item / NSEG) % RH, b = item / (NSEG * RH);
        const float lg2g = log1pf(-__builtin_amdgcn_exp2f(-5.0f - (float)h)) * 1.4426950408889634f, cd = __builtin_amdgcn_exp2f(64.f * lg2g);
        f32x16 ST;
#pragma unroll
        for (int e = 0; e < 16; ++e) ST[e] = 0.f;
        const float kdj = __builtin_amdgcn_exp2f((float)(63 - (tid >> 3)) * lg2g);
        Raw R; load_raw<false>(R, ws, b * SEQ + seg * SEGC * CHUNK, seg * SEGC * CHUNK, h, tid);
#pragma nounroll
        for (int n = 0; n < SEGC; ++n) {
            __syncthreads();
            stage<false>(lds, R, tid, kdj);
            __syncthreads();
            if (n + 1 < SEGC) load_raw<false>(R, ws, b * SEQ + (seg * SEGC + n + 1) * CHUNK, (seg * SEGC + n + 1) * CHUNK, h, tid);
            state_update(ST, lds, wi, wd, r, hh, cd);
        }
        float* TOT = (float*)(ws + WS_HB) + (size_t)item * 8192 + wave * 1024 + lane;
#pragma unroll
        for (int e = 0; e < 16; ++e) TOT[e * 64] = ST[e];
    }
    __syncthreads();
}
DEV void phase_b(const int wbase, LAS unsigned char* lds, unsigned char* ws, int G, int vcu) {
    const int wave = wbase >> 6, tid = pg8::fresh_tid(wbase), lane = tid & 63, r = lane & 31, hh = lane >> 5, wi = wave >> 2, wd = wave & 3;
    for (int item = vcu; item < BATCH * RH * NSEG; item += G) {
        const int seg = item % NSEG, h = (item / NSEG) % RH, b = item / (NSEG * RH);
        const float lg2g = log1pf(-__builtin_amdgcn_exp2f(-5.0f - (float)h)) * 1.4426950408889634f, cd = __builtin_amdgcn_exp2f(64.f * lg2g), cd8 = __builtin_amdgcn_exp2f(64.f * SEGC * lg2g);
        f32x16 ST;
#pragma unroll
        for (int e = 0; e < 16; ++e) ST[e] = 0.f;
#pragma nounroll
        for (int s = 0; s < seg; ++s) { const float* TOT = (const float*)(ws + WS_HB) + (size_t)(item - seg + s) * 8192 + wave * 1024 + lane;
#pragma unroll
            for (int e = 0; e < 16; ++e) ST[e] = cd8 * ST[e] + TOT[e * 64]; }
        const float kdj = __builtin_amdgcn_exp2f((float)(63 - (tid >> 3)) * lg2g);
        Raw R; load_raw<true>(R, ws, b * SEQ + seg * SEGC * CHUNK, seg * SEGC * CHUNK, h, tid);
        float mk0[16], mk1[16], qdec[16];
        { const int lq = pg8::fresh_tid(wbase) & 63, iq = 32 * wi + (lq & 31), hq = lq >> 5;
#pragma unroll
          for (int e = 0; e < 16; ++e) { const int j0 = crow(e, hq), d0 = iq > j0 ? iq - j0 : j0 - iq, d1 = iq > j0 + 32 ? iq - j0 - 32 : j0 + 32 - iq;
              mk0[e] = __builtin_amdgcn_exp2f((float)d0 * lg2g); mk1[e] = __builtin_amdgcn_exp2f((float)d1 * lg2g); qdec[e] = __builtin_amdgcn_exp2f((float)(32 * wi + j0 + 1) * lg2g); } }
#pragma nounroll
        for (int n = 0; n < SEGC; ++n) {
            const int row0 = b * SEQ + (seg * SEGC + n) * CHUNK;
            stage<true>(lds, R, tid, kdj);
            { LAS bf16* st = (LAS bf16*)(lds + L_ST) + (32 * wd + r) * LS + 32 * wi + 4 * hh;
#pragma unroll
              for (int g4 = 0; g4 < 4; ++g4) *(LAS pg8::u32x2*)(st + 8 * g4) = (pg8::u32x2){cvtpk(ST[4 * g4], ST[4 * g4 + 1]), cvtpk(ST[4 * g4 + 2], ST[4 * g4 + 3])}; }
            __syncthreads();
            if (n + 1 < SEGC) load_raw<true>(R, ws, row0 + CHUNK, (seg * SEGC + n + 1) * CHUNK, h, tid);
            const bf16* Gp = (const bf16*)(ws + R_G) + (size_t)(row0 + (tid >> 3)) * 1024 + h * 128 + (tid & 7) * 16;
            const uint4 g0 = *(const uint4*)Gp, g1 = *(const uint4*)(Gp + 8);
            f32x16 X0, X1;
#pragma unroll
            for (int e = 0; e < 16; ++e) { X0[e] = 0.f; X1[e] = 0.f; }
            const LAS bf16* kr = (const LAS bf16*)(lds + L_KR) + r * LS + 8 * hh; const LAS bf16* qr = (const LAS bf16*)(lds + L_QR) + (32 * wi + r) * LS + 8 * hh;
#pragma unroll
            for (int s = 0; s < 4; ++s) { const bf16x8 qb = ld8(qr + 16 * s); X0 = RMFMA(ld8(kr + 16 * s), qb, X0); X1 = RMFMA(ld8(kr + 32 * LS + 16 * s), qb, X1); }
#pragma unroll
            for (int e = 0; e < 16; ++e) { X0[e] *= mk0[e]; X1[e] *= mk1[e]; }
            f32x16 O;
#pragma unroll
            for (int e = 0; e < 16; ++e) O[e] = 0.f;
            const LAS bf16* stb = (const LAS bf16*)(lds + L_ST) + (32 * wd + r) * LS + 8 * hh;
#pragma unroll
            for (int s = 0; s < 4; ++s) O = RMFMA(ld8(qr + 16 * s), ld8(stb + 16 * s), O);
#pragma unroll
            for (int e = 0; e < 16; ++e) O[e] *= qdec[e];
            const LAS bf16* vt = (const LAS bf16*)(lds + L_VT) + (32 * wd + r) * LS + 4 * hh;
#pragma unroll
            for (int s = 0; s < 2; ++s) {
                bf16x8 pa, pb;
                { const unsigned w0 = cvtpk(X0[8 * s], X0[8 * s + 1]), w1 = cvtpk(X0[8 * s + 2], X0[8 * s + 3]), w2 = cvtpk(X0[8 * s + 4], X0[8 * s + 5]), w3 = cvtpk(X0[8 * s + 6], X0[8 * s + 7]);
                  const pg8::u32x4 p = {w0, w1, w2, w3}; pa = __builtin_bit_cast(bf16x8, p); }
                { const unsigned w0 = cvtpk(X1[8 * s], X1[8 * s + 1]), w1 = cvtpk(X1[8 * s + 2], X1[8 * s + 3]), w2 = cvtpk(X1[8 * s + 4], X1[8 * s + 5]), w3 = cvtpk(X1[8 * s + 6], X1[8 * s + 7]);
                  const pg8::u32x4 p = {w0, w1, w2, w3}; pb = __builtin_bit_cast(bf16x8, p); }
                const s16x4 a0 = *(const LAS s16x4*)(vt + 16 * s), a1 = *(const LAS s16x4*)(vt + 16 * s + 8), b0 = *(const LAS s16x4*)(vt + 32 + 16 * s), b1 = *(const LAS s16x4*)(vt + 32 + 16 * s + 8);
                O = RMFMA(pa, __builtin_shufflevector(a0, a1, 0, 1, 2, 3, 4, 5, 6, 7), O);
                O = RMFMA(pb, __builtin_shufflevector(b0, b1, 0, 1, 2, 3, 4, 5, 6, 7), O);
            }
            state_update(ST, lds, wi, wd, r, hh, cd);
            { LAS float* ob = (LAS float*)(lds + L_O) + (32 * wi + 4 * hh) * OS + 32 * wd + r;
#pragma unroll
              for (int e = 0; e < 16; ++e) ob[((e & 3) + 8 * (e >> 2)) * OS] = O[e]; }
            __syncthreads();
            { const int i = tid >> 3, c0 = (tid & 7) * 16; const LAS float* orow = (const LAS float*)(lds + L_O) + i * OS + c0;
              float o[16];
#pragma unroll
              for (int q4 = 0; q4 < 4; ++q4) { const f32x4 t4 = *(const LAS f32x4*)(orow + 4 * q4); o[4 * q4] = t4[0]; o[4 * q4 + 1] = t4[1]; o[4 * q4 + 2] = t4[2]; o[4 * q4 + 3] = t4[3]; }
              float sm = 0.f;
#pragma unroll
              for (int c = 0; c < 16; ++c) sm += o[c];
              sm += xshfl<1>(sm); sm += xshfl<2>(sm); sm += xshfl<4>(sm);
              const float mean = sm * (1.f / 128.f); float qq = 0.f;
#pragma unroll
              for (int c = 0; c < 16; ++c) { o[c] -= mean; qq += o[c] * o[c]; }
              qq += xshfl<1>(qq); qq += xshfl<2>(qq); qq += xshfl<4>(qq);
              const float rstd = rsqrtf(qq * (1.f / 128.f) + HN_EPS);
              const unsigned gw[8] = {g0.x, g0.y, g0.z, g0.w, g1.x, g1.y, g1.z, g1.w}; unsigned ow[8];
#pragma unroll
              for (int e = 0; e < 8; ++e) ow[e] = cvtpk(bflo(gw[e]) * o[2 * e] * rstd, bfhi(gw[e]) * o[2 * e + 1] * rstd);
              bf16* Ap = (bf16*)(ws + R_V) + (size_t)(row0 + i) * 1024 + h * 128 + c0;
              *(uint4*)Ap = make_uint4(ow[0], ow[1], ow[2], ow[3]); *(uint4*)(Ap + 8) = make_uint4(ow[4], ow[5], ow[6], ow[7]); }
        }
    }
    __syncthreads();
}
}

namespace s5 {
using ret::bf16x8; using ret::s16x4; using ret::f32x16; using ret::cvtpk; using ret::crow;
typedef short v4i16_t __attribute__((ext_vector_type(4)));
DEV s16x4 trr(const LAS unsigned char* p) { return __builtin_bit_cast(s16x4, __builtin_amdgcn_ds_read_tr16_b64_v4i16((LAS v4i16_t*)p)); }
struct Cx { float x, y; };
DEV Cx cmul(Cx a, Cx b) { return {a.x * b.x - a.y * b.y, a.x * b.y + a.y * b.x}; }
DEV Cx cfma(Cx a, Cx b, Cx c) { return {a.x * b.x - a.y * b.y + c.x, a.x * b.y + a.y * b.x + c.y}; }
DEV float shx32(float v) { return xshfl<32>(v); }

constexpr int SC = 4, NSG = NCH / SC;
template <bool OUT> DEV void pass(const int wbase, LAS unsigned char* lds, unsigned char* ws, const float* __restrict__ dsk, int layer, int G, int vcu) {
    const int wave = wbase >> 6;
    LAS unsigned char* img = lds + wave * 8192;
    bf16* U = (bf16*)(ws + R_U);
    for (int wi = vcu; wi < BATCH * NSG * (S5G / 8); wi += G) {
        const int lane = pg8::fresh_tid(wbase) & 63, r = lane & 31, hh = lane >> 5;
        const int oct = wi % (S5G / 8), sg = (wi / (S5G / 8)) % NSG, b = wi / ((S5G / 8) * NSG), g = oct * 8 + wave, lg = layer * S5G + g;
        const bf16* BBH = (const bf16*)(ws + TAB_BBH) + (size_t)lg * 128 * 16;
        bf16x8 bbf[4];
#pragma unroll
        for (int nt = 0; nt < 4; ++nt) bbf[nt] = *(const bf16x8*)(BBH + (32 * nt + r) * 16 + 8 * hh);
        Cx a1q[2], c[2];
#pragma unroll
        for (int q = 0; q < 2; ++q) {
            const float2 av = *(const float2*)((const float*)(ws + TAB_AB) + ((size_t)lg * S5N + 32 * q + r) * 2);
            a1q[q] = Cx{av.x, av.y}; c[q] = Cx{0.f, 0.f};
            if (OUT) { Cx ap = a1q[q];
#pragma unroll
                for (int sq = 0; sq < 8; ++sq) ap = cmul(ap, ap);
                const float2* E = (const float2*)(ws + WS_S5E) + ((size_t)(b * NSG) * S5G + g) * S5N + 32 * q + r;
                float2 ev[NSG - 1];
#pragma unroll
                for (int s = 0; s < NSG - 1; ++s) ev[s] = E[(size_t)s * S5G * S5N];
#pragma unroll
                for (int s = 0; s < NSG - 1; ++s) if (s < sg) c[q] = cfma(ap, c[q], Cx{ev[s].x, ev[s].y}); }
        }
        bf16x8 bd; LAS bf16x8* ctl = (LAS bf16x8*)(lds + 65536 + wave * 8192) + lane;
        if (OUT) { const bf16* CTH = (const bf16*)(ws + TAB_CTH) + ((size_t)lg * 16 + (r & 15)) * 128 + 8 * hh;
#pragma unroll
            for (int nt = 0; nt < 4; ++nt)
#pragma unroll
                for (int s = 0; s < 2; ++s) ctl[(nt * 2 + s) * 64] = *(const bf16x8*)(CTH + 32 * nt + 16 * s);
            const float dval = dsk[layer * 512 + g * 16 + (r & 15)];
#pragma unroll
            for (int e = 0; e < 8; ++e) bd[e] = (short)(((r & 15) == 8 * hh + e) ? f2bf(dval) : (bf16)0); }
        const int i16 = lane & 15, q4 = i16 >> 2, p4 = i16 & 3, blk = (lane >> 4) & 1;
        const int rowS = b * SEQ + sg * SC * 64;
        bf16x8 un[2];
#pragma unroll
        for (int th = 0; th < 2; ++th) un[th] = *(const bf16x8*)(U + (size_t)(rowS + 32 * th + r) * 512 + g * 16 + 8 * hh);
#pragma nounroll
        for (int jc = 0; jc < SC; ++jc) {
            const int row0 = rowS + jc * 64;
            bf16x8 ua[2]; ua[0] = un[0]; ua[1] = un[1];
            if (jc + 1 < SC) {
#pragma unroll
                for (int th = 0; th < 2; ++th) un[th] = *(const bf16x8*)(U + (size_t)(row0 + 64 + 32 * th + r) * 512 + g * 16 + 8 * hh); }
#pragma unroll
            for (int th = 0; th < 2; ++th) {
                f32x16 BU[4];
#pragma unroll
                for (int nt = 0; nt < 4; ++nt) { f32x16 z;
#pragma unroll
                    for (int e = 0; e < 16; ++e) z[e] = 0.f;
                    BU[nt] = RMFMA(ua[th], bbf[nt], z); }
#pragma unroll
                for (int q = 0; q < 2; ++q) {
                    const Cx a1 = a1q[q], a2 = cmul(a1, a1), a3 = cmul(a2, a1), a4 = cmul(a2, a2);
                    Cx cc = c[q];
#pragma unroll
                    for (int qb = 0; qb < 4; ++qb) {
                        f32x16& RE = BU[q]; f32x16& IM = BU[2 + q];
                        Cx x = {RE[4 * qb], IM[4 * qb]};
#pragma unroll
                        for (int i = 1; i < 4; ++i) x = cfma(a1, x, Cx{RE[4 * qb + i], IM[4 * qb + i]});
                        const Cx px = {shx32(x.x), shx32(x.y)};
                        const Cx g0 = hh ? px : x, g1 = hh ? x : px;
                        const Cx c0 = cc; cc = cfma(a4, cc, g0); const Cx c1 = cc; cc = cfma(a4, cc, g1);
                        if (OUT) { Cx hx = hh ? c1 : c0;
#pragma unroll
                            for (int i = 0; i < 4; ++i) { hx = cfma(a1, hx, Cx{RE[4 * qb + i], IM[4 * qb + i]}); RE[4 * qb + i] = hx.x; IM[4 * qb + i] = hx.y; } }
                    }
                    c[q] = cc;
                }
                if (OUT) {
                    asm volatile("s_waitcnt lgkmcnt(0)" ::: "memory");
#pragma unroll
                    for (int nt = 0; nt < 4; ++nt)
#pragma unroll
                        for (int g4 = 0; g4 < 4; ++g4) { const f32x16& X = BU[nt];
                            *(LAS pg8::u32x2*)(img + nt * 2048 + r * 64 + 8 * (2 * g4 + hh)) = (pg8::u32x2){cvtpk(X[4 * g4], X[4 * g4 + 1]), cvtpk(X[4 * g4 + 2], X[4 * g4 + 3])}; }
                    asm volatile("s_waitcnt lgkmcnt(0)" ::: "memory");
                    f32x16 Y;
#pragma unroll
                    for (int e = 0; e < 16; ++e) Y[e] = 0.f;
#pragma unroll
                    for (int nt = 0; nt < 4; ++nt)
#pragma unroll
                        for (int s = 0; s < 2; ++s) {
                            const s16x4 lo = trr(img + nt * 2048 + (16 * s + 8 * hh + q4) * 64 + 8 * (4 * blk + p4));
                            const s16x4 hi = trr(img + nt * 2048 + (16 * s + 8 * hh + 4 + q4) * 64 + 8 * (4 * blk + p4));
                            const bf16x8 xa = __builtin_shufflevector(lo, hi, 0, 1, 2, 3, 4, 5, 6, 7);
                            Y = RMFMA(xa, ctl[(nt * 2 + s) * 64], Y);
                        }
                    Y = RMFMA(ua[th], bd, Y);
                    { const int up = r >> 4;
#pragma unroll
                      for (int e = 0; e < 8; ++e) { const float yv = up ? Y[8 + e] : Y[e]; const float u3 = yv * yv * yv;
                          const float zz = yv * __builtin_amdgcn_rcpf(1.f + __expf(-1.5957691216057308f * (yv + 0.044715f * u3)));
                          U[(size_t)(row0 + 32 * th + (e & 3) + 8 * ((e >> 2) + 2 * up) + 4 * hh) * 512 + g * 16 + (r & 15)] = f2bf(zz); } }
                }
            }
        }
        if (!OUT) {
            if (hh == 0) { float2* E = (float2*)(ws + WS_S5E) + ((size_t)(b * NSG + sg) * S5G + g) * S5N + r;
                E[0] = make_float2(c[0].x, c[0].y); E[32] = make_float2(c[1].x, c[1].y); }
        }
    }
    asm volatile("s_waitcnt lgkmcnt(0)" ::: "memory");
    __syncthreads();
}
}

__global__ void __launch_bounds__(NWAVES * 64, 2) mk_fwd(Args args_k) {
    extern __shared__ __attribute__((aligned(16))) unsigned char lds_raw[];
    LAS unsigned char* lds = (LAS unsigned char*)lds_raw;
    volatile LAS unsigned* MISC = (volatile LAS unsigned*)(lds + MISC_OFF);
    const int wbase = __builtin_amdgcn_readfirstlane((int)threadIdx.x) & ~63;
    const int G = gridDim.x;
    unsigned* ctl = (unsigned*)(args_k.ws + WS_CTL);
    { const int tid = pg8::fresh_tid(wbase); for (int u = tid; u < (LDS_BYTES - LDSCTL_OFF) / 4; u += NWAVES * 64) ((LAS unsigned*)(lds + LDSCTL_OFF))[u] = 0u; }
    __syncthreads();
    if (pg8::fresh_tid(wbase) == 0) { const unsigned b0 = blockIdx.x; MISC[8 + 4] = b0; MISC[8 + 5] = (G % 8 == 0) ? (b0 % 8u) * (unsigned)(G / 8) + b0 / 8u : b0; }
    __syncthreads();
    if ((args_k.ph_hi - args_k.ph_lo) > 1) (void)xcd_barrier_post(ctl + CW_BAR + args_k.bar_id * XCD_BAR_WORDS, MISC + 8, pg8::fresh_tid(wbase) == 0);
    const int ph_lo = args_k.ph_lo, ph_hi = args_k.ph_hi;
    bool rep_done = false; (void)rep_done;
    for (int ph = ph_lo; ph < ph_hi; ++ph) {
        const int l = ph > 0 ? (ph - 1) / NPL : 0, k = ph > 0 ? (ph - 1) % NPL : -1;
        unsigned moff = MISC_OFF + 32; asm volatile("" : "+s"(moff));
        const volatile LAS unsigned* MS = (const volatile LAS unsigned*)(lds + moff);
        const bool lok = __builtin_amdgcn_readfirstlane((int)MS[2]) != 0;
        const int bx = __builtin_amdgcn_readfirstlane((int)MS[4]), vcu = __builtin_amdgcn_readfirstlane((int)MS[5]);
        const __attribute__((address_space(4))) Args* ap = (const __attribute__((address_space(4))) Args*)__builtin_amdgcn_kernarg_segment_ptr(); asm volatile("" : "+s"(ap));
        const Args& args = *(const Args*)ap;
        unsigned char* ws = ap->ws;
        float* hA = ap->out; float* hB = (float*)(ws + WS_HB); bf16* hbf = (bf16*)(ws + WS_HBF);
        switch (k) {
        case -1: { ph::ProIn P{args.in[0], args.in[1], args.in[2], args.in[3], args.in[4], args.in[5], args.in[6], args.in[7], args.in[8], args.in[9], args.in[10], args.in[12], args.in[13], args.in[14], args.in[15], args.in[18], args.in[20], args.out};
            ph::prologue(wbase, lds, ws, P, G, vcu); } break;
        case K_PROJ: case K_BRANCH: {
            if (k == K_BRANCH) {
            { pg8::Gemm g{(const bf16*)(ws + R_V), (const bf16*)(ws + W_BRET) + (size_t)l * Dm * RV, RV}; pg8::StaticOrder S; S.init(T, Dm, RV, G, bx);
              epi::EpiRet E{ws}; pg8::gemm_phase<RV, epi::EpiRet, pg8::StaticOrder, true>(wbase, lds + RING_OFF, lds + PARK_OFF, g, S, E); }
            { pg8::Gemm g{(const bf16*)(ws + R_U), (const bf16*)(ws + W_GLU) + (size_t)l * S5W * S5W, S5W}; pg8::StaticOrder S; S.init(T, S5W, S5W, G, bx);
              epi::EpiGlu E{ws}; pg8::gemm_phase<S5W, epi::EpiGlu, pg8::StaticOrder, true>(wbase, lds + RING_OFF, lds + PARK_OFF, g, S, E); }
            }
            { const bool late = (k == K_BRANCH); const int hg = G / 2;
              pg8::Gemm g{hbf, (const bf16*)(ws + W_IN) + (size_t)l * INW * Dm, Dm}; pg8::StaticOrder S; S.init(T, late ? 512 : INW - 512, Dm, G, late ? (bx >= hg ? bx - hg : bx + G - hg) : bx, late ? (INW - 512) / 256 : 0);
              epi::EpiProj E{ws}; pg8::gemm_phase<Dm, epi::EpiProj, pg8::StaticOrder, true>(wbase, lds + RING_OFF, lds + PARK_OFF, g, S, E); } } break;
        case K_RETA: ret::phase_a(wbase, lds, ws, G, vcu); s5::pass<false>(wbase, lds, ws, nullptr, l, G, vcu); break;
        case K_RETB: ret::phase_b(wbase, lds, ws, G, vcu); s5::pass<true>(wbase, lds, ws, ap->in[11], l, G, vcu); break;
        case K_S5B: {
            pg8::Gemm g{(const bf16*)(ws + R_S5IN), (const bf16*)(ws + W_BS5) + (size_t)l * Dm * S5W, S5W}; pg8::StaticOrder S; S.init(T, Dm, S5W, G, bx);
            epi::EpiS5b E{ws}; pg8::gemm_phase<S5W, epi::EpiS5b, pg8::StaticOrder, true>(wbase, lds + RING_OFF, lds + PARK_OFF, g, S, E); } break;
        case K_OUT: {
            pg8::Gemm g{(const bf16*)(ws + R_G), (const bf16*)(ws + W_OUT) + (size_t)l * Dm * Dm, Dm}; pg8::StaticOrder S; S.init(T, Dm, Dm, G, bx);
            epi::EpiOut E{hbf, (bf16*)hB}; pg8::gemm_phase<Dm, epi::EpiOut, pg8::StaticOrder, true>(wbase, lds + RING_OFF, lds + PARK_OFF, g, S, E); } break;
        case K_LNROUTE: { ph::RouteIn P{args.in[16] + l * Dm, args.in[17] + l * Dm, args.in[19] + l * MG, args.in[21] + l * NE, args.in[22] + (size_t)l * NE * Dm * FF, args.in[23] + (size_t)l * NE * Dm * FF, args.in[24] + (size_t)l * NE * FF * Dm};
            ph::phase_lnroute(wbase, lds, ws, P, l, G, vcu); } break;
        case K_MOEGU: case K_MOEDN: {
            LAS unsigned* tp = (LAS unsigned*)(lds + LDSCTL_OFF + 512);
            const int tid = pg8::fresh_tid(wbase);
            if (tid < 32) tp[33 + tid] = __hip_atomic_load((unsigned*)(ws + WS_CNT) + l * NE + tid, __ATOMIC_RELAXED, __HIP_MEMORY_SCOPE_AGENT);
            __syncthreads();
            if (tid == 0) { unsigned a = 0; for (int j = 0; j < 32; ++j) { tp[j] = a; a += (tp[33 + j] + 255u) >> 8; } tp[32] = a; }
            __syncthreads();
            const unsigned* LIST = (const unsigned*)(ws + RT_LIST);
            if (k == K_MOEGU) {
                pg8::Gemm g{hbf, (const bf16*)(ws + R_WGU), Dm}; pg8::GroupedOrder S{tp, LIST, 2, G, vcu, 1};
                epi::EpiMoeGU E{ws, LIST}; pg8::gemm_phase<Dm, epi::EpiMoeGU, pg8::GroupedOrder, true>(wbase, lds + RING_OFF, lds + PARK_OFF, g, S, E);
                { const int U = 2 * __builtin_amdgcn_readfirstlane((int)tp[32]), R2 = U > G ? (U - G < G ? U - G : G) : 0, W1 = G - R2;
                  if (W1 > 0 && vcu >= R2) { const int lane = pg8::fresh_tid(wbase) & 63, wv = wbase >> 6; LAS float* scr = (LAS float*)(lds + wv * 16384); constexpr int I_D = (FF / 64) * (Dm / 32);
                      const float* wd = ap->in[24] + (size_t)l * NE * FF * Dm;
                      for (int it = (vcu - R2) * NWAVES + wv; it < NE * I_D; it += W1 * NWAVES) { const int e = it / I_D, r = it % I_D;
                          ph::transpose_item(wd + (size_t)e * FF * Dm, FF, Dm, (bf16*)(ws + R_WDN) + (size_t)e * Dm * FF, 1, 0, scr, r, lane); } }
                  else if (W1 <= 0) { const int lane = pg8::fresh_tid(wbase) & 63, wv = wbase >> 6; LAS float* scr = (LAS float*)(lds + wv * 16384); constexpr int I_D = (FF / 64) * (Dm / 32);
                      const float* wd = ap->in[24] + (size_t)l * NE * FF * Dm;
                      for (int it = bx * NWAVES + wv; it < NE * I_D; it += G * NWAVES) { const int e = it / I_D, r = it % I_D;
                          ph::transpose_item(wd + (size_t)e * FF * Dm, FF, Dm, (bf16*)(ws + R_WDN) + (size_t)e * Dm * FF, 1, 0, scr, r, lane); } }
                  __syncthreads(); }
            } else {
                pg8::Gemm g{(const bf16*)(ws + R_ACT), (const bf16*)(ws + R_WDN), FF}; pg8::GroupedOrder S{tp, LIST, 4, G, vcu, 0};
                epi::EpiMoeDN E{ws, LIST}; pg8::gemm_phase<FF, epi::EpiMoeDN, pg8::GroupedOrder, true>(wbase, lds + RING_OFF, lds + PARK_OFF, g, S, E);
            } } break;
        case K_LN2: ph::phase_ln2(wbase, ws, args.in[25] + l * Dm, args.in[26] + l * Dm, l == DEPTH - 1 ? args.out : nullptr, G, vcu); break;
        default: break;
        }
#ifdef PROBE_REP_MASK
        if (((k >= 0 && ((PROBE_REP_MASK >> k) & 1)) || (k < 0 && (PROBE_REP_MASK & 0x8000))) && !rep_done) { rep_done = true; --ph; } else rep_done = false;
#endif
        if (ph + 1 < ph_hi) { XcdBarrier bar; bar.bar = (unsigned*)(ws + WS_CTL) + CW_BAR + ap->bar_id * XCD_BAR_WORDS; bar.x = xb_xcc_id(); bar.st = (volatile LAS unsigned*)(lds + MISC_OFF) + 8;
            const bool local = lok && (k == K_PROJ || k == K_RETA || k == K_RETB || k == K_BRANCH || k == K_S5B || k == K_OUT);
            xcd_barrier(bar, pg8::fresh_tid(wbase) == 0, local); }
    }
}
#ifndef MK_ONE_LAUNCH
#define MK_ONE_LAUNCH 1
#endif
static int g_grid = 0;
static void launch_mk(const Args& base, int lo, int hi, int bar_id, hipStream_t stream) {
    Args a = base; a.ph_lo = lo; a.ph_hi = hi; a.bar_id = bar_id;
    hipLaunchKernelGGL(mk_fwd, dim3(g_grid), dim3(NWAVES * 64), LDS_BYTES, stream, a);
}
extern "C" void kernel_launch(void* const* d_in, const int* in_sizes, int n_in, void* d_out, int out_size, void* d_ws, size_t ws_size, hipStream_t stream) {
    static int ok = 0;
    if (ok == 0) {
        if (n_in != 27 || in_sizes[0] != T * Dm || out_size != T * Dm || ws_size < WS_END) { fprintf(stderr, "kernel_launch: unexpected shapes/ws (%d, %d, %d, %zu < %zu)\n", n_in, n_in > 0 ? in_sizes[0] : -1, out_size, ws_size, (size_t)WS_END); ok = -1; return; }
        int dev = 0, cus = 0;
        if (hipGetDevice(&dev) != hipSuccess || hipDeviceGetAttribute(&cus, hipDeviceAttributeMultiprocessorCount, dev) != hipSuccess) { fprintf(stderr, "kernel_launch: device query failed\n"); ok = -1; return; }
        if (hipFuncSetAttribute((const void*)mk_fwd, hipFuncAttributeMaxDynamicSharedMemorySize, LDS_BYTES) != hipSuccess) { fprintf(stderr, "kernel_launch: LDS attribute failed\n"); ok = -1; return; }
        g_grid = cus;
        ok = 1;
    }
    if (ok < 0) return;
    unsigned char* ws = (unsigned char*)d_ws;
    const float* const* in = (const float* const*)d_in;
    float* hA = (float*)d_out;
    (void)hipMemsetAsync(ws + WS_CTL, 0, 1 * MiB, stream);
    Args base{}; for (int i = 0; i < 27; ++i) base.in[i] = in[i]; base.out = hA; base.ws = ws;
#if MK_ONE_LAUNCH
    launch_mk(base, 0, NPH, 0, stream);
#else
    for (int p = 0; p < NPH; ++p) launch_mk(base, p, p + 1, 0, stream);
#endif
}
```

```cpp
#include <hip/hip_runtime.h>
#include <cstdio>
#include <cstdint>
#include <cmath>

typedef unsigned short bf16;
#define DEV __device__ __forceinline__

constexpr int Dm = 1024, BATCH = 8, SEQ = 2048, T = BATCH * SEQ, DEPTH = 2;
constexpr int CHUNK = 64, NCH = SEQ / CHUNK;
constexpr int RH = 8, RQK = 512, RV = 1024, DK = 64, DV = 128;
constexpr int S5W = 512, S5G = 32, S5GC = 16, S5N = 64;
constexpr int MG = 4, EPG = 8, NE = 32, FF = 256;
constexpr int INW = 5632;
constexpr float LN_EPS = 1e-5f, HN_EPS = 1e-6f;
constexpr float ALPHA = 1.41421356237309515f;

constexpr size_t MiB = 1u << 20;
constexpr size_t WS_CTL = 0;
constexpr size_t WS_CNT = 64 * 1024;
constexpr size_t WS_TAB = 1 * MiB;
constexpr size_t TAB_COS = WS_TAB;
constexpr size_t TAB_SIN = TAB_COS + 2048 * 32 * 4;
constexpr size_t TAB_POWG = TAB_SIN + 2048 * 32 * 4;
constexpr size_t TAB_AB = TAB_POWG + 8 * 80 * 4;
constexpr size_t TAB_BBH = TAB_AB + DEPTH * S5G * S5N * 2 * 4;
constexpr size_t TAB_CTH = TAB_BBH + (size_t)DEPTH * S5G * 128 * 16 * 2;
constexpr size_t TAB_WRT = TAB_CTH + (size_t)DEPTH * S5G * 16 * 128 * 2;
constexpr size_t TAB_WRH = TAB_WRT + (size_t)DEPTH * 36 * Dm * 4;
constexpr size_t TAB_WRL = TAB_WRH + (size_t)DEPTH * 48 * Dm * 2;
constexpr size_t TAB_END = TAB_WRL + (size_t)DEPTH * 48 * Dm * 2;
static_assert(TAB_END <= 3 * MiB, "tables");
constexpr size_t WS_S5E = 3 * MiB;
constexpr size_t WS_ROUTE = 7 * MiB;
constexpr size_t RT_E = WS_ROUTE, RT_C = RT_E + (size_t)T * 2 * 4, RT_LIST = RT_C + (size_t)T * 2 * 4;
static_assert(RT_LIST + (size_t)NE * T * 4 <= 10 * MiB, "route");
constexpr size_t WS_WSM = 10 * MiB;
constexpr size_t W_IN = WS_WSM;
constexpr size_t W_GLU = W_IN + (size_t)DEPTH * INW * Dm * 2;
constexpr size_t W_BRET = W_GLU + (size_t)DEPTH * S5W * S5W * 2;
constexpr size_t W_BS5 = W_BRET + (size_t)DEPTH * Dm * RV * 2;
constexpr size_t W_OUT = W_BS5 + (size_t)DEPTH * Dm * S5W * 2;
constexpr size_t W_END = W_OUT + (size_t)DEPTH * Dm * Dm * 2;
static_assert(W_END <= 44 * MiB, "small weights");
constexpr size_t WS_HB = 44 * MiB;
constexpr size_t WS_HBF = 108 * MiB;
constexpr size_t WS_R1 = 140 * MiB;
constexpr size_t R_Q = WS_R1, R_K = R_Q + 16 * MiB, R_U = R_K + 16 * MiB, R_GR = R_U + 16 * MiB, R_GS = R_GR + 32 * MiB;
constexpr size_t WS_R2 = 252 * MiB;
constexpr size_t R_V = WS_R2, R_G = R_V + 32 * MiB;
constexpr size_t WS_END = 316 * MiB;
constexpr size_t R_S5IN = R_Q;
constexpr size_t R_WGU = WS_R1;
constexpr size_t R_WDN = WS_R1 + 32 * MiB;
constexpr size_t R_ACT = WS_R1 + 48 * MiB;
constexpr size_t R_Y = WS_R2;

DEV float bf2f(bf16 v) { return __uint_as_float((unsigned)v << 16); }
DEV bf16 f2bf(float f) { unsigned u = __float_as_uint(f); return (bf16)((u + 0x7fffu + ((u >> 16) & 1u)) >> 16); }
DEV float sigmoidf_(float x) { return 1.f / (1.f + __expf(-x)); }
DEV float siluf_(float x) { return x * sigmoidf_(x); }
DEV float geluf_(float x) { const float c = 0.7978845608028654f; float t = tanhf(c * (x + 0.044715f * x * x * x)); return 0.5f * x * (1.f + t); }
template <int M> DEV float xshfl(float v) {
    if constexpr (M < 32) return __int_as_float(__builtin_amdgcn_ds_swizzle(__float_as_int(v), 0x1f | (M << 10)));
    else { const unsigned u = __float_as_uint(v); auto rr = __builtin_amdgcn_permlane32_swap(u, u, false, false);
           const bool hi = (__builtin_amdgcn_mbcnt_hi(~0u, __builtin_amdgcn_mbcnt_lo(~0u, 0u)) >= 32u); return __uint_as_float(hi ? rr[0] : rr[1]); }
}
template <int CTRL> DEV float dpp_add(float v) { return v + __int_as_float(__builtin_amdgcn_update_dpp(0, __float_as_int(v), CTRL, 0xf, 0xf, true)); }
DEV float wave_sum(float v) {
    v = dpp_add<0xB1>(v); v = dpp_add<0x4E>(v); v = dpp_add<0x141>(v); v = dpp_add<0x140>(v); v += xshfl<16>(v); v += xshfl<32>(v);
    return v;
}

namespace pg8 {
#define PG8_LAS __attribute__((address_space(3)))
typedef unsigned short bf16_t;
typedef short bf16x8 __attribute__((ext_vector_type(8)));
typedef float f32x4 __attribute__((ext_vector_type(4)));
typedef unsigned u32x4 __attribute__((ext_vector_type(4)));
typedef unsigned u32x2 __attribute__((ext_vector_type(2)));
typedef float f32x2 __attribute__((ext_vector_type(2)));
constexpr int BM = 256, BK = 64, HALF = 128, HTB = HALF * BK * 2  , STAGE_BYTES = 8 * HTB, NXCD = 8, WGM = 8;

__host__ __device__ __forceinline__ int lds_byte(int r, int c) { const int st = (r >> 4) * 2 + (c >> 5), rr = r & 15, cc = c & 31, ob = rr * 64 + cc * 2; return st * 1024 + (ob ^ (((ob >> 9) & 1) << 5)); }
__host__ __device__ __forceinline__ void stage_rc(int b, int& R, int& C) { const int st = b / 1024, sb = b % 1024, swz = sb ^ (((sb >> 9) & 1) << 5); R = (st >> 1) * 16 + swz / 64; C = (st & 1) * 32 + (swz % 64) / 2; }
__host__ __device__ __forceinline__ int perm32(int rho) { const int n = rho >> 4, i = rho & 15; return 8 * (i >> 2) + 4 * n + (i & 3); }

struct Unit { int pm, pn, pnb, e, cnt; };
struct Gemm { const bf16_t* A; const bf16_t* Bt; int K; };

struct StaticOrder {
    int nM, nN, nwg, G, c, K, pn0;
    __device__ void init(int M, int N, int K_, int G_, int c_, int pn0_ = 0) { nM = M / BM; nN = N / BM; nwg = nM * nN; G = G_; c = c_; K = K_; pn0 = pn0_; }
    __device__ bool next(int i, Unit& u) const {
        const long L = (long)i * G + c; if (L >= nwg) return false;
        int wgid = (int)L; { const int q = nwg / NXCD, r = nwg % NXCD, xcd = wgid % NXCD, off = wgid / NXCD; wgid = (xcd < r ? xcd * (q + 1) : r * (q + 1) + (xcd - r) * q) + off; }
        const int nig = WGM * nN, gid = wgid / nig, fm = gid * WGM, gsz = (nM - fm) < WGM ? (nM - fm) : WGM;
        u.pm = fm + ((wgid % nig) % gsz); u.pn = pn0 + (wgid % nig) / gsz; u.pnb = u.pn; u.e = 0; u.cnt = 0; return true;
    }
    static constexpr bool GATHER = false;
    __device__ __forceinline__ const unsigned* list_ptr(const Unit&, int) const { return nullptr; }
    __device__ __forceinline__ unsigned row_of(unsigned e) const { return e; }
};

__device__ __forceinline__ unsigned cvt_pk_bf16(float lo, float hi) { unsigned r; asm volatile("v_cvt_pk_bf16_f32 %0, %1, %2" : "=v"(r) : "v"(lo), "v"(hi)); return r; }

__device__ __forceinline__ int fresh_tid(int wbase) { int t = wbase + (int)__builtin_amdgcn_mbcnt_hi(~0u, __builtin_amdgcn_mbcnt_lo(~0u, 0u)); asm volatile("" : "+v"(t)); return t; }
template <int K, class Epi, class Sched, bool ALIGN_EPI = false>
__device__ __forceinline__ void gemm_phase(const int wbase, PG8_LAS unsigned char* lds, PG8_LAS unsigned char* park, const Gemm g, const Sched& S, const Epi& E) {
    constexpr bool GA = Sched::GATHER;
    const int wid = wbase >> 6, wr = wid >> 2, wc = wid & 3;
    const int tid = fresh_tid(wbase);
    constexpr int nt = K / BK; static_assert(K % 128 == 0 && K >= 256, "K");
    unsigned voffA[2], voffB[2];
#pragma unroll
    for (int i = 0; i < 2; ++i) { int R, C; stage_rc(tid * 16 + i * 8192, R, C); const int Rb = Epi::PERM ? ((R & ~31) + perm32(R & 31)) : R;
        voffA[i] = (unsigned)(R * K + C) * 2u; voffB[i] = (unsigned)(Rb * K + C) * 2u; }
#define PG8_RC(i, R, C) int R, C; stage_rc(fresh_tid(wbase) * 16 + (i) * 8192, R, C)
    const int kstep = BK * 2;
    const int hstep = HALF * K * 2;
    const int tstep = 2 * hstep;
    const __amdgpu_buffer_rsrc_t rsA = __builtin_amdgcn_make_buffer_rsrc((void*)g.A, 0, 0x7fffffff, 0x00020000);
    const __amdgpu_buffer_rsrc_t rsB = __builtin_amdgcn_make_buffer_rsrc((void*)g.Bt, 0, 0x7fffffff, 0x00020000);
    const unsigned ldsw = (unsigned)wid * 1024u;
    const int aoff = lds_byte(wr * 64 + (tid & 15), ((tid & 63) >> 4) * 8), boff = lds_byte(wc * 32 + (tid & 15), ((tid & 63) >> 4) * 8);
#define PG8_SA(b, h) (((b) * 2 + (h)) * HTB)
#define PG8_SB(b, h) ((4 + (b) * 2 + (h)) * HTB)
#define PG8_STAGE(bufoff, rs, voff, so) do { _Pragma("unroll") for (int _i = 0; _i < 2; ++_i) \
        __builtin_amdgcn_raw_ptr_buffer_load_lds(rs, (PG8_LAS void*)(lds + (bufoff) + ldsw + _i * 8192), 16, (int)(voff)[_i], (int)(so), 0, 0); } while (0)
#define PG8_STAGE_B(bufoff, so) PG8_STAGE(bufoff, rsB, voffB, so)
#define PG8_STAGE_A(bufoff, h, kb) do { if constexpr (GA) { if ((h) == 0) PG8_STAGE(bufoff, rsA, ao0, kb); else PG8_STAGE(bufoff, rsA, ao1, kb); } else { PG8_STAGE(bufoff, rsA, voffA, (kb) + (h) * hstep); } } while (0)
#define PG8_LDA(dst, b, h) do { _Pragma("unroll") for (int m = 0; m < 4; ++m) _Pragma("unroll") for (int k = 0; k < 2; ++k) dst[m][k] = *(const PG8_LAS bf16x8*)(lds + PG8_SA(b, h) + aoff + m * 2048 + k * 1024); } while (0)
#define PG8_LDB(dst, b, h) do { _Pragma("unroll") for (int n = 0; n < 2; ++n) _Pragma("unroll") for (int k = 0; k < 2; ++k) dst[n][k] = *(const PG8_LAS bf16x8*)(lds + PG8_SB(b, h) + boff + n * 2048 + k * 1024); } while (0)
#define PG8_MMA(ai, bj, At, Bt) do { __builtin_amdgcn_s_setprio(1); _Pragma("unroll") for (int m = 0; m < 4; ++m) _Pragma("unroll") for (int n = 0; n < 2; ++n) _Pragma("unroll") for (int k = 0; k < 2; ++k) \
        acc[ai][bj][m][n] = __builtin_amdgcn_mfma_f32_16x16x32_bf16(Bt[n][k], At[m][k], acc[ai][bj][m][n], 0, 0, 0); __builtin_amdgcn_s_setprio(0); } while (0)
#define PG8_WAIT_V(n) asm volatile("s_waitcnt vmcnt(" #n ")" ::: "memory")
#define PG8_WAIT_L(n) asm volatile("s_waitcnt lgkmcnt(" #n ")" ::: "memory")
#define PG8_BAR __builtin_amdgcn_s_barrier()
#define PG8_SCHED __builtin_amdgcn_sched_barrier(0)
    Unit cur, nxt; int ui = 0;
    if (!S.next(0, cur)) return;
    f32x4 acc[2][2][4][2];
#pragma unroll
    for (int a = 0; a < 2; ++a)
#pragma unroll
        for (int b = 0; b < 2; ++b)
#pragma unroll
            for (int m = 0; m < 4; ++m)
#pragma unroll
                for (int n = 0; n < 2; ++n) acc[a][b][m][n] = (f32x4){0.f, 0.f, 0.f, 0.f};
    bf16x8 At[4][2], B0[2][2], B1[2][2];
    unsigned ao0[2] = {0u, 0u}, ao1[2] = {0u, 0u};
    if constexpr (GA) {
#pragma unroll
        for (int i = 0; i < 2; ++i) { PG8_RC(i, R, C); ao0[i] = (S.row_of(*S.list_ptr(cur, R)) * (unsigned)K + (unsigned)C) * 2u; ao1[i] = (S.row_of(*S.list_ptr(cur, HALF + R)) * (unsigned)K + (unsigned)C) * 2u; }
    }
    int cA = GA ? 0 : cur.pm * tstep;
    int cB = cur.pnb * tstep;
    PG8_STAGE_B(PG8_SB(0, 0), cB); PG8_STAGE_B(PG8_SB(0, 1), cB + hstep); PG8_STAGE_A(PG8_SA(0, 0), 0, cA); PG8_STAGE_A(PG8_SA(0, 1), 1, cA);
    if (wr == 1) PG8_BAR;
    PG8_WAIT_V(2); PG8_BAR;
    PG8_STAGE_B(PG8_SB(1, 0), cB + kstep); PG8_STAGE_A(PG8_SA(1, 0), 0, cA + kstep); PG8_STAGE_B(PG8_SB(1, 1), cB + hstep + kstep);
    PG8_WAIT_V(6); PG8_BAR;
    for (;;) {
        const bool has_next = S.next(ui + 1, nxt);
        const int nA = (GA || !has_next) ? cA : nxt.pm * tstep; const int nB = has_next ? nxt.pnb * tstep : cB;
        if constexpr (GA) { if (has_next) {
#pragma unroll
            for (int s = 0; s < 4; ++s) { PG8_RC(s & 1, R, C); (void)C; __builtin_amdgcn_global_load_lds(S.list_ptr(nxt, (s >> 1) * HALF + R), (PG8_LAS unsigned*)(park + s * 2048 + wid * 256), 4, 0, 0); } } }
#define PG8_TRIP(LASTT) do { \
            const int a1 = cA + (t + 1) * kstep; \
            PG8_LDB(B0, 0, 0); PG8_LDB(B1, 0, 1); PG8_SCHED; PG8_LDA(At, 0, 0); PG8_STAGE_A(PG8_SA(1, 1), 1, a1); \
            if constexpr (GA && (LASTT)) { if (has_next) { _Pragma("unroll") for (int i = 0; i < 2; ++i) { PG8_RC(i, R, C); (void)R; const int t4 = fresh_tid(wbase) * 4; \
                ao0[i] = (S.row_of(*(const PG8_LAS unsigned*)(park + (0 + i) * 2048 + t4)) * (unsigned)K + (unsigned)C) * 2u; \
                ao1[i] = (S.row_of(*(const PG8_LAS unsigned*)(park + (2 + i) * 2048 + t4)) * (unsigned)K + (unsigned)C) * 2u; } } } \
            const int a2 = (LASTT) ? nA : cA + (t + 2) * kstep; const int b2 = (LASTT) ? nB : cB + (t + 2) * kstep; \
            const int a3 = a2 + kstep; const int b3 = b2 + kstep; \
            PG8_WAIT_V(8); PG8_WAIT_L(0); PG8_BAR; PG8_MMA(0, 0, At, B0); PG8_MMA(0, 1, At, B1); PG8_BAR; PG8_SCHED; \
            PG8_LDA(At, 0, 1); PG8_STAGE_B(PG8_SB(0, 0), b2); PG8_STAGE_B(PG8_SB(0, 1), b2 + hstep); PG8_STAGE_A(PG8_SA(0, 0), 0, a2); \
            PG8_WAIT_V(8); PG8_WAIT_L(0); PG8_BAR; PG8_MMA(1, 0, At, B0); PG8_MMA(1, 1, At, B1); PG8_BAR; PG8_SCHED; \
            PG8_LDB(B0, 1, 0); PG8_LDB(B1, 1, 1); PG8_SCHED; PG8_LDA(At, 1, 0); PG8_STAGE_A(PG8_SA(0, 1), 1, a2); \
            PG8_WAIT_V(8); PG8_WAIT_L(0); PG8_BAR; PG8_MMA(0, 0, At, B0); PG8_MMA(0, 1, At, B1); PG8_BAR; PG8_SCHED; \
            PG8_LDA(At, 1, 1); PG8_STAGE_B(PG8_SB(1, 0), b3); PG8_STAGE_B(PG8_SB(1, 1), b3 + hstep); PG8_STAGE_A(PG8_SA(1, 0), 0, a3); \
            PG8_WAIT_V(8); PG8_WAIT_L(0); PG8_BAR; PG8_MMA(1, 0, At, B0); PG8_MMA(1, 1, At, B1); PG8_BAR; PG8_SCHED; \
        } while (0)
        int t = 0; int ntm = nt - 2; asm volatile("" : "+s"(ntm));
        for (; t < ntm; t += 2) PG8_TRIP(false);
        PG8_TRIP(true);
#undef PG8_TRIP
        if constexpr (ALIGN_EPI) { if (wr == 0) PG8_BAR; }
        { const int te = fresh_tid(wbase); E(acc, cur, wr, wc, te & 15, (te & 63) >> 4); }
        if (!has_next) break;
#pragma unroll
        for (int a = 0; a < 2; ++a)
#pragma unroll
            for (int b = 0; b < 2; ++b)
#pragma unroll
                for (int m = 0; m < 4; ++m)
#pragma unroll
                    for (int n = 0; n < 2; ++n) acc[a][b][m][n] = (f32x4){0.f, 0.f, 0.f, 0.f};
        cur = nxt; cA = nA; cB = nB; ++ui;
        if constexpr (ALIGN_EPI) { if (wr == 1) PG8_BAR; }
    }
    PG8_WAIT_V(0);
    if constexpr (!ALIGN_EPI) { if (wr == 0) PG8_BAR; }
    PG8_BAR;
#undef PG8_SA
#undef PG8_SB
#undef PG8_STAGE
#undef PG8_STAGE_A
#undef PG8_STAGE_B
#undef PG8_RC
#undef PG8_LDA
#undef PG8_LDB
#undef PG8_MMA
#undef PG8_WAIT_V
#undef PG8_WAIT_L
#undef PG8_BAR
#undef PG8_SCHED
}
}
namespace epi {
using pg8::f32x4; using pg8::u32x4; using pg8::u32x2; using pg8::Unit; using pg8::cvt_pk_bf16;
DEV float fsig(float x) { return __builtin_amdgcn_rcpf(1.f + __expf(-x)); }
DEV void st16(void* p, const u32x4 v) { asm volatile("global_store_dwordx4 %0, %1, off sc1\n\ts_nop 1" :: "v"(p), "v"(v) : "memory"); }
DEV u32x4 pack8(const f32x4 a, const f32x4 b) { u32x4 w; w.x = cvt_pk_bf16(a[0], a[1]); w.y = cvt_pk_bf16(a[2], a[3]); w.z = cvt_pk_bf16(b[0], b[1]); w.w = cvt_pk_bf16(b[2], b[3]); return w; }
DEV void unpack8(const u32x4 w, f32x4& a, f32x4& b) {
    a[0] = __uint_as_float(w.x << 16); a[1] = __uint_as_float(w.x & 0xffff0000u); a[2] = __uint_as_float(w.y << 16); a[3] = __uint_as_float(w.y & 0xffff0000u);
    b[0] = __uint_as_float(w.z << 16); b[1] = __uint_as_float(w.z & 0xffff0000u); b[2] = __uint_as_float(w.w << 16); b[3] = __uint_as_float(w.w & 0xffff0000u); }
#define EPI_FOR8(...) _Pragma("unroll") for (int ai = 0; ai < 2; ++ai) _Pragma("unroll") for (int m = 0; m < 4; ++m) _Pragma("unroll") for (int bj = 0; bj < 2; ++bj) { \
        const int row = u.pm * 256 + ai * 128 + wr * 64 + m * 16 + fr; const int ct = bj * 128 + wc * 32 + 8 * fq; f32x4 v0 = acc[ai][bj][m][0], v1 = acc[ai][bj][m][1]; __VA_ARGS__ }

struct EpiProj {
    static constexpr bool PERM = true;
    unsigned char* ws;
    DEV void operator()(const f32x4 (&acc)[2][2][4][2], const Unit& u, int wr, int wc, int fr, int fq) const {
        const int pn = u.pn; bf16* base; int ld, c0, act; float sc = 1.f;
        if (pn < 2) { base = (bf16*)(ws + R_Q); ld = 512; c0 = pn * 256; act = 0; }
        else if (pn < 4) { base = (bf16*)(ws + R_K); ld = 512; c0 = (pn - 2) * 256; act = 0; sc = 0.125f; }
        else if (pn < 8) { base = (bf16*)(ws + R_V); ld = 1024; c0 = (pn - 4) * 256; act = 0; }
        else if (pn < 12) { base = (bf16*)(ws + R_G); ld = 1024; c0 = (pn - 8) * 256; act = 1; }
        else if (pn < 14) { base = (bf16*)(ws + R_U); ld = 512; c0 = (pn - 12) * 256; act = 0; }
        else if (pn < 18) { base = (bf16*)(ws + R_GR); ld = 1024; c0 = (pn - 14) * 256; act = 2; }
        else { base = (bf16*)(ws + R_GS); ld = 1024; c0 = (pn - 18) * 256; act = 2; }
        EPI_FOR8(
            if (act == 1) { _Pragma("unroll") for (int j = 0; j < 4; ++j) { v0[j] = v0[j] * fsig(v0[j]); v1[j] = v1[j] * fsig(v1[j]); } }
            else if (act == 2) { _Pragma("unroll") for (int j = 0; j < 4; ++j) { v0[j] = fsig(v0[j]); v1[j] = fsig(v1[j]); } }
            else { v0 = v0 * sc; v1 = v1 * sc; }
            st16(base + (size_t)row * ld + c0 + ct, pack8(v0, v1)); )
    }
};
#define EPI_OFF(m, bj, LD) ((size_t)(u.pm * 256 + ai * 128 + wr * 64 + (m) * 16 + fr) * (LD) + u.pn * 256 + (bj) * 128 + wc * 32 + 8 * fq)
struct EpiRet {
    static constexpr bool PERM = true;
    unsigned char* ws;
    DEV void operator()(const f32x4 (&acc)[2][2][4][2], const Unit& u, int wr, int wc, int fr, int fq) const {
        const bf16* GR = (const bf16*)(ws + R_GR); bf16* O = (bf16*)(ws + R_G);
#pragma unroll
        for (int ai = 0; ai < 2; ++ai) { u32x4 gv[4][2];
#pragma unroll
            for (int m = 0; m < 4; ++m)
#pragma unroll
                for (int bj = 0; bj < 2; ++bj) gv[m][bj] = *(const u32x4*)(GR + EPI_OFF(m, bj, 1024));
#pragma unroll
            for (int m = 0; m < 4; ++m)
#pragma unroll
                for (int bj = 0; bj < 2; ++bj) { f32x4 g0, g1; unpack8(gv[m][bj], g0, g1); st16(O + EPI_OFF(m, bj, 1024), pack8(acc[ai][bj][m][0] * g0, acc[ai][bj][m][1] * g1)); } }
    }
};
struct EpiGlu {
    static constexpr bool PERM = true;
    unsigned char* ws;
    DEV void operator()(const f32x4 (&acc)[2][2][4][2], const Unit& u, int wr, int wc, int fr, int fq) const {
        const bf16* Z = (const bf16*)(ws + R_U); bf16* O = (bf16*)(ws + R_S5IN);
#pragma unroll
        for (int ai = 0; ai < 2; ++ai) { u32x4 zv[4][2];
#pragma unroll
            for (int m = 0; m < 4; ++m)
#pragma unroll
                for (int bj = 0; bj < 2; ++bj) zv[m][bj] = *(const u32x4*)(Z + EPI_OFF(m, bj, 512));
#pragma unroll
            for (int m = 0; m < 4; ++m)
#pragma unroll
                for (int bj = 0; bj < 2; ++bj) { f32x4 z0, z1, v0 = acc[ai][bj][m][0], v1 = acc[ai][bj][m][1]; unpack8(zv[m][bj], z0, z1);
#pragma unroll
                    for (int q = 0; q < 4; ++q) { v0[q] = z0[q] * fsig(v0[q]); v1[q] = z1[q] * fsig(v1[q]); }
                    st16(O + EPI_OFF(m, bj, 512), pack8(v0, v1)); } }
    }
};
struct EpiS5b {
    static constexpr bool PERM = true;
    unsigned char* ws;
    DEV void operator()(const f32x4 (&acc)[2][2][4][2], const Unit& u, int wr, int wc, int fr, int fq) const {
        const bf16* GS = (const bf16*)(ws + R_GS); bf16* O = (bf16*)(ws + R_G);
#pragma unroll
        for (int ai = 0; ai < 2; ++ai) { u32x4 gv[4][2], pv[4][2];
#pragma unroll
            for (int m = 0; m < 4; ++m)
#pragma unroll
                for (int bj = 0; bj < 2; ++bj) { gv[m][bj] = *(const u32x4*)(GS + EPI_OFF(m, bj, 1024)); pv[m][bj] = *(const u32x4*)(O + EPI_OFF(m, bj, 1024)); }
#pragma unroll
            for (int m = 0; m < 4; ++m)
#pragma unroll
                for (int bj = 0; bj < 2; ++bj) { f32x4 g0, g1, p0, p1; unpack8(gv[m][bj], g0, g1); unpack8(pv[m][bj], p0, p1);
                    st16(O + EPI_OFF(m, bj, 1024), pack8(p0 + acc[ai][bj][m][0] * g0, p1 + acc[ai][bj][m][1] * g1)); } }
    }
};
struct EpiOut {
    static constexpr bool PERM = true;
    const bf16* hres; bf16* out;
    DEV void operator()(const f32x4 (&acc)[2][2][4][2], const Unit& u, int wr, int wc, int fr, int fq) const {
#pragma unroll
        for (int ai = 0; ai < 2; ++ai) { u32x4 hv[4][2];
#pragma unroll
            for (int m = 0; m < 4; ++m)
#pragma unroll
                for (int bj = 0; bj < 2; ++bj) hv[m][bj] = *(const u32x4*)(hres + EPI_OFF(m, bj, Dm));
#pragma unroll
            for (int m = 0; m < 4; ++m)
#pragma unroll
                for (int bj = 0; bj < 2; ++bj) { f32x4 h0, h1; unpack8(hv[m][bj], h0, h1); st16(out + EPI_OFF(m, bj, Dm), pack8(h0 * ALPHA + acc[ai][bj][m][0], h1 * ALPHA + acc[ai][bj][m][1])); } }
    }
};
}
namespace pg8 {
struct GroupedOrder {
    static constexpr bool GATHER = true;
    const PG8_LAS unsigned* tp; const unsigned* list; int NT, G, c, shift;
    __device__ bool next(int i, Unit& u) const {
        const unsigned total = (unsigned)__builtin_amdgcn_readfirstlane((int)tp[32]) * (unsigned)NT; const unsigned L = (unsigned)i * (unsigned)G + (unsigned)c;
        if (L >= total) return false;
        const unsigned mt = L / (unsigned)NT; int e = 0;
#pragma unroll
        for (int j = 1; j < 32; ++j) e += (mt >= tp[j]) ? 1 : 0;
        e = __builtin_amdgcn_readfirstlane(e);
        u.e = e; u.pm = (int)mt - __builtin_amdgcn_readfirstlane((int)tp[e]); u.pn = (int)(L % (unsigned)NT); u.pnb = e * NT + u.pn; u.cnt = __builtin_amdgcn_readfirstlane((int)tp[33 + e]); return true;
    }
    __device__ __forceinline__ const unsigned* list_ptr(const Unit& u, int r) const { int rr = u.pm * BM + r; rr = rr < u.cnt ? rr : u.cnt - 1; return list + (size_t)u.e * T + rr; }
    __device__ __forceinline__ unsigned row_of(unsigned e) const { return e >> shift; }
};
}
namespace epi {
struct EpiMoeGU {
    static constexpr bool PERM = true;
    unsigned char* ws; const unsigned* list;
    DEV void operator()(const f32x4 (&acc)[2][2][4][2], const Unit& u, int wr, int wc, int fr, int fq) const {
        bf16* ACT = (bf16*)(ws + R_ACT);
        unsigned pp[2][4];
#pragma unroll
        for (int ai = 0; ai < 2; ++ai)
#pragma unroll
            for (int m = 0; m < 4; ++m) { int r = u.pm * 256 + ai * 128 + wr * 64 + m * 16 + fr; r = r < u.cnt ? r : u.cnt - 1; pp[ai][m] = list[(size_t)u.e * T + r]; }
#pragma unroll
        for (int ai = 0; ai < 2; ++ai)
#pragma unroll
            for (int m = 0; m < 4; ++m) { const int r = u.pm * 256 + ai * 128 + wr * 64 + m * 16 + fr;
                if (r < u.cnt) { const unsigned p = pp[ai][m];
#pragma unroll
                    for (int bj = 0; bj < 2; ++bj) { const int f0 = u.pn * 128 + bj * 64 + wc * 16 + 4 * fq; const f32x4 v0 = acc[ai][bj][m][0], v1 = acc[ai][bj][m][1];
                        const float a0 = v0[0] * fsig(v0[0]) * v0[1], a1 = v0[2] * fsig(v0[2]) * v0[3], a2 = v1[0] * fsig(v1[0]) * v1[1], a3 = v1[2] * fsig(v1[2]) * v1[3];
                        u32x2 w; w.x = cvt_pk_bf16(a0, a1); w.y = cvt_pk_bf16(a2, a3); *(u32x2*)(ACT + (size_t)p * 256 + f0) = w; } } }
    }
};
struct EpiMoeDN {
    static constexpr bool PERM = true;
    unsigned char* ws; const unsigned* list;
    DEV void operator()(const f32x4 (&acc)[2][2][4][2], const Unit& u, int wr, int wc, int fr, int fq) const {
        bf16* Y = (bf16*)(ws + R_Y); const float* TC = (const float*)(ws + RT_C);
        unsigned pp[2][4]; float cw[2][4];
#pragma unroll
        for (int ai = 0; ai < 2; ++ai)
#pragma unroll
            for (int m = 0; m < 4; ++m) { int r = u.pm * 256 + ai * 128 + wr * 64 + m * 16 + fr; r = r < u.cnt ? r : u.cnt - 1; pp[ai][m] = list[(size_t)u.e * T + r]; }
#pragma unroll
        for (int ai = 0; ai < 2; ++ai)
#pragma unroll
            for (int m = 0; m < 4; ++m) cw[ai][m] = TC[pp[ai][m]];
#pragma unroll
        for (int ai = 0; ai < 2; ++ai)
#pragma unroll
            for (int m = 0; m < 4; ++m) { const int r = u.pm * 256 + ai * 128 + wr * 64 + m * 16 + fr;
                if (r < u.cnt) { const unsigned p = pp[ai][m]; const float c = cw[ai][m];
#pragma unroll
                    for (int bj = 0; bj < 2; ++bj) { const int d0 = u.pn * 256 + bj * 128 + wc * 32 + 8 * fq;
                        st16(Y + (size_t)p * Dm + d0, pack8(acc[ai][bj][m][0] * c, acc[ai][bj][m][1] * c)); } } }
    }
};
}
#define GAS __attribute__((address_space(1)))
#define LAS __attribute__((address_space(3)))
constexpr int NWAVES = 8;
constexpr int RING_OFF = 0, RING_BYTES = 131072;
constexpr int LDSCTL_OFF = RING_BYTES, MISC_OFF = LDSCTL_OFF + 320, PARK_OFF = RING_BYTES + 1024;
constexpr int LDS_BYTES = 147456;
constexpr int CW_TMO = 0, CW_CODE = 1, CW_BAR = 4096;

#define XB_TMO      128
#define XB_XCNT(j)  (256  + 64 * (j))
#define XB_XSUB(j)  (1280 + 64 * (j))
#define XB_XGEN(j)  (2304 + 64 * (j))
#define XB_TOP      3328
#define XB_TOPGEN   3392
#define XCD_BAR_WORDS 3456
#define XB_SPIN_CAP (1u << 18)
__device__ __forceinline__ unsigned xb_ld(unsigned* p)              { return __hip_atomic_load(p, __ATOMIC_RELAXED, __HIP_MEMORY_SCOPE_AGENT); }
__device__ __forceinline__ unsigned xb_add(unsigned* p, unsigned v) { return __hip_atomic_fetch_add(p, v, __ATOMIC_RELAXED, __HIP_MEMORY_SCOPE_AGENT); }
__device__ __forceinline__ unsigned xb_xcc_id() { return (unsigned)__builtin_amdgcn_s_getreg((3 << 11) | 20) & 0xFu; }
#define XB_SPIN(cond, bar) do { unsigned _sp = 0; while (cond) { __builtin_amdgcn_s_sleep(1); \
    if ((++_sp & 255u) == 0u) { if (xb_ld(&(bar)[XB_TMO])) break; if (_sp > XB_SPIN_CAP) { atomicAdd(&(bar)[XB_TMO], 1u); break; } } } } while (0)
struct XcdBarrier { unsigned* bar; unsigned x; volatile LAS unsigned* st; };
__device__ __forceinline__ XcdBarrier xcd_barrier_post(unsigned* bar, volatile LAS unsigned* st, bool t0) {
    XcdBarrier b; b.bar = bar; b.x = xb_xcc_id(); b.st = st;
    if (t0) st[3] = xb_add(&bar[XB_XCNT(b.x)], 1u);
    return b;
}
__device__ __forceinline__ void xcd_barrier_complete(unsigned* bar, unsigned x, unsigned& nloc, unsigned& nx) {
    const unsigned G = gridDim.x * gridDim.y * gridDim.z;
    unsigned sum, cnt, mine, sp = 0u;
    for (;;) {
        sum = 0u; cnt = 0u; mine = 0u;
#pragma unroll
        for (unsigned j = 0; j < 16; ++j) { const unsigned c = xb_ld(&bar[XB_XCNT(j)]); sum += c; cnt += (c > 0u) ? 1u : 0u; mine = (j == x) ? c : mine; }
        if (sum == G) break;
        __builtin_amdgcn_s_sleep(1);
        if ((++sp & 255u) == 0u) { if (xb_ld(&bar[XB_TMO])) break; if (sp > XB_SPIN_CAP) { atomicAdd(&bar[XB_TMO], 1u); break; } }
    }
    nloc = mine > 0u ? mine : 1u; nx = cnt > 0u ? cnt : 1u;
}
__device__ __forceinline__ void xcd_barrier(const XcdBarrier& b, bool t0, bool local) {
    asm volatile("s_waitcnt vmcnt(0)" ::: "memory");
    __syncthreads();
    if (t0) {
        unsigned* bar = b.bar;
        __builtin_amdgcn_s_waitcnt(0);
        unsigned nloc = b.st[0], nx = b.st[1];
        if (nloc == 0u) { xcd_barrier_complete(bar, b.x, nloc, nx); b.st[0] = nloc; b.st[1] = nx;
            const unsigned G = gridDim.x; unsigned even = (nx == 8u && (G & 7u) == 0u) ? 1u : 0u;
#pragma unroll
            for (unsigned j = 0; j < 8; ++j) even &= (xb_ld(&bar[XB_XCNT(j)]) == G / 8u) ? 1u : 0u;
            b.st[2] = even;
            if (even) { const unsigned rk = b.st[3]; b.st[4] = rk * 8u + b.x; b.st[5] = b.x * (G / 8u) + rk; } }
        const unsigned old = xb_add(&bar[XB_XSUB(b.x)], 1u);
        const unsigned gen = old / nloc;
        if (old + 1u == (gen + 1u) * nloc) {
            if (!local) {
            __builtin_amdgcn_fence(__ATOMIC_RELEASE, "agent");
            asm volatile("s_waitcnt vmcnt(0)" ::: "memory");
            const unsigned og = xb_add(&bar[XB_TOP], 1u);
            const unsigned tg = og / nx;
            if (og + 1u == (tg + 1u) * nx) xb_add(&bar[XB_TOPGEN], 1u);
            else XB_SPIN(xb_ld(&bar[XB_TOPGEN]) == tg, bar);
            }
            __builtin_amdgcn_fence(__ATOMIC_ACQUIRE, "agent");
            xb_add(&bar[XB_XGEN(b.x)], 1u);
            asm volatile("s_waitcnt vmcnt(0)" ::: "memory");
        } else {
            XB_SPIN(xb_ld(&bar[XB_XGEN(b.x)]) == gen, bar);
            __builtin_amdgcn_fence(__ATOMIC_ACQUIRE, "agent");
            asm volatile("s_waitcnt vmcnt(0)" ::: "memory");
        }
    }
    __syncthreads();
}

struct Args { const float* in[27]; float* out; unsigned char* ws; int ph_lo, ph_hi, bar_id, pad; };
constexpr int NPL = 10, NPH = 1 + DEPTH * NPL;
enum { K_PROJ = 0, K_RETA = 1, K_RETB = 2, K_BRANCH = 3, K_S5B = 4, K_OUT = 5, K_LNROUTE = 6, K_MOEGU = 7, K_MOEDN = 8, K_LN2 = 9 };
namespace ph {
#define LDSW() asm volatile("s_waitcnt lgkmcnt(0)" ::: "memory")
DEV int lane_id(int wbase) { return pg8::fresh_tid(wbase) & 63; }
DEV unsigned pk2(float lo, float hi) { return (unsigned)f2bf(lo) | ((unsigned)f2bf(hi) << 16); }
DEV void transpose_item(const float* __restrict__ W, int K, int N, bf16* __restrict__ WT, int rmul, int radd, LAS float* scr, int item, int lane) {
    const int nblk = N / 32, kb = item / nblk, nb = item % nblk, k0 = 64 * kb, n0 = 32 * nb;
#pragma unroll 8
    for (int i = 0; i < 32; ++i) { const int kk = 2 * i + (lane >> 5); scr[kk * 33 + (lane & 31)] = W[(size_t)(k0 + kk) * N + n0 + (lane & 31)]; }
    LDSW(); asm volatile("" ::: "memory");
    const int c = lane & 7;
#pragma unroll
    for (int j = 0; j < 4; ++j) { const int n = (lane >> 3) + 8 * j; const LAS float* s = scr + (8 * c) * 33 + n;
        uint4 o; o.x = pk2(s[0 * 33], s[1 * 33]); o.y = pk2(s[2 * 33], s[3 * 33]); o.z = pk2(s[4 * 33], s[5 * 33]); o.w = pk2(s[6 * 33], s[7 * 33]);
        *(uint4*)(WT + (size_t)((n0 + n) * rmul + radd) * K + k0 + 8 * c) = o; }
    LDSW(); asm volatile("" ::: "memory");
}
struct ConvItem { const float* W; bf16* WT; int K, N, rmul, radd, k0, n0; };
DEV void conv_issue(const ConvItem& c, LAS unsigned char* tile, int lane) {
    const float* src = c.W + (size_t)(c.k0 + (lane >> 3)) * c.N + c.n0;
#pragma unroll
    for (int j = 0; j < 8; ++j) __builtin_amdgcn_global_load_lds(src + (size_t)(8 * j) * c.N + (((lane & 7) ^ j) * 4), (LAS void*)(tile + j * 1024), 16, 0, 0);
}
DEV void conv_finish(const ConvItem& c, const LAS unsigned char* tile, int lane) {
    const int cc = lane & 7, nb = lane >> 3;
#pragma unroll
    for (int jj = 0; jj < 4; ++jj) { const int n = nb + 8 * jj; const LAS float* s = (const LAS float*)tile + cc * 256 + (((n >> 2) ^ cc) * 4) + (n & 3);
        uint4 o; o.x = pk2(s[0], s[32]); o.y = pk2(s[64], s[96]); o.z = pk2(s[128], s[160]); o.w = pk2(s[192], s[224]);
        *(uint4*)(c.WT + (size_t)((c.n0 + n) * c.rmul + c.radd) * c.K + c.k0 + 8 * cc) = o; }
}
DEV void ln_row(const float* pre, const bf16* preb, float scale, const bf16* y2, const float* __restrict__ g, const float* __restrict__ b, float* of, bf16* ob, int lane, float (&v)[16]) {
    float s = 0.f;
    if (pre) {
#pragma unroll
        for (int j = 0; j < 4; ++j) { const float4 x = *(const float4*)(pre + j * 256 + lane * 4); v[4 * j] = x.x * scale; v[4 * j + 1] = x.y * scale; v[4 * j + 2] = x.z * scale; v[4 * j + 3] = x.w * scale; }
    } else {
#pragma unroll
        for (int j = 0; j < 4; ++j) { const uint2 a = *(const uint2*)(preb + j * 256 + lane * 4);
            v[4 * j] = __uint_as_float(a.x << 16) * scale; v[4 * j + 1] = __uint_as_float(a.x & 0xffff0000u) * scale; v[4 * j + 2] = __uint_as_float(a.y << 16) * scale; v[4 * j + 3] = __uint_as_float(a.y & 0xffff0000u) * scale; }
    }
    if (y2) {
#pragma unroll
        for (int j = 0; j < 4; ++j) { const uint2 a = *(const uint2*)(y2 + j * 256 + lane * 4), c = *(const uint2*)(y2 + Dm + j * 256 + lane * 4);
            v[4 * j] += __uint_as_float(a.x << 16) + __uint_as_float(c.x << 16); v[4 * j + 1] += __uint_as_float(a.x & 0xffff0000u) + __uint_as_float(c.x & 0xffff0000u);
            v[4 * j + 2] += __uint_as_float(a.y << 16) + __uint_as_float(c.y << 16); v[4 * j + 3] += __uint_as_float(a.y & 0xffff0000u) + __uint_as_float(c.y & 0xffff0000u); }
    }
#pragma unroll
    for (int i = 0; i < 16; ++i) s += v[i];
    const float mean = wave_sum(s) * (1.f / Dm); float q = 0.f;
#pragma unroll
    for (int i = 0; i < 16; ++i) { v[i] -= mean; q += v[i] * v[i]; }
    const float rstd = rsqrtf(wave_sum(q) * (1.f / Dm) + LN_EPS);
#pragma unroll
    for (int j = 0; j < 4; ++j) { const float4 gg = *(const float4*)(g + j * 256 + lane * 4), bb = *(const float4*)(b + j * 256 + lane * 4);
        float4 o; o.x = v[4 * j] * rstd * gg.x + bb.x; o.y = v[4 * j + 1] * rstd * gg.y + bb.y; o.z = v[4 * j + 2] * rstd * gg.z + bb.z; o.w = v[4 * j + 3] * rstd * gg.w + bb.w;
        v[4 * j] = o.x; v[4 * j + 1] = o.y; v[4 * j + 2] = o.z; v[4 * j + 3] = o.w;
        if (of) *(float4*)(of + j * 256 + lane * 4) = o;
        uint2 w; w.x = pk2(o.x, o.y); w.y = pk2(o.z, o.w); *(uint2*)(ob + j * 256 + lane * 4) = w; }
}

struct ProIn { const float *x, *lng, *lnb, *w_in, *lam_re, *lam_im, *log_step, *b_re, *b_im, *c_re, *c_im, *w_glu, *w_bret, *w_bs5, *w_out, *w_rg, *w_re; float* out; };
DEV void prologue(const int wbase, LAS unsigned char* lds, unsigned char* ws, const ProIn P, int G, int vcu) {
    const int wave = wbase >> 6, lane = lane_id(wbase), tid = wbase + lane;
    LAS float* scr = (LAS float*)(lds + wave * 16384);
    const int gw = vcu * NWAVES + wave, NGW = G * NWAVES;
    constexpr int I_IN = (Dm / 64) * (INW / 32), I_GLU = (S5W / 64) * (S5W / 32), I_BRET = (RV / 64) * (Dm / 32), I_BS5 = (S5W / 64) * (Dm / 32), I_OUT = (Dm / 64) * (Dm / 32);
    constexpr int I_L = I_IN + I_GLU + I_BRET + I_BS5 + I_OUT;
    for (int it = gw; it < DEPTH * I_L; it += NGW) {
        const int l = it / I_L; int r = it % I_L;
        if (r < I_IN) { transpose_item(P.w_in + (size_t)l * Dm * INW, Dm, INW, (bf16*)(ws + W_IN) + (size_t)l * INW * Dm, 1, 0, scr, r, lane); continue; } r -= I_IN;
        if (r < I_GLU) { transpose_item(P.w_glu + (size_t)l * S5W * S5W, S5W, S5W, (bf16*)(ws + W_GLU) + (size_t)l * S5W * S5W, 1, 0, scr, r, lane); continue; } r -= I_GLU;
        if (r < I_BRET) { transpose_item(P.w_bret + (size_t)l * RV * Dm, RV, Dm, (bf16*)(ws + W_BRET) + (size_t)l * Dm * RV, 1, 0, scr, r, lane); continue; } r -= I_BRET;
        if (r < I_BS5) { transpose_item(P.w_bs5 + (size_t)l * S5W * Dm, S5W, Dm, (bf16*)(ws + W_BS5) + (size_t)l * Dm * S5W, 1, 0, scr, r, lane); continue; } r -= I_BS5;
        transpose_item(P.w_out + (size_t)l * Dm * Dm, Dm, Dm, (bf16*)(ws + W_OUT) + (size_t)l * Dm * Dm, 1, 0, scr, r, lane);
    }
    const int gt = vcu * (NWAVES * 64) + tid, NGT = G * NWAVES * 64;
    float* COS = (float*)(ws + TAB_COS); float* SIN = (float*)(ws + TAB_SIN); float* POWG = (float*)(ws + TAB_POWG);
    float* AB = (float*)(ws + TAB_AB); bf16* BBH = (bf16*)(ws + TAB_BBH); bf16* CTH = (bf16*)(ws + TAB_CTH); float* WRT = (float*)(ws + TAB_WRT);
    for (int gid = gt; gid < 2048 * 32; gid += NGT) { const int pos = gid >> 5, i = gid & 31; const float inv = exp2f(-(float)i * (13.287712379549449f / 32.0f)); const float ang = (float)pos * inv;
        COS[gid] = cosf(ang); SIN[gid] = sinf(ang); }
    for (int gid = gt; gid < 8 * 80; gid += NGT) { const int h = gid / 80, n = gid % 80; const float lg = log1pf(-exp2f(-5.0f - (float)h)); POWG[gid] = expf(lg * (float)n); }
    for (int gid = gt; gid < DEPTH * S5G * S5N; gid += NGT) {
        const int g = (gid / S5N) % S5G, l = gid / (S5G * S5N);
        float lr = P.lam_re[gid]; if (lr > -1e-4f) lr = -1e-4f; const float li = P.lam_im[gid];
        const float step = expf(P.log_step[l * S5G + g]);
        const float em1 = expm1f(lr * step), mag = em1 + 1.f, ang = li * step, cs = cosf(ang), sn = sinf(ang), sh = sinf(0.5f * ang);
        const float abr = mag * cs, abi = mag * sn;
        const float nre = em1 * cs - 2.f * sh * sh;
        const float den = lr * lr + li * li;
        const float zr = (nre * lr + abi * li) / den, zi = (abi * lr - nre * li) / den;
        AB[gid * 2] = abr; AB[gid * 2 + 1] = abi;
        const int n = gid % S5N, lg = gid / S5N;
        for (int c = 0; c < 16; ++c) { const float br = P.b_re[(size_t)gid * 16 + c], bi = P.b_im[(size_t)gid * 16 + c];
            BBH[((size_t)lg * 128 + n) * 16 + c] = f2bf(zr * br - zi * bi); BBH[((size_t)lg * 128 + 64 + n) * 16 + c] = f2bf(zr * bi + zi * br); }
    }
    for (int gid = gt; gid < DEPTH * S5G * 16 * 128; gid += NGT) { const int np = gid & 127, lgc = gid >> 7;
        CTH[gid] = f2bf(np < 64 ? P.c_re[(size_t)lgc * 64 + np] : -P.c_im[(size_t)lgc * 64 + np - 64]); }
    for (int gid = gt; gid < DEPTH * 36 * Dm; gid += NGT) { const int kk = gid % Dm, j = (gid / Dm) % 36, l = gid / (36 * Dm);
        WRT[gid] = j < 4 ? P.w_rg[((size_t)l * Dm + kk) * MG + j] : P.w_re[((size_t)l * Dm + kk) * NE + (j - 4)]; }
    { bf16* WRH = (bf16*)(ws + TAB_WRH); bf16* WRL = (bf16*)(ws + TAB_WRL);
      for (int gid = gt; gid < DEPTH * 48 * Dm; gid += NGT) { const int kk = gid % Dm, j = (gid / Dm) % 48, l = gid / (48 * Dm);
          const float w = j < 4 ? P.w_rg[((size_t)l * Dm + kk) * MG + j] : (j < 36 ? P.w_re[((size_t)l * Dm + kk) * NE + (j - 4)] : 0.f);
          const bf16 hi = f2bf(w); WRH[gid] = hi; WRL[gid] = f2bf(w - bf2f(hi)); } }
    float v[16];
    for (int m = gw; m < T; m += NGW) ln_row(P.x + (size_t)m * Dm, nullptr, 1.f, nullptr, P.lng, P.lnb, nullptr, (bf16*)(ws + WS_HBF) + (size_t)m * Dm, lane, v);
}

struct RouteIn { const float *lng, *lnb, *brg, *bre, *wg, *wu, *wd; };
DEV void phase_lnroute(const int wbase, LAS unsigned char* lds, unsigned char* ws, const RouteIn P, int layer, int G, int vcu) {
    const int wave = wbase >> 6, lane = lane_id(wbase);
    const int gw = vcu * NWAVES + wave, NGW = G * NWAVES;
    const bf16* preb = (const bf16*)(ws + WS_HB); bf16* ob = (bf16*)(ws + WS_HBF);
    const float* WRT = (const float*)(ws + TAB_WRT) + (size_t)layer * 36 * Dm;
    const float* brg = P.brg; const float* bre = P.bre;
    int* TE = (int*)(ws + RT_E); float* TC = (float*)(ws + RT_C); int* LIST = (int*)(ws + RT_LIST); unsigned* CNT = (unsigned*)(ws + WS_CNT) + layer * NE;
    typedef short bf16x8 __attribute__((ext_vector_type(8))); typedef float f32x4 __attribute__((ext_vector_type(4)));
    constexpr int AS = 2064, A_LO = 16 * AS, PL_OFF = 2 * 16 * AS, LG_OFF = PL_OFF + 8 * 16 * 48 * 4, RT_OFF = LG_OFF + 16 * 48 * 4, CAP = 128;
    LAS unsigned* lcnt = (LAS unsigned*)(lds + RT_OFF); LAS unsigned* gbase = lcnt + 32; LAS int* le1 = (LAS int*)(gbase + 32); LAS int* le2 = le1 + CAP;
    LAS unsigned* lr1 = (LAS unsigned*)(le2 + CAP); LAS unsigned* lr2 = lr1 + CAP; LAS float* lc1 = (LAS float*)(lr2 + CAP); LAS float* lc2 = lc1 + CAP; LAS int* lrow = (LAS int*)(lc2 + CAP);
    static_assert(RT_OFF + 64 * 4 + 7 * CAP * 4 <= RING_BYTES, "lnroute LDS");
    const int tid = wbase + lane, fr = lane & 15, fq = lane >> 4;
    bf16x8 bh[3][4], bl[3][4];
    { const bf16* WRH = (const bf16*)(ws + TAB_WRH) + (size_t)layer * 48 * Dm; const bf16* WRL = (const bf16*)(ws + TAB_WRL) + (size_t)layer * 48 * Dm;
#pragma unroll
      for (int nt = 0; nt < 3; ++nt)
#pragma unroll
          for (int ks = 0; ks < 4; ++ks) { const size_t o = (size_t)(16 * nt + fr) * Dm + wave * 128 + ks * 32 + 8 * fq; bh[nt][ks] = *(const bf16x8*)(WRH + o); bl[nt][ks] = *(const bf16x8*)(WRL + o); } }
    if (tid < 32) lcnt[tid] = 0u;
    int nent = 0;
    __syncthreads();
    const bool contig = ((T / 16) % G) == 0; const int nbw = contig ? (T / 16) / G : ((T / 16) + G - 1) / G;
    for (int ib = 0; ib < nbw; ++ib) { const int blk = contig ? vcu * nbw + ib : vcu + ib * G; if (blk >= T / 16) break;
#pragma unroll
        for (int jr = 0; jr < 2; ++jr) { const int lr = 2 * wave + jr, row = blk * 16 + lr;
            float v[16];
            ln_row(nullptr, preb + (size_t)row * Dm, 1.f, nullptr, P.lng, P.lnb, nullptr, ob + (size_t)row * Dm, lane, v);
#pragma unroll
            for (int j = 0; j < 4; ++j) { unsigned hw[2], lw[2];
#pragma unroll
                for (int e2 = 0; e2 < 2; ++e2) { const float x0 = v[4 * j + 2 * e2], x1 = v[4 * j + 2 * e2 + 1]; const bf16 h0 = f2bf(x0), h1 = f2bf(x1);
                    hw[e2] = (unsigned)h0 | ((unsigned)h1 << 16); lw[e2] = (unsigned)f2bf(x0 - bf2f(h0)) | ((unsigned)f2bf(x1 - bf2f(h1)) << 16); }
                *(LAS pg8::u32x2*)(lds + lr * AS + (j * 256 + lane * 4) * 2) = (pg8::u32x2){hw[0], hw[1]};
                *(LAS pg8::u32x2*)(lds + A_LO + lr * AS + (j * 256 + lane * 4) * 2) = (pg8::u32x2){lw[0], lw[1]}; } }
        __syncthreads();
        f32x4 acc[3];
#pragma unroll
        for (int nt = 0; nt < 3; ++nt) acc[nt] = (f32x4){0.f, 0.f, 0.f, 0.f};
#pragma unroll
        for (int ks = 0; ks < 4; ++ks) { const int ao = fr * AS + (wave * 128 + ks * 32 + 8 * fq) * 2;
            const bf16x8 ah = *(const LAS bf16x8*)(lds + ao), al = *(const LAS bf16x8*)(lds + A_LO + ao);
#pragma unroll
            for (int nt = 0; nt < 3; ++nt) { acc[nt] = __builtin_amdgcn_mfma_f32_16x16x32_bf16(ah, bh[nt][ks], acc[nt], 0, 0, 0);
                acc[nt] = __builtin_amdgcn_mfma_f32_16x16x32_bf16(al, bh[nt][ks], acc[nt], 0, 0, 0); acc[nt] = __builtin_amdgcn_mfma_f32_16x16x32_bf16(ah, bl[nt][ks], acc[nt], 0, 0, 0); } }
        { LAS float* PL = (LAS float*)(lds + PL_OFF) + wave * 16 * 48;
#pragma unroll
          for (int nt = 0; nt < 3; ++nt)
#pragma unroll
              for (int rg = 0; rg < 4; ++rg) PL[(4 * fq + rg) * 48 + 16 * nt + fr] = acc[nt][rg]; }
        __syncthreads();
        for (int idx = tid; idx < 16 * 48; idx += NWAVES * 64) { const LAS float* PL = (const LAS float*)(lds + PL_OFF) + idx; float s = 0.f;
#pragma unroll
            for (int w = 0; w < 8; ++w) s += PL[w * 16 * 48];
            ((LAS float*)(lds + LG_OFF))[idx] = s; }
        __syncthreads();
        if (tid < 16) { const LAS float* LG = (const LAS float*)(lds + LG_OFF) + tid * 48; const int row = blk * 16 + tid;
            float lg[4];
#pragma unroll
            for (int kk = 0; kk < 4; ++kk) lg[kk] = LG[kk] + brg[kk];
            int gi = 0; float gm = lg[0];
#pragma unroll
            for (int kk = 1; kk < 4; ++kk) if (lg[kk] > gm) { gm = lg[kk]; gi = kk; }
            float den = 0.f;
#pragma unroll
            for (int kk = 0; kk < 4; ++kk) den += __expf(lg[kk] - gm);
            const float gtop = 1.f / den;
            int i1 = 0, i2 = 0; float m1 = -INFINITY, m2 = -INFINITY;
            for (int kk = 0; kk < 8; ++kk) { const float x = LG[4 + gi * 8 + kk] + bre[gi * 8 + kk];
                if (x > m1) { m2 = m1; i2 = i1; m1 = x; i1 = kk; } else if (x > m2) { m2 = x; i2 = kk; } }
            const float p2 = __expf(m2 - m1);
            const float w1 = 1.f / (1.f + p2), w2 = p2 / (1.f + p2);
            const int e1 = gi * 8 + i1, e2 = gi * 8 + i2, li = nent + tid;
            le1[li] = e1; le2[li] = e2; lc1[li] = gtop * w1; lc2[li] = gtop * w2; lrow[li] = row;
            lr1[li] = __hip_atomic_fetch_add(lcnt + e1, 1u, __ATOMIC_RELAXED, __HIP_MEMORY_SCOPE_WORKGROUP); lr2[li] = __hip_atomic_fetch_add(lcnt + e2, 1u, __ATOMIC_RELAXED, __HIP_MEMORY_SCOPE_WORKGROUP); }
        nent += 16;
        const bool last = (ib + 1 >= nbw) || (!contig && blk + G >= T / 16);
        if (nent == CAP || last) {
            __syncthreads();
            if (tid < 32) { const unsigned c = lcnt[tid]; gbase[tid] = c ? atomicAdd(&CNT[tid], c) : 0u; }
            __syncthreads();
            if (tid < nent) { const int row = lrow[tid], e1 = le1[tid], e2 = le2[tid];
                TE[row * 2] = e1; TE[row * 2 + 1] = e2; TC[row * 2] = lc1[tid]; TC[row * 2 + 1] = lc2[tid];
                LIST[(size_t)e1 * T + gbase[e1] + lr1[tid]] = row * 2; LIST[(size_t)e2 * T + gbase[e2] + lr2[tid]] = row * 2 + 1; }
            __syncthreads();
            if (tid < 32) lcnt[tid] = 0u;
            nent = 0;
        }
        __syncthreads();
    }
    constexpr int I_G = (Dm / 64) * (FF / 32);
    { LAS unsigned char* t0 = lds + wave * 16384;
      auto decode = [&](int it) { const int e = it / (2 * I_G), r = it % (2 * I_G), m = r / I_G, q = r % I_G;
          return ConvItem{(m ? P.wu : P.wg) + (size_t)e * Dm * FF, (bf16*)(ws + R_WGU) + (size_t)e * 512 * Dm, Dm, FF, 2, m, 64 * (q / (FF / 32)), 32 * (q % (FF / 32))}; };
      int it = gw, par = 0; bool have = it < NE * 2 * I_G; ConvItem cur{};
      __syncthreads();
      if (have) { cur = decode(it); conv_issue(cur, t0, lane); }
      while (have) { const int nx = it + NGW; const bool hn = nx < NE * 2 * I_G; ConvItem nxt{};
          if (hn) { nxt = decode(nx); conv_issue(nxt, t0 + (par ^ 1) * 8192, lane); asm volatile("s_waitcnt vmcnt(8)" ::: "memory"); } else asm volatile("s_waitcnt vmcnt(0)" ::: "memory");
          conv_finish(cur, t0 + par * 8192, lane); cur = nxt; it = nx; have = hn; par ^= 1; } }
}
DEV void phase_ln2(const int wbase, unsigned char* ws, const float* lng, const float* lnb, float* out, int G, int vcu) {
    const int wave = wbase >> 6, lane = lane_id(wbase);
    const int gw = vcu * NWAVES + wave, NGW = G * NWAVES;
    float v[16];
    for (int row = gw; row < T; row += NGW)
        ln_row(nullptr, (const bf16*)(ws + WS_HBF) + (size_t)row * Dm, ALPHA, (const bf16*)(ws + R_Y) + (size_t)(2 * row) * Dm, lng, lnb, out ? out + (size_t)row * Dm : nullptr, (bf16*)(ws + WS_HBF) + (size_t)row * Dm, lane, v);
}
}

namespace ret {
typedef short bf16x8 __attribute__((ext_vector_type(8)));
typedef short s16x4 __attribute__((ext_vector_type(4)));
typedef float f32x16 __attribute__((ext_vector_type(16)));
typedef float f32x4 __attribute__((ext_vector_type(4)));
typedef float f32x2_t __attribute__((ext_vector_type(2))); typedef __bf16 bf16x2_t __attribute__((ext_vector_type(2)));
DEV unsigned cvtpk(float lo, float hi) { f32x2_t v = {lo, hi}; bf16x2_t b = __builtin_convertvector(v, bf16x2_t); return __builtin_bit_cast(unsigned, b); }
#define RMFMA(a, b, c) __builtin_amdgcn_mfma_f32_32x32x16_bf16((a), (b), (c), 0, 0, 0)
constexpr int LS = 72;
constexpr int L_KR = 0, L_QR = 9216, L_KDT = 18432, L_VT = 27648, L_ST = 46080, L_O = 64512, OS = 132, L_END = L_O + 64 * OS * 4;
static_assert(L_END <= RING_BYTES, "retention LDS");
constexpr int SEGC = 8, NSEG = NCH / SEGC;
DEV int crow(int reg, int h) { return (reg & 3) + 8 * (reg >> 2) + 4 * h; }
DEV float bflo(unsigned w) { return __uint_as_float(w << 16); }
DEV float bfhi(unsigned w) { return __uint_as_float(w & 0xffff0000u); }

struct Raw { uint2 k1, k2, q1, q2; float4 cs, sn; uint4 v0, v1; };
template <bool WITH_Q> DEV void load_raw(Raw& R, const unsigned char* ws, int row0, int pos0, int h, int tid) {
    const int j = tid >> 3, c0 = (tid & 7) * 4;
    const bf16* K = (const bf16*)(ws + R_K) + (size_t)(row0 + j) * 512 + h * 64 + c0;
    R.k1 = *(const uint2*)K; R.k2 = *(const uint2*)(K + 32);
    if (WITH_Q) { const bf16* Q = (const bf16*)(ws + R_Q) + (size_t)(row0 + j) * 512 + h * 64 + c0; R.q1 = *(const uint2*)Q; R.q2 = *(const uint2*)(Q + 32); }
    R.cs = *(const float4*)((const float*)(ws + TAB_COS) + (pos0 + j) * 32 + c0); R.sn = *(const float4*)((const float*)(ws + TAB_SIN) + (pos0 + j) * 32 + c0);
    const bf16* V = (const bf16*)(ws + R_V) + (size_t)(row0 + j) * 1024 + h * 128 + (tid & 7) * 16;
    R.v0 = *(const uint4*)V; R.v1 = *(const uint4*)(V + 8);
}
DEV void rot4(const uint2 x1, const uint2 x2, const float4 cs, const float4 sn, float (&r1)[4], float (&r2)[4]) {
    const float a[4] = {bflo(x1.x), bfhi(x1.x), bflo(x1.y), bfhi(x1.y)}, b[4] = {bflo(x2.x), bfhi(x2.x), bflo(x2.y), bfhi(x2.y)};
    const float c[4] = {cs.x, cs.y, cs.z, cs.w}, s[4] = {sn.x, sn.y, sn.z, sn.w};
#pragma unroll
    for (int e = 0; e < 4; ++e) { r1[e] = a[e] * c[e] - b[e] * s[e]; r2[e] = a[e] * s[e] + b[e] * c[e]; }
}
template <bool WITH_Q> DEV void stage(LAS unsigned char* lds, const Raw& R, int tid, float kd) {
    const int j = tid >> 3, c0 = (tid & 7) * 4;
    float r1[4], r2[4];
    rot4(R.k1, R.k2, R.cs, R.sn, r1, r2);
    if (WITH_Q) { LAS bf16* kr = (LAS bf16*)(lds + L_KR) + j * LS + c0;
        *(LAS pg8::u32x2*)kr = (pg8::u32x2){cvtpk(r1[0], r1[1]), cvtpk(r1[2], r1[3])}; *(LAS pg8::u32x2*)(kr + 32) = (pg8::u32x2){cvtpk(r2[0], r2[1]), cvtpk(r2[2], r2[3])}; }
    LAS bf16* kdt = (LAS bf16*)(lds + L_KDT) + c0 * LS + j;
#pragma unroll
    for (int e = 0; e < 4; ++e) { kdt[e * LS] = f2bf(r1[e] * kd); kdt[(32 + e) * LS] = f2bf(r2[e] * kd); }
    if (WITH_Q) { rot4(R.q1, R.q2, R.cs, R.sn, r1, r2); LAS bf16* qr = (LAS bf16*)(lds + L_QR) + j * LS + c0;
        *(LAS pg8::u32x2*)qr = (pg8::u32x2){cvtpk(r1[0], r1[1]), cvtpk(r1[2], r1[3])}; *(LAS pg8::u32x2*)(qr + 32) = (pg8::u32x2){cvtpk(r2[0], r2[1]), cvtpk(r2[2], r2[3])}; }
    LAS bf16* vt = (LAS bf16*)(lds + L_VT) + ((tid & 7) * 16) * LS + j;
    const unsigned vw[8] = {R.v0.x, R.v0.y, R.v0.z, R.v0.w, R.v1.x, R.v1.y, R.v1.z, R.v1.w};
#pragma unroll
    for (int e = 0; e < 8; ++e) { vt[(2 * e) * LS] = (bf16)(vw[e] & 0xffffu); vt[(2 * e + 1) * LS] = (bf16)(vw[e] >> 16); }
}
DEV bf16x8 ld8(const LAS bf16* p) { return *(const LAS bf16x8*)p; }
DEV void state_update(f32x16& ST, const LAS unsigned char* lds, int wi, int wd, int r, int hh, float cd) {
#pragma unroll
    for (int e = 0; e < 16; ++e) ST[e] *= cd;
    const LAS bf16* a = (const LAS bf16*)(lds + L_KDT) + (32 * wi + r) * LS + 8 * hh; const LAS bf16* b = (const LAS bf16*)(lds + L_VT) + (32 * wd + r) * LS + 8 * hh;
#pragma unroll
    for (int s = 0; s < 4; ++s) ST = RMFMA(ld8(a + 16 * s), ld8(b + 16 * s), ST);
}

DEV void phase_a(const int wbase, LAS unsigned char* lds, unsigned char* ws, int G, int vcu) {
    const int wave = wbase >> 6, tid = pg8::fresh_tid(wbase), lane = tid & 63, r = lane & 31, hh = lane >> 5, wi = wave >> 2, wd = wave & 3;
    for (int item = vcu; item < BATCH * RH * NSEG; item += G) {
        const int seg = item % NSEG, h = (item / NSEG) % RH, b = item / (NSEG * RH);
        const float lg2g = log1pf(-__builtin_amdgcn_exp2f(-5.0f - (float)h)) * 1.4426950408889634f, cd = __builtin_amdgcn_exp2f(64.f * lg2g);
        f32x16 ST;
#pragma unroll
        for (int e = 0; e < 16; ++e) ST[e] = 0.f;
        const float kdj = __builtin_amdgcn_exp2f((float)(63 - (tid >> 3)) * lg2g);
        Raw R; load_raw<false>(R, ws, b * SEQ + seg * SEGC * CHUNK, seg * SEGC * CHUNK, h, tid);
#pragma nounroll
        for (int n = 0; n < SEGC; ++n) {
            __syncthreads();
            stage<false>(lds, R, tid, kdj);
            __syncthreads();
            if (n + 1 < SEGC) load_raw<false>(R, ws, b * SEQ + (seg * SEGC + n + 1) * CHUNK, (seg * SEGC + n + 1) * CHUNK, h, tid);
            state_update(ST, lds, wi, wd, r, hh, cd);
        }
        float* TOT = (float*)(ws + WS_HB) + (size_t)item * 8192 + wave * 1024 + lane;
#pragma unroll
        for (int e = 0; e < 16; ++e) TOT[e * 64] = ST[e];
    }
    __syncthreads();
}
DEV void phase_b(const int wbase, LAS unsigned char* lds, unsigned char* ws, int G, int vcu) {
    const int wave = wbase >> 6, tid = pg8::fresh_tid(wbase), lane = tid & 63, r = lane & 31, hh = lane >> 5, wi = wave >> 2, wd = wave & 3;
    for (int item = vcu; item < BATCH * RH * NSEG; item += G) {
        const int seg = item % NSEG, h = (item / NSEG) % RH, b = item / (NSEG * RH);
        const float lg2g = log1pf(-__builtin_amdgcn_exp2f(-5.0f - (float)h)) * 1.4426950408889634f, cd = __builtin_amdgcn_exp2f(64.f * lg2g), cd8 = __builtin_amdgcn_exp2f(64.f * SEGC * lg2g);
        f32x16 ST;
#pragma unroll
        for (int e = 0; e < 16; ++e) ST[e] = 0.f;
#pragma nounroll
        for (int s = 0; s < seg; ++s) { const float* TOT = (const float*)(ws + WS_HB) + (size_t)(item - seg + s) * 8192 + wave * 1024 + lane;
#pragma unroll
            for (int e = 0; e < 16; ++e) ST[e] = cd8 * ST[e] + TOT[e * 64]; }
        const float kdj = __builtin_amdgcn_exp2f((float)(63 - (tid >> 3)) * lg2g);
        Raw R; load_raw<true>(R, ws, b * SEQ + seg * SEGC * CHUNK, seg * SEGC * CHUNK, h, tid);
        float mk0[16], mk1[16], qdec[16];
        { const int lq = pg8::fresh_tid(wbase) & 63, iq = 32 * wi + (lq & 31), hq = lq >> 5;
#pragma unroll
          for (int e = 0; e < 16; ++e) { const int j0 = crow(e, hq), d0 = iq > j0 ? iq - j0 : j0 - iq, d1 = iq > j0 + 32 ? iq - j0 - 32 : j0 + 32 - iq;
              mk0[e] = __builtin_amdgcn_exp2f((float)d0 * lg2g); mk1[e] = __builtin_amdgcn_exp2f((float)d1 * lg2g); qdec[e] = __builtin_amdgcn_exp2f((float)(32 * wi + j0 + 1) * lg2g); } }
#pragma nounroll
        for (int n = 0; n < SEGC; ++n) {
            const int row0 = b * SEQ + (seg * SEGC + n) * CHUNK;
            stage<true>(lds, R, tid, kdj);
            { LAS bf16* st = (LAS bf16*)(lds + L_ST) + (32 * wd + r) * LS + 32 * wi + 4 * hh;
#pragma unroll
              for (int g4 = 0; g4 < 4; ++g4) *(LAS pg8::u32x2*)(st + 8 * g4) = (pg8::u32x2){cvtpk(ST[4 * g4], ST[4 * g4 + 1]), cvtpk(ST[4 * g4 + 2], ST[4 * g4 + 3])}; }
            __syncthreads();
            if (n + 1 < SEGC) load_raw<true>(R, ws, row0 + CHUNK, (seg * SEGC + n + 1) * CHUNK, h, tid);
            const bf16* Gp = (const bf16*)(ws + R_G) + (size_t)(row0 + (tid >> 3)) * 1024 + h * 128 + (tid & 7) * 16;
            const uint4 g0 = *(const uint4*)Gp, g1 = *(const uint4*)(Gp + 8);
            f32x16 X0, X1;
#pragma unroll
            for (int e = 0; e < 16; ++e) { X0[e] = 0.f; X1[e] = 0.f; }
            const LAS bf16* kr = (const LAS bf16*)(lds + L_KR) + r * LS + 8 * hh; const LAS bf16* qr = (const LAS bf16*)(lds + L_QR) + (32 * wi + r) * LS + 8 * hh;
#pragma unroll
            for (int s = 0; s < 4; ++s) { const bf16x8 qb = ld8(qr + 16 * s); X0 = RMFMA(ld8(kr + 16 * s), qb, X0); X1 = RMFMA(ld8(kr + 32 * LS + 16 * s), qb, X1); }
#pragma unroll
            for (int e = 0; e < 16; ++e) { X0[e] *= mk0[e]; X1[e] *= mk1[e]; }
            f32x16 O;
#pragma unroll
            for (int e = 0; e < 16; ++e) O[e] = 0.f;
            const LAS bf16* stb = (const LAS bf16*)(lds + L_ST) + (32 * wd + r) * LS + 8 * hh;
#pragma unroll
            for (int s = 0; s < 4; ++s) O = RMFMA(ld8(qr + 16 * s), ld8(stb + 16 * s), O);
#pragma unroll
            for (int e = 0; e < 16; ++e) O[e] *= qdec[e];
            const LAS bf16* vt = (const LAS bf16*)(lds + L_VT) + (32 * wd + r) * LS + 4 * hh;
#pragma unroll
            for (int s = 0; s < 2; ++s) {
                bf16x8 pa, pb;
                { const unsigned w0 = cvtpk(X0[8 * s], X0[8 * s + 1]), w1 = cvtpk(X0[8 * s + 2], X0[8 * s + 3]), w2 = cvtpk(X0[8 * s + 4], X0[8 * s + 5]), w3 = cvtpk(X0[8 * s + 6], X0[8 * s + 7]);
                  const pg8::u32x4 p = {w0, w1, w2, w3}; pa = __builtin_bit_cast(bf16x8, p); }
                { const unsigned w0 = cvtpk(X1[8 * s], X1[8 * s + 1]), w1 = cvtpk(X1[8 * s + 2], X1[8 * s + 3]), w2 = cvtpk(X1[8 * s + 4], X1[8 * s + 5]), w3 = cvtpk(X1[8 * s + 6], X1[8 * s + 7]);
                  const pg8::u32x4 p = {w0, w1, w2, w3}; pb = __builtin_bit_cast(bf16x8, p); }
                const s16x4 a0 = *(const LAS s16x4*)(vt + 16 * s), a1 = *(const LAS s16x4*)(vt + 16 * s + 8), b0 = *(const LAS s16x4*)(vt + 32 + 16 * s), b1 = *(const LAS s16x4*)(vt + 32 + 16 * s + 8);
                O = RMFMA(pa, __builtin_shufflevector(a0, a1, 0, 1, 2, 3, 4, 5, 6, 7), O);
                O = RMFMA(pb, __builtin_shufflevector(b0, b1, 0, 1, 2, 3, 4, 5, 6, 7), O);
            }
            state_update(ST, lds, wi, wd, r, hh, cd);
            { LAS float* ob = (LAS float*)(lds + L_O) + (32 * wi + 4 * hh) * OS + 32 * wd + r;
#pragma unroll
              for (int e = 0; e < 16; ++e) ob[((e & 3) + 8 * (e >> 2)) * OS] = O[e]; }
            __syncthreads();
            { const int i = tid >> 3, c0 = (tid & 7) * 16; const LAS float* orow = (const LAS float*)(lds + L_O) + i * OS + c0;
              float o[16];
#pragma unroll
              for (int q4 = 0; q4 < 4; ++q4) { const f32x4 t4 = *(const LAS f32x4*)(orow + 4 * q4); o[4 * q4] = t4[0]; o[4 * q4 + 1] = t4[1]; o[4 * q4 + 2] = t4[2]; o[4 * q4 + 3] = t4[3]; }
              float sm = 0.f;
#pragma unroll
              for (int c = 0; c < 16; ++c) sm += o[c];
              sm += xshfl<1>(sm); sm += xshfl<2>(sm); sm += xshfl<4>(sm);
              const float mean = sm * (1.f / 128.f); float qq = 0.f;
#pragma unroll
              for (int c = 0; c < 16; ++c) { o[c] -= mean; qq += o[c] * o[c]; }
              qq += xshfl<1>(qq); qq += xshfl<2>(qq); qq += xshfl<4>(qq);
              const float rstd = rsqrtf(qq * (1.f / 128.f) + HN_EPS);
              const unsigned gw[8] = {g0.x, g0.y, g0.z, g0.w, g1.x, g1.y, g1.z, g1.w}; unsigned ow[8];
#pragma unroll
              for (int e = 0; e < 8; ++e) ow[e] = cvtpk(bflo(gw[e]) * o[2 * e] * rstd, bfhi(gw[e]) * o[2 * e + 1] * rstd);
              bf16* Ap = (bf16*)(ws + R_V) + (size_t)(row0 + i) * 1024 + h * 128 + c0;
              *(uint4*)Ap = make_uint4(ow[0], ow[1], ow[2], ow[3]); *(uint4*)(Ap + 8) = make_uint4(ow[4], ow[5], ow[6], ow[7]); }
        }
    }
    __syncthreads();
}
}

namespace s5 {
using ret::bf16x8; using ret::s16x4; using ret::f32x16; using ret::cvtpk; using ret::crow;
typedef short v4i16_t __attribute__((ext_vector_type(4)));
DEV s16x4 trr(const LAS unsigned char* p) { return __builtin_bit_cast(s16x4, __builtin_amdgcn_ds_read_tr16_b64_v4i16((LAS v4i16_t*)p)); }
struct Cx { float x, y; };
DEV Cx cmul(Cx a, Cx b) { return {a.x * b.x - a.y * b.y, a.x * b.y + a.y * b.x}; }
DEV Cx cfma(Cx a, Cx b, Cx c) { return {a.x * b.x - a.y * b.y + c.x, a.x * b.y + a.y * b.x + c.y}; }
DEV float shx32(float v) { return xshfl<32>(v); }

constexpr int SC = 4, NSG = NCH / SC;
template <bool OUT> DEV void pass(const int wbase, LAS unsigned char* lds, unsigned char* ws, const float* __restrict__ dsk, int layer, int G, int vcu) {
    const int wave = wbase >> 6;
    LAS unsigned char* img = lds + wave * 8192;
    bf16* U = (bf16*)(ws + R_U);
    for (int wi = vcu; wi < BATCH * NSG * (S5G / 8); wi += G) {
        const int lane = pg8::fresh_tid(wbase) & 63, r = lane & 31, hh = lane >> 5;
        const int oct = wi % (S5G / 8), sg = (wi / (S5G / 8)) % NSG, b = wi / ((S5G / 8) * NSG), g = oct * 8 + wave, lg = layer * S5G + g;
        const bf16* BBH = (const bf16*)(ws + TAB_BBH) + (size_t)lg * 128 * 16;
        bf16x8 bbf[4];
#pragma unroll
        for (int nt = 0; nt < 4; ++nt) bbf[nt] = *(const bf16x8*)(BBH + (32 * nt + r) * 16 + 8 * hh);
        Cx a1q[2], c[2];
#pragma unroll
        for (int q = 0; q < 2; ++q) {
            const float2 av = *(const float2*)((const float*)(ws + TAB_AB) + ((size_t)lg * S5N + 32 * q + r) * 2);
            a1q[q] = Cx{av.x, av.y}; c[q] = Cx{0.f, 0.f};
            if (OUT) { Cx ap = a1q[q];
#pragma unroll
                for (int sq = 0; sq < 8; ++sq) ap = cmul(ap, ap);
                const float2* E = (const float2*)(ws + WS_S5E) + ((size_t)(b * NSG) * S5G + g) * S5N + 32 * q + r;
                float2 ev[NSG - 1];
#pragma unroll
                for (int s = 0; s < NSG - 1; ++s) ev[s] = E[(size_t)s * S5G * S5N];
#pragma unroll
                for (int s = 0; s < NSG - 1; ++s) if (s < sg) c[q] = cfma(ap, c[q], Cx{ev[s].x, ev[s].y}); }
        }
        bf16x8 bd; LAS bf16x8* ctl = (LAS bf16x8*)(lds + 65536 + wave * 8192) + lane;
        if (OUT) { const bf16* CTH = (const bf16*)(ws + TAB_CTH) + ((size_t)lg * 16 + (r & 15)) * 128 + 8 * hh;
#pragma unroll
            for (int nt = 0; nt < 4; ++nt)
#pragma unroll
                for (int s = 0; s < 2; ++s) ctl[(nt * 2 + s) * 64] = *(const bf16x8*)(CTH + 32 * nt + 16 * s);
            const float dval = dsk[layer * 512 + g * 16 + (r & 15)];
#pragma unroll
            for (int e = 0; e < 8; ++e) bd[e] = (short)(((r & 15) == 8 * hh + e) ? f2bf(dval) : (bf16)0); }
        const int i16 = lane & 15, q4 = i16 >> 2, p4 = i16 & 3, blk = (lane >> 4) & 1;
        const int rowS = b * SEQ + sg * SC * 64;
        bf16x8 un[2];
#pragma unroll
        for (int th = 0; th < 2; ++th) un[th] = *(const bf16x8*)(U + (size_t)(rowS + 32 * th + r) * 512 + g * 16 + 8 * hh);
#pragma nounroll
        for (int jc = 0; jc < SC; ++jc) {
            const int row0 = rowS + jc * 64;
            bf16x8 ua[2]; ua[0] = un[0]; ua[1] = un[1];
            if (jc + 1 < SC) {
#pragma unroll
                for (int th = 0; th < 2; ++th) un[th] = *(const bf16x8*)(U + (size_t)(row0 + 64 + 32 * th + r) * 512 + g * 16 + 8 * hh); }
#pragma unroll
            for (int th = 0; th < 2; ++th) {
                f32x16 BU[4];
#pragma unroll
                for (int nt = 0; nt < 4; ++nt) { f32x16 z;
#pragma unroll
                    for (int e = 0; e < 16; ++e) z[e] = 0.f;
                    BU[nt] = RMFMA(ua[th], bbf[nt], z); }
#pragma unroll
                for (int q = 0; q < 2; ++q) {
                    const Cx a1 = a1q[q], a2 = cmul(a1, a1), a3 = cmul(a2, a1), a4 = cmul(a2, a2);
                    Cx cc = c[q];
#pragma unroll
                    for (int qb = 0; qb < 4; ++qb) {
                        f32x16& RE = BU[q]; f32x16& IM = BU[2 + q];
                        Cx x = {RE[4 * qb], IM[4 * qb]};
#pragma unroll
                        for (int i = 1; i < 4; ++i) x = cfma(a1, x, Cx{RE[4 * qb + i], IM[4 * qb + i]});
                        const Cx px = {shx32(x.x), shx32(x.y)};
                        const Cx g0 = hh ? px : x, g1 = hh ? x : px;
                        const Cx c0 = cc; cc = cfma(a4, cc, g0); const Cx c1 = cc; cc = cfma(a4, cc, g1);
                        if (OUT) { Cx hx = hh ? c1 : c0;
#pragma unroll
                            for (int i = 0; i < 4; ++i) { hx = cfma(a1, hx, Cx{RE[4 * qb + i], IM[4 * qb + i]}); RE[4 * qb + i] = hx.x; IM[4 * qb + i] = hx.y; } }
                    }
                    c[q] = cc;
                }
                if (OUT) {
                    asm volatile("s_waitcnt lgkmcnt(0)" ::: "memory");
#pragma unroll
                    for (int nt = 0; nt < 4; ++nt)
#pragma unroll
                        for (int g4 = 0; g4 < 4; ++g4) { const f32x16& X = BU[nt];
                            *(LAS pg8::u32x2*)(img + nt * 2048 + r * 64 + 8 * (2 * g4 + hh)) = (pg8::u32x2){cvtpk(X[4 * g4], X[4 * g4 + 1]), cvtpk(X[4 * g4 + 2], X[4 * g4 + 3])}; }
                    asm volatile("s_waitcnt lgkmcnt(0)" ::: "memory");
                    f32x16 Y;
#pragma unroll
                    for (int e = 0; e < 16; ++e) Y[e] = 0.f;
#pragma unroll
                    for (int nt = 0; nt < 4; ++nt)
#pragma unroll
                        for (int s = 0; s < 2; ++s) {
                            const s16x4 lo = trr(img + nt * 2048 + (16 * s + 8 * hh + q4) * 64 + 8 * (4 * blk + p4));
                            const s16x4 hi = trr(img + nt * 2048 + (16 * s + 8 * hh + 4 + q4) * 64 + 8 * (4 * blk + p4));
                            const bf16x8 xa = __builtin_shufflevector(lo, hi, 0, 1, 2, 3, 4, 5, 6, 7);
                            Y = RMFMA(xa, ctl[(nt * 2 + s) * 64], Y);
                        }
                    Y = RMFMA(ua[th], bd, Y);
                    { const int up = r >> 4;
#pragma unroll
                      for (int e = 0; e < 8; ++e) { const float yv = up ? Y[8 + e] : Y[e]; const float u3 = yv * yv * yv;
                          const float zz = yv * __builtin_amdgcn_rcpf(1.f + __expf(-1.5957691216057308f * (yv + 0.044715f * u3)));
                          U[(size_t)(row0 + 32 * th + (e & 3) + 8 * ((e >> 2) + 2 * up) + 4 * hh) * 512 + g * 16 + (r & 15)] = f2bf(zz); } }
                }
            }
        }
        if (!OUT) {
            if (hh == 0) { float2* E = (float2*)(ws + WS_S5E) + ((size_t)(b * NSG + sg) * S5G + g) * S5N + r;
                E[0] = make_float2(c[0].x, c[0].y); E[32] = make_float2(c[1].x, c[1].y); }
        }
    }
    asm volatile("s_waitcnt lgkmcnt(0)" ::: "memory");
    __syncthreads();
}
}

__global__ void __launch_bounds__(NWAVES * 64, 2) mk_fwd(Args args_k) {
    extern __shared__ __attribute__((aligned(16))) unsigned char lds_raw[];
    LAS unsigned char* lds = (LAS unsigned char*)lds_raw;
    volatile LAS unsigned* MISC = (volatile LAS unsigned*)(lds + MISC_OFF);
    const int wbase = __builtin_amdgcn_readfirstlane((int)threadIdx.x) & ~63;
    const int G = gridDim.x;
    unsigned* ctl = (unsigned*)(args_k.ws + WS_CTL);
    { const int tid = pg8::fresh_tid(wbase); for (int u = tid; u < (LDS_BYTES - LDSCTL_OFF) / 4; u += NWAVES * 64) ((LAS unsigned*)(lds + LDSCTL_OFF))[u] = 0u; }
    __syncthreads();
    if (pg8::fresh_tid(wbase) == 0) { const unsigned b0 = blockIdx.x; MISC[8 + 4] = b0; MISC[8 + 5] = (G % 8 == 0) ? (b0 % 8u) * (unsigned)(G / 8) + b0 / 8u : b0; }
    __syncthreads();
    if ((args_k.ph_hi - args_k.ph_lo) > 1) (void)xcd_barrier_post(ctl + CW_BAR + args_k.bar_id * XCD_BAR_WORDS, MISC + 8, pg8::fresh_tid(wbase) == 0);
    const int ph_lo = args_k.ph_lo, ph_hi = args_k.ph_hi;
    bool rep_done = false; (void)rep_done;
    for (int ph = ph_lo; ph < ph_hi; ++ph) {
        const int l = ph > 0 ? (ph - 1) / NPL : 0, k = ph > 0 ? (ph - 1) % NPL : -1;
        unsigned moff = MISC_OFF + 32; asm volatile("" : "+s"(moff));
        const volatile LAS unsigned* MS = (const volatile LAS unsigned*)(lds + moff);
        const bool lok = __builtin_amdgcn_readfirstlane((int)MS[2]) != 0;
        const int bx = __builtin_amdgcn_readfirstlane((int)MS[4]), vcu = __builtin_amdgcn_readfirstlane((int)MS[5]);
        const __attribute__((address_space(4))) Args* ap = (const __attribute__((address_space(4))) Args*)__builtin_amdgcn_kernarg_segment_ptr(); asm volatile("" : "+s"(ap));
        const Args& args = *(const Args*)ap;
        unsigned char* ws = ap->ws;
        float* hA = ap->out; float* hB = (float*)(ws + WS_HB); bf16* hbf = (bf16*)(ws + WS_HBF);
        switch (k) {
        case -1: { ph::ProIn P{args.in[0], args.in[1], args.in[2], args.in[3], args.in[4], args.in[5], args.in[6], args.in[7], args.in[8], args.in[9], args.in[10], args.in[12], args.in[13], args.in[14], args.in[15], args.in[18], args.in[20], args.out};
            ph::prologue(wbase, lds, ws, P, G, vcu); } break;
        case K_PROJ: case K_BRANCH: {
            if (k == K_BRANCH) {
            { pg8::Gemm g{(const bf16*)(ws + R_V), (const bf16*)(ws + W_BRET) + (size_t)l * Dm * RV, RV}; pg8::StaticOrder S; S.init(T, Dm, RV, G, bx);
              epi::EpiRet E{ws}; pg8::gemm_phase<RV, epi::EpiRet, pg8::StaticOrder, true>(wbase, lds + RING_OFF, lds + PARK_OFF, g, S, E); }
            { pg8::Gemm g{(const bf16*)(ws + R_U), (const bf16*)(ws + W_GLU) + (size_t)l * S5W * S5W, S5W}; pg8::StaticOrder S; S.init(T, S5W, S5W, G, bx);
              epi::EpiGlu E{ws}; pg8::gemm_phase<S5W, epi::EpiGlu, pg8::StaticOrder, true>(wbase, lds + RING_OFF, lds + PARK_OFF, g, S, E); }
            }
            { const bool late = (k == K_BRANCH); const int hg = G / 2;
              pg8::Gemm g{hbf, (const bf16*)(ws + W_IN) + (size_t)l * INW * Dm, Dm}; pg8::StaticOrder S; S.init(T, late ? 512 : INW - 512, Dm, G, late ? (bx >= hg ? bx - hg : bx + G - hg) : bx, late ? (INW - 512) / 256 : 0);
              epi::EpiProj E{ws}; pg8::gemm_phase<Dm, epi::EpiProj, pg8::StaticOrder, true>(wbase, lds + RING_OFF, lds + PARK_OFF, g, S, E); } } break;
        case K_RETA: ret::phase_a(wbase, lds, ws, G, vcu); s5::pass<false>(wbase, lds, ws, nullptr, l, G, vcu); break;
        case K_RETB: ret::phase_b(wbase, lds, ws, G, vcu); s5::pass<true>(wbase, lds, ws, ap->in[11], l, G, vcu); break;
        case K_S5B: {
            pg8::Gemm g{(const bf16*)(ws + R_S5IN), (const bf16*)(ws + W_BS5) + (size_t)l * Dm * S5W, S5W}; pg8::StaticOrder S; S.init(T, Dm, S5W, G, bx);
            epi::EpiS5b E{ws}; pg8::gemm_phase<S5W, epi::EpiS5b, pg8::StaticOrder, true>(wbase, lds + RING_OFF, lds + PARK_OFF, g, S, E); } break;
        case K_OUT: {
            pg8::Gemm g{(const bf16*)(ws + R_G), (const bf16*)(ws + W_OUT) + (size_t)l * Dm * Dm, Dm}; pg8::StaticOrder S; S.init(T, Dm, Dm, G, bx);
            epi::EpiOut E{hbf, (bf16*)hB}; pg8::gemm_phase<Dm, epi::EpiOut, pg8::StaticOrder, true>(wbase, lds + RING_OFF, lds + PARK_OFF, g, S, E); } break;
        case K_LNROUTE: { ph::RouteIn P{args.in[16] + l * Dm, args.in[17] + l * Dm, args.in[19] + l * MG, args.in[21] + l * NE, args.in[22] + (size_t)l * NE * Dm * FF, args.in[23] + (size_t)l * NE * Dm * FF, args.in[24] + (size_t)l * NE * FF * Dm};
            ph::phase_lnroute(wbase, lds, ws, P, l, G, vcu); } break;
        case K_MOEGU: case K_MOEDN: {
            LAS unsigned* tp = (LAS unsigned*)(lds + LDSCTL_OFF + 512);
            const int tid = pg8::fresh_tid(wbase);
            if (tid < 32) tp[33 + tid] = __hip_atomic_load((unsigned*)(ws + WS_CNT) + l * NE + tid, __ATOMIC_RELAXED, __HIP_MEMORY_SCOPE_AGENT);
            __syncthreads();
            if (tid == 0) { unsigned a = 0; for (int j = 0; j < 32; ++j) { tp[j] = a; a += (tp[33 + j] + 255u) >> 8; } tp[32] = a; }
            __syncthreads();
            const unsigned* LIST = (const unsigned*)(ws + RT_LIST);
            if (k == K_MOEGU) {
                pg8::Gemm g{hbf, (const bf16*)(ws + R_WGU), Dm}; pg8::GroupedOrder S{tp, LIST, 2, G, vcu, 1};
                epi::EpiMoeGU E{ws, LIST}; pg8::gemm_phase<Dm, epi::EpiMoeGU, pg8::GroupedOrder, true>(wbase, lds + RING_OFF, lds + PARK_OFF, g, S, E);
                { const int U = 2 * __builtin_amdgcn_readfirstlane((int)tp[32]), R2 = U > G ? (U - G < G ? U - G : G) : 0, W1 = G - R2;
                  if (W1 > 0 && vcu >= R2) { const int lane = pg8::fresh_tid(wbase) & 63, wv = wbase >> 6; LAS float* scr = (LAS float*)(lds + wv * 16384); constexpr int I_D = (FF / 64) * (Dm / 32);
                      const float* wd = ap->in[24] + (size_t)l * NE * FF * Dm;
                      for (int it = (vcu - R2) * NWAVES + wv; it < NE * I_D; it += W1 * NWAVES) { const int e = it / I_D, r = it % I_D;
                          ph::transpose_item(wd + (size_t)e * FF * Dm, FF, Dm, (bf16*)(ws + R_WDN) + (size_t)e * Dm * FF, 1, 0, scr, r, lane); } }
                  else if (W1 <= 0) { const int lane = pg8::fresh_tid(wbase) & 63, wv = wbase >> 6; LAS float* scr = (LAS float*)(lds + wv * 16384); constexpr int I_D = (FF / 64) * (Dm / 32);
                      const float* wd = ap->in[24] + (size_t)l * NE * FF * Dm;
                      for (int it = bx * NWAVES + wv; it < NE * I_D; it += G * NWAVES) { const int e = it / I_D, r = it % I_D;
                          ph::transpose_item(wd + (size_t)e * FF * Dm, FF, Dm, (bf16*)(ws + R_WDN) + (size_t)e * Dm * FF, 1, 0, scr, r, lane); } }
                  __syncthreads(); }
            } else {
                pg8::Gemm g{(const bf16*)(ws + R_ACT), (const bf16*)(ws + R_WDN), FF}; pg8::GroupedOrder S{tp, LIST, 4, G, vcu, 0};
                epi::EpiMoeDN E{ws, LIST}; pg8::gemm_phase<FF, epi::EpiMoeDN, pg8::GroupedOrder, true>(wbase, lds + RING_OFF, lds + PARK_OFF, g, S, E);
            } } break;
        case K_LN2: ph::phase_ln2(wbase, ws, args.in[25] + l * Dm, args.in[26] + l * Dm, l == DEPTH - 1 ? args.out : nullptr, G, vcu); break;
        default: break;
        }
#ifdef PROBE_REP_MASK
        if (((k >= 0 && ((PROBE_REP_MASK >> k) & 1)) || (k < 0 && (PROBE_REP_MASK & 0x8000))) && !rep_done) { rep_done = true; --ph; } else rep_done = false;
#endif
        if (ph + 1 < ph_hi) { XcdBarrier bar; bar.bar = (unsigned*)(ws + WS_CTL) + CW_BAR + ap->bar_id * XCD_BAR_WORDS; bar.x = xb_xcc_id(); bar.st = (volatile LAS unsigned*)(lds + MISC_OFF) + 8;
            const bool local = lok && (k == K_PROJ || k == K_RETA || k == K_RETB || k == K_BRANCH || k == K_S5B || k == K_OUT);
            xcd_barrier(bar, pg8::fresh_tid(wbase) == 0, local); }
    }
}
#ifndef MK_ONE_LAUNCH
#define MK_ONE_LAUNCH 1
#endif
static int g_grid = 0;
static void launch_mk(const Args& base, int lo, int hi, int bar_id, hipStream_t stream) {
    Args a = base; a.ph_lo = lo; a.ph_hi = hi; a.bar_id = bar_id;
    hipLaunchKernelGGL(mk_fwd, dim3(g_grid), dim3(NWAVES * 64), LDS_BYTES, stream, a);
}
extern "C" void kernel_launch(void* const* d_in, const int* in_sizes, int n_in, void* d_out, int out_size, void* d_ws, size_t ws_size, hipStream_t stream) {
    static int ok = 0;
    if (ok == 0) {
        if (n_in != 27 || in_sizes[0] != T * Dm || out_size != T * Dm || ws_size < WS_END) { fprintf(stderr, "kernel_launch: unexpected shapes/ws (%d, %d, %d, %zu < %zu)\n", n_in, n_in > 0 ? in_sizes[0] : -1, out_size, ws_size, (size_t)WS_END); ok = -1; return; }
        int dev = 0, cus = 0;
        if (hipGetDevice(&dev) != hipSuccess || hipDeviceGetAttribute(&cus, hipDeviceAttributeMultiprocessorCount, dev) != hipSuccess) { fprintf(stderr, "kernel_launch: device query failed\n"); ok = -1; return; }
        if (hipFuncSetAttribute((const void*)mk_fwd, hipFuncAttributeMaxDynamicSharedMemorySize, LDS_BYTES) != hipSuccess) { fprintf(stderr, "kernel_launch: LDS attribute failed\n"); ok = -1; return; }
        g_grid = cus;
        ok = 1;
    }
    if (ok < 0) return;
    unsigned char* ws = (unsigned char*)d_ws;
    const float* const* in = (const float* const*)d_in;
    float* hA = (float*)d_out;
    (void)hipMemsetAsync(ws + WS_CTL, 0, 1 * MiB, stream);
    Args base{}; for (int i = 0; i < 27; ++i) base.in[i] = in[i]; base.out = hA; base.ws = ws;
#if MK_ONE_LAUNCH
    launch_mk(base, 0, NPH, 0, stream);
#else
    for (int p = 0; p < NPH; ++p) launch_mk(base, p, p + 1, 0, stream);
#endif
}
```

```cpp
#include <hip/hip_runtime.h>
#include <cstdio>
#include <cstdint>
#include <cmath>

typedef unsigned short bf16;
#define DEV __device__ __forceinline__

constexpr int Dm = 1024, BATCH = 8, SEQ = 2048, T = BATCH * SEQ, DEPTH = 2;
constexpr int CHUNK = 64, NCH = SEQ / CHUNK;
constexpr int RH = 8, RQK = 512, RV = 1024, DK = 64, DV = 128;
constexpr int S5W = 512, S5G = 32, S5GC = 16, S5N = 64;
constexpr int MG = 4, EPG = 8, NE = 32, FF = 256;
constexpr int INW = 5632;
constexpr float LN_EPS = 1e-5f, HN_EPS = 1e-6f;
constexpr float ALPHA = 1.41421356237309515f;

constexpr size_t MiB = 1u << 20;
constexpr size_t WS_CTL = 0;
constexpr size_t WS_CNT = 64 * 1024;
constexpr size_t WS_TAB = 1 * MiB;
constexpr size_t TAB_COS = WS_TAB;
constexpr size_t TAB_SIN = TAB_COS + 2048 * 32 * 4;
constexpr size_t TAB_POWG = TAB_SIN + 2048 * 32 * 4;
constexpr size_t TAB_AB = TAB_POWG + 8 * 80 * 4;
constexpr size_t TAB_BBH = TAB_AB + DEPTH * S5G * S5N * 2 * 4;
constexpr size_t TAB_CTH = TAB_BBH + (size_t)DEPTH * S5G * 128 * 16 * 2;
constexpr size_t TAB_WRT = TAB_CTH + (size_t)DEPTH * S5G * 16 * 128 * 2;
constexpr size_t TAB_WRH = TAB_WRT + (size_t)DEPTH * 36 * Dm * 4;
constexpr size_t TAB_WRL = TAB_WRH + (size_t)DEPTH * 48 * Dm * 2;
constexpr size_t TAB_END = TAB_WRL + (size_t)DEPTH * 48 * Dm * 2;
static_assert(TAB_END <= 3 * MiB, "tables");
constexpr size_t WS_S5E = 3 * MiB;
constexpr size_t WS_ROUTE = 7 * MiB;
constexpr size_t RT_E = WS_ROUTE, RT_C = RT_E + (size_t)T * 2 * 4, RT_LIST = RT_C + (size_t)T * 2 * 4;
static_assert(RT_LIST + (size_t)NE * T * 4 <= 10 * MiB, "route");
constexpr size_t WS_WSM = 10 * MiB;
constexpr size_t W_IN = WS_WSM;
constexpr size_t W_GLU = W_IN + (size_t)DEPTH * INW * Dm * 2;
constexpr size_t W_BRET = W_GLU + (size_t)DEPTH * S5W * S5W * 2;
constexpr size_t W_BS5 = W_BRET + (size_t)DEPTH * Dm * RV * 2;
constexpr size_t W_OUT = W_BS5 + (size_t)DEPTH * Dm * S5W * 2;
constexpr size_t W_END = W_OUT + (size_t)DEPTH * Dm * Dm * 2;
static_assert(W_END <= 44 * MiB, "small weights");
constexpr size_t WS_HB = 44 * MiB;
constexpr size_t WS_HBF = 108 * MiB;
constexpr size_t WS_R1 = 140 * MiB;
constexpr size_t R_Q = WS_R1, R_K = R_Q + 16 * MiB, R_U = R_K + 16 * MiB, R_GR = R_U + 16 * MiB, R_GS = R_GR + 32 * MiB;
constexpr size_t WS_R2 = 252 * MiB;
constexpr size_t R_V = WS_R2, R_G = R_V + 32 * MiB;
constexpr size_t WS_END = 316 * MiB;
constexpr size_t R_S5IN = R_Q;
constexpr size_t R_WGU = WS_R1;
constexpr size_t R_WDN = WS_R1 + 32 * MiB;
constexpr size_t R_ACT = WS_R1 + 48 * MiB;
constexpr size_t R_Y = WS_R2;

DEV float bf2f(bf16 v) { return __uint_as_float((unsigned)v << 16); }
DEV bf16 f2bf(float f) { unsigned u = __float_as_uint(f); return (bf16)((u + 0x7fffu + ((u >> 16) & 1u)) >> 16); }
DEV float sigmoidf_(float x) { return 1.f / (1.f + __expf(-x)); }
DEV float siluf_(float x) { return x * sigmoidf_(x); }
DEV float geluf_(float x) { const float c = 0.7978845608028654f; float t = tanhf(c * (x + 0.044715f * x * x * x)); return 0.5f * x * (1.f + t); }
template <int M> DEV float xshfl(float v) {
    if constexpr (M < 32) return __int_as_float(__builtin_amdgcn_ds_swizzle(__float_as_int(v), 0x1f | (M << 10)));
    else { const unsigned u = __float_as_uint(v); auto rr = __builtin_amdgcn_permlane32_swap(u, u, false, false);
           const bool hi = (__builtin_amdgcn_mbcnt_hi(~0u, __builtin_amdgcn_mbcnt_lo(~0u, 0u)) >= 32u); return __uint_as_float(hi ? rr[0] : rr[1]); }
}
template <int CTRL> DEV float dpp_add(float v) { return v + __int_as_float(__builtin_amdgcn_update_dpp(0, __float_as_int(v), CTRL, 0xf, 0xf, true)); }
DEV float wave_sum(float v) {
    v = dpp_add<0xB1>(v); v = dpp_add<0x4E>(v); v = dpp_add<0x141>(v); v = dpp_add<0x140>(v); v += xshfl<16>(v); v += xshfl<32>(v);
    return v;
}

namespace pg8 {
#define PG8_LAS __attribute__((address_space(3)))
typedef unsigned short bf16_t;
typedef short bf16x8 __attribute__((ext_vector_type(8)));
typedef float f32x4 __attribute__((ext_vector_type(4)));
typedef unsigned u32x4 __attribute__((ext_vector_type(4)));
typedef unsigned u32x2 __attribute__((ext_vector_type(2)));
typedef float f32x2 __attribute__((ext_vector_type(2)));
constexpr int BM = 256, BK = 64, HALF = 128, HTB = HALF * BK * 2  , STAGE_BYTES = 8 * HTB, NXCD = 8, WGM = 8;

__host__ __device__ __forceinline__ int lds_byte(int r, int c) { const int st = (r >> 4) * 2 + (c >> 5), rr = r & 15, cc = c & 31, ob = rr * 64 + cc * 2; return st * 1024 + (ob ^ (((ob >> 9) & 1) << 5)); }
__host__ __device__ __forceinline__ void stage_rc(int b, int& R, int& C) { const int st = b / 1024, sb = b % 1024, swz = sb ^ (((sb >> 9) & 1) << 5); R = (st >> 1) * 16 + swz / 64; C = (st & 1) * 32 + (swz % 64) / 2; }
__host__ __device__ __forceinline__ int perm32(int rho) { const int n = rho >> 4, i = rho & 15; return 8 * (i >> 2) + 4 * n + (i & 3); }

struct Unit { int pm, pn, pnb, e, cnt; };
struct Gemm { const bf16_t* A; const bf16_t* Bt; int K; };

struct StaticOrder {
    int nM, nN, nwg, G, c, K, pn0;
    __device__ void init(int M, int N, int K_, int G_, int c_, int pn0_ = 0) { nM = M / BM; nN = N / BM; nwg = nM * nN; G = G_; c = c_; K = K_; pn0 = pn0_; }
    __device__ bool next(int i, Unit& u) const {
        const long L = (long)i * G + c; if (L >= nwg) return false;
        int wgid = (int)L; { const int q = nwg / NXCD, r = nwg % NXCD, xcd = wgid % NXCD, off = wgid / NXCD; wgid = (xcd < r ? xcd * (q + 1) : r * (q + 1) + (xcd - r) * q) + off; }
        const int nig = WGM * nN, gid = wgid / nig, fm = gid * WGM, gsz = (nM - fm) < WGM ? (nM - fm) : WGM;
        u.pm = fm + ((wgid % nig) % gsz); u.pn = pn0 + (wgid % nig) / gsz; u.pnb = u.pn; u.e = 0; u.cnt = 0; return true;
    }
    static constexpr bool GATHER = false;
    __device__ __forceinline__ const unsigned* list_ptr(const Unit&, int) const { return nullptr; }
    __device__ __forceinline__ unsigned row_of(unsigned e) const { return e; }
};

__device__ __forceinline__ unsigned cvt_pk_bf16(float lo, float hi) { unsigned r; asm volatile("v_cvt_pk_bf16_f32 %0, %1, %2" : "=v"(r) : "v"(lo), "v"(hi)); return r; }

__device__ __forceinline__ int fresh_tid(int wbase) { int t = wbase + (int)__builtin_amdgcn_mbcnt_hi(~0u, __builtin_amdgcn_mbcnt_lo(~0u, 0u)); asm volatile("" : "+v"(t)); return t; }
template <int K, class Epi, class Sched, bool ALIGN_EPI = false>
__device__ __forceinline__ void gemm_phase(const int wbase, PG8_LAS unsigned char* lds, PG8_LAS unsigned char* park, const Gemm g, const Sched& S, const Epi& E) {
    constexpr bool GA = Sched::GATHER;
    const int wid = wbase >> 6, wr = wid >> 2, wc = wid & 3;
    const int tid = fresh_tid(wbase);
    constexpr int nt = K / BK; static_assert(K % 128 == 0 && K >= 256, "K");
    unsigned voffA[2], voffB[2];
#pragma unroll
    for (int i = 0; i < 2; ++i) { int R, C; stage_rc(tid * 16 + i * 8192, R, C); const int Rb = Epi::PERM ? ((R & ~31) + perm32(R & 31)) : R;
        voffA[i] = (unsigned)(R * K + C) * 2u; voffB[i] = (unsigned)(Rb * K + C) * 2u; }
#define PG8_RC(i, R, C) int R, C; stage_rc(fresh_tid(wbase) * 16 + (i) * 8192, R, C)
    const int kstep = BK * 2;
    const int hstep = HALF * K * 2;
    const int tstep = 2 * hstep;
    const __amdgpu_buffer_rsrc_t rsA = __builtin_amdgcn_make_buffer_rsrc((void*)g.A, 0, 0x7fffffff, 0x00020000);
    const __amdgpu_buffer_rsrc_t rsB = __builtin_amdgcn_make_buffer_rsrc((void*)g.Bt, 0, 0x7fffffff, 0x00020000);
    const unsigned ldsw = (unsigned)wid * 1024u;
    const int aoff = lds_byte(wr * 64 + (tid & 15), ((tid & 63) >> 4) * 8), boff = lds_byte(wc * 32 + (tid & 15), ((tid & 63) >> 4) * 8);
#define PG8_SA(b, h) (((b) * 2 + (h)) * HTB)
#define PG8_SB(b, h) ((4 + (b) * 2 + (h)) * HTB)
#define PG8_STAGE(bufoff, rs, voff, so) do { _Pragma("unroll") for (int _i = 0; _i < 2; ++_i) \
        __builtin_amdgcn_raw_ptr_buffer_load_lds(rs, (PG8_LAS void*)(lds + (bufoff) + ldsw + _i * 8192), 16, (int)(voff)[_i], (int)(so), 0, 0); } while (0)
#define PG8_STAGE_B(bufoff, so) PG8_STAGE(bufoff, rsB, voffB, so)
#define PG8_STAGE_A(bufoff, h, kb) do { if constexpr (GA) { if ((h) == 0) PG8_STAGE(bufoff, rsA, ao0, kb); else PG8_STAGE(bufoff, rsA, ao1, kb); } else { PG8_STAGE(bufoff, rsA, voffA, (kb) + (h) * hstep); } } while (0)
#define PG8_LDA(dst, b, h) do { _Pragma("unroll") for (int m = 0; m < 4; ++m) _Pragma("unroll") for (int k = 0; k < 2; ++k) dst[m][k] = *(const PG8_LAS bf16x8*)(lds + PG8_SA(b, h) + aoff + m * 2048 + k * 1024); } while (0)
#define PG8_LDB(dst, b, h) do { _Pragma("unroll") for (int n = 0; n < 2; ++n) _Pragma("unroll") for (int k = 0; k < 2; ++k) dst[n][k] = *(const PG8_LAS bf16x8*)(lds + PG8_SB(b, h) + boff + n * 2048 + k * 1024); } while (0)
#define PG8_MMA(ai, bj, At, Bt) do { __builtin_amdgcn_s_setprio(1); _Pragma("unroll") for (int m = 0; m < 4; ++m) _Pragma("unroll") for (int n = 0; n < 2; ++n) _Pragma("unroll") for (int k = 0; k < 2; ++k) \
        acc[ai][bj][m][n] = __builtin_amdgcn_mfma_f32_16x16x32_bf16(Bt[n][k], At[m][k], acc[ai][bj][m][n], 0, 0, 0); __builtin_amdgcn_s_setprio(0); } while (0)
#define PG8_WAIT_V(n) asm volatile("s_waitcnt vmcnt(" #n ")" ::: "memory")
#define PG8_WAIT_L(n) asm volatile("s_waitcnt lgkmcnt(" #n ")" ::: "memory")
#define PG8_BAR __builtin_amdgcn_s_barrier()
#define PG8_SCHED __builtin_amdgcn_sched_barrier(0)
    Unit cur, nxt; int ui = 0;
    if (!S.next(0, cur)) return;
    f32x4 acc[2][2][4][2];
#pragma unroll
    for (int a = 0; a < 2; ++a)
#pragma unroll
        for (int b = 0; b < 2; ++b)
#pragma unroll
            for (int m = 0; m < 4; ++m)
#pragma unroll
                for (int n = 0; n < 2; ++n) acc[a][b][m][n] = (f32x4){0.f, 0.f, 0.f, 0.f};
    bf16x8 At[4][2], B0[2][2], B1[2][2];
    unsigned ao0[2] = {0u, 0u}, ao1[2] = {0u, 0u};
    if constexpr (GA) {
#pragma unroll
        for (int i = 0; i < 2; ++i) { PG8_RC(i, R, C); ao0[i] = (S.row_of(*S.list_ptr(cur, R)) * (unsigned)K + (unsigned)C) * 2u; ao1[i] = (S.row_of(*S.list_ptr(cur, HALF + R)) * (unsigned)K + (unsigned)C) * 2u; }
    }
    int cA = GA ? 0 : cur.pm * tstep;
    int cB = cur.pnb * tstep;
    PG8_STAGE_B(PG8_SB(0, 0), cB); PG8_STAGE_B(PG8_SB(0, 1), cB + hstep); PG8_STAGE_A(PG8_SA(0, 0), 0, cA); PG8_STAGE_A(PG8_SA(0, 1), 1, cA);
    if (wr == 1) PG8_BAR;
    PG8_WAIT_V(2); PG8_BAR;
    PG8_STAGE_B(PG8_SB(1, 0), cB + kstep); PG8_STAGE_A(PG8_SA(1, 0), 0, cA + kstep); PG8_STAGE_B(PG8_SB(1, 1), cB + hstep + kstep);
    PG8_WAIT_V(6); PG8_BAR;
    for (;;) {
        const bool has_next = S.next(ui + 1, nxt);
        const int nA = (GA || !has_next) ? cA : nxt.pm * tstep; const int nB = has_next ? nxt.pnb * tstep : cB;
        if constexpr (GA) { if (has_next) {
#pragma unroll
            for (int s = 0; s < 4; ++s) { PG8_RC(s & 1, R, C); (void)C; __builtin_amdgcn_global_load_lds(S.list_ptr(nxt, (s >> 1) * HALF + R), (PG8_LAS unsigned*)(park + s * 2048 + wid * 256), 4, 0, 0); } } }
#define PG8_TRIP(LASTT) do { \
            const int a1 = cA + (t + 1) * kstep; \
            PG8_LDB(B0, 0, 0); PG8_LDB(B1, 0, 1); PG8_SCHED; PG8_LDA(At, 0, 0); PG8_STAGE_A(PG8_SA(1, 1), 1, a1); \
            if constexpr (GA && (LASTT)) { if (has_next) { _Pragma("unroll") for (int i = 0; i < 2; ++i) { PG8_RC(i, R, C); (void)R; const int t4 = fresh_tid(wbase) * 4; \
                ao0[i] = (S.row_of(*(const PG8_LAS unsigned*)(park + (0 + i) * 2048 + t4)) * (unsigned)K + (unsigned)C) * 2u; \
                ao1[i] = (S.row_of(*(const PG8_LAS unsigned*)(park + (2 + i) * 2048 + t4)) * (unsigned)K + (unsigned)C) * 2u; } } } \
            const int a2 = (LASTT) ? nA : cA + (t + 2) * kstep; const int b2 = (LASTT) ? nB : cB + (t + 2) * kstep; \
            const int a3 = a2 + kstep; const int b3 = b2 + kstep; \
            PG8_WAIT_V(8); PG8_WAIT_L(0); PG8_BAR; PG8_MMA(0, 0, At, B0); PG8_MMA(0, 1, At, B1); PG8_BAR; PG8_SCHED; \
            PG8_LDA(At, 0, 1); PG8_STAGE_B(PG8_SB(0, 0), b2); PG8_STAGE_B(PG8_SB(0, 1), b2 + hstep); PG8_STAGE_A(PG8_SA(0, 0), 0, a2); \
            PG8_WAIT_V(8); PG8_WAIT_L(0); PG8_BAR; PG8_MMA(1, 0, At, B0); PG8_MMA(1, 1, At, B1); PG8_BAR; PG8_SCHED; \
            PG8_LDB(B0, 1, 0); PG8_LDB(B1, 1, 1); PG8_SCHED; PG8_LDA(At, 1, 0); PG8_STAGE_A(PG8_SA(0, 1), 1, a2); \
            PG8_WAIT_V(8); PG8_WAIT_L(0); PG8_BAR; PG8_MMA(0, 0, At, B0); PG8_MMA(0, 1, At, B1); PG8_BAR; PG8_SCHED; \
            PG8_LDA(At, 1, 1); PG8_STAGE_B(PG8_SB(1, 0), b3); PG8_STAGE_B(PG8_SB(1, 1), b3 + hstep); PG8_STAGE_A(PG8_SA(1, 0), 0, a3); \
            PG8_WAIT_V(8); PG8_WAIT_L(0); PG8_BAR; PG8_MMA(1, 0, At, B0); PG8_MMA(1, 1, At, B1); PG8_BAR; PG8_SCHED; \
        } while (0)
        int t = 0; int ntm = nt - 2; asm volatile("" : "+s"(ntm));
        for (; t < ntm; t += 2) PG8_TRIP(false);
        PG8_TRIP(true);
#undef PG8_TRIP
        if constexpr (ALIGN_EPI) { if (wr == 0) PG8_BAR; }
        { const int te = fresh_tid(wbase); E(acc, cur, wr, wc, te & 15, (te & 63) >> 4); }
        if (!has_next) break;
#pragma unroll
        for (int a = 0; a < 2; ++a)
#pragma unroll
            for (int b = 0; b < 2; ++b)
#pragma unroll
                for (int m = 0; m < 4; ++m)
#pragma unroll
                    for (int n = 0; n < 2; ++n) acc[a][b][m][n] = (f32x4){0.f, 0.f, 0.f, 0.f};
        cur = nxt; cA = nA; cB = nB; ++ui;
        if constexpr (ALIGN_EPI) { if (wr == 1) PG8_BAR; }
    }
    PG8_WAIT_V(0);
    if constexpr (!ALIGN_EPI) { if (wr == 0) PG8_BAR; }
    PG8_BAR;
#undef PG8_SA
#undef PG8_SB
#undef PG8_STAGE
#undef PG8_STAGE_A
#undef PG8_STAGE_B
#undef PG8_RC
#undef PG8_LDA
#undef PG8_LDB
#undef PG8_MMA
#undef PG8_WAIT_V
#undef PG8_WAIT_L
#undef PG8_BAR
#undef PG8_SCHED
}
}
namespace epi {
using pg8::f32x4; using pg8::u32x4; using pg8::u32x2; using pg8::Unit; using pg8::cvt_pk_bf16;
DEV float fsig(float x) { return __builtin_amdgcn_rcpf(1.f + __expf(-x)); }
DEV void st16(void* p, const u32x4 v) { asm volatile("global_store_dwordx4 %0, %1, off sc1\n\ts_nop 1" :: "v"(p), "v"(v) : "memory"); }
DEV u32x4 pack8(const f32x4 a, const f32x4 b) { u32x4 w; w.x = cvt_pk_bf16(a[0], a[1]); w.y = cvt_pk_bf16(a[2], a[3]); w.z = cvt_pk_bf16(b[0], b[1]); w.w = cvt_pk_bf16(b[2], b[3]); return w; }
DEV void unpack8(const u32x4 w, f32x4& a, f32x4& b) {
    a[0] = __uint_as_float(w.x << 16); a[1] = __uint_as_float(w.x & 0xffff0000u); a[2] = __uint_as_float(w.y << 16); a[3] = __uint_as_float(w.y & 0xffff0000u);
    b[0] = __uint_as_float(w.z << 16); b[1] = __uint_as_float(w.z & 0xffff0000u); b[2] = __uint_as_float(w.w << 16); b[3] = __uint_as_float(w.w & 0xffff0000u); }
#define EPI_FOR8(...) _Pragma("unroll") for (int ai = 0; ai < 2; ++ai) _Pragma("unroll") for (int m = 0; m < 4; ++m) _Pragma("unroll") for (int bj = 0; bj < 2; ++bj) { \
        const int row = u.pm * 256 + ai * 128 + wr * 64 + m * 16 + fr; const int ct = bj * 128 + wc * 32 + 8 * fq; f32x4 v0 = acc[ai][bj][m][0], v1 = acc[ai][bj][m][1]; __VA_ARGS__ }

struct EpiProj {
    static constexpr bool PERM = true;
    unsigned char* ws;
    DEV void operator()(const f32x4 (&acc)[2][2][4][2], const Unit& u, int wr, int wc, int fr, int fq) const {
        const int pn = u.pn; bf16* base; int ld, c0, act; float sc = 1.f;
        if (pn < 2) { base = (bf16*)(ws + R_Q); ld = 512; c0 = pn * 256; act = 0; }
        else if (pn < 4) { base = (bf16*)(ws + R_K); ld = 512; c0 = (pn - 2) * 256; act = 0; sc = 0.125f; }
        else if (pn < 8) { base = (bf16*)(ws + R_V); ld = 1024; c0 = (pn - 4) * 256; act = 0; }
        else if (pn < 12) { base = (bf16*)(ws + R_G); ld = 1024; c0 = (pn - 8) * 256; act = 1; }
        else if (pn < 14) { base = (bf16*)(ws + R_U); ld = 512; c0 = (pn - 12) * 256; act = 0; }
        else if (pn < 18) { base = (bf16*)(ws + R_GR); ld = 1024; c0 = (pn - 14) * 256; act = 2; }
        else { base = (bf16*)(ws + R_GS); ld = 1024; c0 = (pn - 18) * 256; act = 2; }
        EPI_FOR8(
            if (act == 1) { _Pragma("unroll") for (int j = 0; j < 4; ++j) { v0[j] = v0[j] * fsig(v0[j]); v1[j] = v1[j] * fsig(v1[j]); } }
            else if (act == 2) { _Pragma("unroll") for (int j = 0; j < 4; ++j) { v0[j] = fsig(v0[j]); v1[j] = fsig(v1[j]); } }
            else { v0 = v0 * sc; v1 = v1 * sc; }
            st16(base + (size_t)row * ld + c0 + ct, pack8(v0, v1)); )
    }
};
#define EPI_OFF(m, bj, LD) ((size_t)(u.pm * 256 + ai * 128 + wr * 64 + (m) * 16 + fr) * (LD) + u.pn * 256 + (bj) * 128 + wc * 32 + 8 * fq)
struct EpiRet {
    static constexpr bool PERM = true;
    unsigned char* ws;
    DEV void operator()(const f32x4 (&acc)[2][2][4][2], const Unit& u, int wr, int wc, int fr, int fq) const {
        const bf16* GR = (const bf16*)(ws + R_GR); bf16* O = (bf16*)(ws + R_G);
#pragma unroll
        for (int ai = 0; ai < 2; ++ai) { u32x4 gv[4][2];
#pragma unroll
            for (int m = 0; m < 4; ++m)
#pragma unroll
                for (int bj = 0; bj < 2; ++bj) gv[m][bj] = *(const u32x4*)(GR + EPI_OFF(m, bj, 1024));
#pragma unroll
            for (int m = 0; m < 4; ++m)
#pragma unroll
                for (int bj = 0; bj < 2; ++bj) { f32x4 g0, g1; unpack8(gv[m][bj], g0, g1); st16(O + EPI_OFF(m, bj, 1024), pack8(acc[ai][bj][m][0] * g0, acc[ai][bj][m][1] * g1)); } }
    }
};
struct EpiGlu {
    static constexpr bool PERM = true;
    unsigned char* ws;
    DEV void operator()(const f32x4 (&acc)[2][2][4][2], const Unit& u, int wr, int wc, int fr, int fq) const {
        const bf16* Z = (const bf16*)(ws + R_U); bf16* O = (bf16*)(ws + R_S5IN);
#pragma unroll
        for (int ai = 0; ai < 2; ++ai) { u32x4 zv[4][2];
#pragma unroll
            for (int m = 0; m < 4; ++m)
#pragma unroll
                for (int bj = 0; bj < 2; ++bj) zv[m][bj] = *(const u32x4*)(Z + EPI_OFF(m, bj, 512));
#pragma unroll
            for (int m = 0; m < 4; ++m)
#pragma unroll
                for (int bj = 0; bj < 2; ++bj) { f32x4 z0, z1, v0 = acc[ai][bj][m][0], v1 = acc[ai][bj][m][1]; unpack8(zv[m][bj], z0, z1);
#pragma unroll
                    for (int q = 0; q < 4; ++q) { v0[q] = z0[q] * fsig(v0[q]); v1[q] = z1[q] * fsig(v1[q]); }
                    st16(O + EPI_OFF(m, bj, 512), pack8(v0, v1)); } }
    }
};
struct EpiS5b {
    static constexpr bool PERM = true;
    unsigned char* ws;
    DEV void operator()(const f32x4 (&acc)[2][2][4][2], const Unit& u, int wr, int wc, int fr, int fq) const {
        const bf16* GS = (const bf16*)(ws + R_GS); bf16* O = (bf16*)(ws + R_G);
#pragma unroll
        for (int ai = 0; ai < 2; ++ai) { u32x4 gv[4][2], pv[4][2];
#pragma unroll
            for (int m = 0; m < 4; ++m)
#pragma unroll
                for (int bj = 0; bj < 2; ++bj) { gv[m][bj] = *(const u32x4*)(GS + EPI_OFF(m, bj, 1024)); pv[m][bj] = *(const u32x4*)(O + EPI_OFF(m, bj, 1024)); }
#pragma unroll
            for (int m = 0; m < 4; ++m)
#pragma unroll
                for (int bj = 0; bj < 2; ++bj) { f32x4 g0, g1, p0, p1; unpack8(gv[m][bj], g0, g1); unpack8(pv[m][bj], p0, p1);
                    st16(O + EPI_OFF(m, bj, 1024), pack8(p0 + acc[ai][bj][m][0] * g0, p1 + acc[ai][bj][m][1] * g1)); } }
    }
};
struct EpiOut {
    static constexpr bool PERM = true;
    const bf16* hres; bf16* out;
    DEV void operator()(const f32x4 (&acc)[2][2][4][2], const Unit& u, int wr, int wc, int fr, int fq) const {
#pragma unroll
        for (int ai = 0; ai < 2; ++ai) { u32x4 hv[4][2];
#pragma unroll
            for (int m = 0; m < 4; ++m)
#pragma unroll
                for (int bj = 0; bj < 2; ++bj) hv[m][bj] = *(const u32x4*)(hres + EPI_OFF(m, bj, Dm));
#pragma unroll
            for (int m = 0; m < 4; ++m)
#pragma unroll
                for (int bj = 0; bj < 2; ++bj) { f32x4 h0, h1; unpack8(hv[m][bj], h0, h1); st16(out + EPI_OFF(m, bj, Dm), pack8(h0 * ALPHA + acc[ai][bj][m][0], h1 * ALPHA + acc[ai][bj][m][1])); } }
    }
};
}
namespace pg8 {
struct GroupedOrder {
    static constexpr bool GATHER = true;
    const PG8_LAS unsigned* tp; const unsigned* list; int NT, G, c, shift;
    __device__ bool next(int i, Unit& u) const {
        const unsigned total = (unsigned)__builtin_amdgcn_readfirstlane((int)tp[32]) * (unsigned)NT; const unsigned L = (unsigned)i * (unsigned)G + (unsigned)c;
        if (L >= total) return false;
        const unsigned mt = L / (unsigned)NT; int e = 0;
#pragma unroll
        for (int j = 1; j < 32; ++j) e += (mt >= tp[j]) ? 1 : 0;
        e = __builtin_amdgcn_readfirstlane(e);
        u.e = e; u.pm = (int)mt - __builtin_amdgcn_readfirstlane((int)tp[e]); u.pn = (int)(L % (unsigned)NT); u.pnb = e * NT + u.pn; u.cnt = __builtin_amdgcn_readfirstlane((int)tp[33 + e]); return true;
    }
    __device__ __forceinline__ const unsigned* list_ptr(const Unit& u, int r) const { int rr = u.pm * BM + r; rr = rr < u.cnt ? rr : u.cnt - 1; return list + (size_t)u.e * T + rr; }
    __device__ __forceinline__ unsigned row_of(unsigned e) const { return e >> shift; }
};
}
namespace epi {
struct EpiMoeGU {
    static constexpr bool PERM = true;
    unsigned char* ws; const unsigned* list;
    DEV void operator()(const f32x4 (&acc)[2][2][4][2], const Unit& u, int wr, int wc, int fr, int fq) const {
        bf16* ACT = (bf16*)(ws + R_ACT);
        unsigned pp[2][4];
#pragma unroll
        for (int ai = 0; ai < 2; ++ai)
#pragma unroll
            for (int m = 0; m < 4; ++m) { int r = u.pm * 256 + ai * 128 + wr * 64 + m * 16 + fr; r = r < u.cnt ? r : u.cnt - 1; pp[ai][m] = list[(size_t)u.e * T + r]; }
#pragma unroll
        for (int ai = 0; ai < 2; ++ai)
#pragma unroll
            for (int m = 0; m < 4; ++m) { const int r = u.pm * 256 + ai * 128 + wr * 64 + m * 16 + fr;
                if (r < u.cnt) { const unsigned p = pp[ai][m];
#pragma unroll
                    for (int bj = 0; bj < 2; ++bj) { const int f0 = u.pn * 128 + bj * 64 + wc * 16 + 4 * fq; const f32x4 v0 = acc[ai][bj][m][0], v1 = acc[ai][bj][m][1];
                        const float a0 = v0[0] * fsig(v0[0]) * v0[1], a1 = v0[2] * fsig(v0[2]) * v0[3], a2 = v1[0] * fsig(v1[0]) * v1[1], a3 = v1[2] * fsig(v1[2]) * v1[3];
                        u32x2 w; w.x = cvt_pk_bf16(a0, a1); w.y = cvt_pk_bf16(a2, a3); *(u32x2*)(ACT + (size_t)p * 256 + f0) = w; } } }
    }
};
struct EpiMoeDN {
    static constexpr bool PERM = true;
    unsigned char* ws; const unsigned* list;
    DEV void operator()(const f32x4 (&acc)[2][2][4][2], const Unit& u, int wr, int wc, int fr, int fq) const {
        bf16* Y = (bf16*)(ws + R_Y); const float* TC = (const float*)(ws + RT_C);
        unsigned pp[2][4]; float cw[2][4];
#pragma unroll
        for (int ai = 0; ai < 2; ++ai)
#pragma unroll
            for (int m = 0; m < 4; ++m) { int r = u.pm * 256 + ai * 128 + wr * 64 + m * 16 + fr; r = r < u.cnt ? r : u.cnt - 1; pp[ai][m] = list[(size_t)u.e * T + r]; }
#pragma unroll
        for (int ai = 0; ai < 2; ++ai)
#pragma unroll
            for (int m = 0; m < 4; ++m) cw[ai][m] = TC[pp[ai][m]];
#pragma unroll
        for (int ai = 0; ai < 2; ++ai)
#pragma unroll
            for (int m = 0; m < 4; ++m) { const int r = u.pm * 256 + ai * 128 + wr * 64 + m * 16 + fr;
                if (r < u.cnt) { const unsigned p = pp[ai][m]; const float c = cw[ai][m];
#pragma unroll
                    for (int bj = 0; bj < 2; ++bj) { const int d0 = u.pn * 256 + bj * 128 + wc * 32 + 8 * fq;
                        st16(Y + (size_t)p * Dm + d0, pack8(acc[ai][bj][m][0] * c, acc[ai][bj][m][1] * c)); } } }
    }
};
}
#define GAS __attribute__((address_space(1)))
#define LAS __attribute__((address_space(3)))
constexpr int NWAVES = 8;
constexpr int RING_OFF = 0, RING_BYTES = 131072;
constexpr int LDSCTL_OFF = RING_BYTES, MISC_OFF = LDSCTL_OFF + 320, PARK_OFF = RING_BYTES + 1024;
constexpr int LDS_BYTES = 147456;
constexpr int CW_TMO = 0, CW_CODE = 1, CW_BAR = 4096;

#define XB_TMO      128
#define XB_XCNT(j)  (256  + 64 * (j))
#define XB_XSUB(j)  (1280 + 64 * (j))
#define XB_XGEN(j)  (2304 + 64 * (j))
#define XB_TOP      3328
#define XB_TOPGEN   3392
#define XCD_BAR_WORDS 3456
#define XB_SPIN_CAP (1u << 18)
__device__ __forceinline__ unsigned xb_ld(unsigned* p)              { return __hip_atomic_load(p, __ATOMIC_RELAXED, __HIP_MEMORY_SCOPE_AGENT); }
__device__ __forceinline__ unsigned xb_add(unsigned* p, unsigned v) { return __hip_atomic_fetch_add(p, v, __ATOMIC_RELAXED, __HIP_MEMORY_SCOPE_AGENT); }
__device__ __forceinline__ unsigned xb_xcc_id() { return (unsigned)__builtin_amdgcn_s_getreg((3 << 11) | 20) & 0xFu; }
#define XB_SPIN(cond, bar) do { unsigned _sp = 0; while (cond) { __builtin_amdgcn_s_sleep(1); \
    if ((++_sp & 255u) == 0u) { if (xb_ld(&(bar)[XB_TMO])) break; if (_sp > XB_SPIN_CAP) { atomicAdd(&(bar)[XB_TMO], 1u); break; } } } } while (0)
struct XcdBarrier { unsigned* bar; unsigned x; volatile LAS unsigned* st; };
__device__ __forceinline__ XcdBarrier xcd_barrier_post(unsigned* bar, volatile LAS unsigned* st, bool t0) {
    XcdBarrier b; b.bar = bar; b.x = xb_xcc_id(); b.st = st;
    if (t0) st[3] = xb_add(&bar[XB_XCNT(b.x)], 1u);
    return b;
}
__device__ __forceinline__ void xcd_barrier_complete(unsigned* bar, unsigned x, unsigned& nloc, unsigned& nx) {
    const unsigned G = gridDim.x * gridDim.y * gridDim.z;
    unsigned sum, cnt, mine, sp = 0u;
    for (;;) {
        sum = 0u; cnt = 0u; mine = 0u;
#pragma unroll
        for (unsigned j = 0; j < 16; ++j) { const unsigned c = xb_ld(&bar[XB_XCNT(j)]); sum += c; cnt += (c > 0u) ? 1u : 0u; mine = (j == x) ? c : mine; }
        if (sum == G) break;
        __builtin_amdgcn_s_sleep(1);
        if ((++sp & 255u) == 0u) { if (xb_ld(&bar[XB_TMO])) break; if (sp > XB_SPIN_CAP) { atomicAdd(&bar[XB_TMO], 1u); break; } }
    }
    nloc = mine > 0u ? mine : 1u; nx = cnt > 0u ? cnt : 1u;
}
__device__ __forceinline__ void xcd_barrier(const XcdBarrier& b, bool t0, bool local) {
    asm volatile("s_waitcnt vmcnt(0)" ::: "memory");
    __syncthreads();
    if (t0) {
        unsigned* bar = b.bar;
        __builtin_amdgcn_s_waitcnt(0);
        unsigned nloc = b.st[0], nx = b.st[1];
        if (nloc == 0u) { xcd_barrier_complete(bar, b.x, nloc, nx); b.st[0] = nloc; b.st[1] = nx;
            const unsigned G = gridDim.x; unsigned even = (nx == 8u && (G & 7u) == 0u) ? 1u : 0u;
#pragma unroll
            for (unsigned j = 0; j < 8; ++j) even &= (xb_ld(&bar[XB_XCNT(j)]) == G / 8u) ? 1u : 0u;
            b.st[2] = even;
            if (even) { const unsigned rk = b.st[3]; b.st[4] = rk * 8u + b.x; b.st[5] = b.x * (G / 8u) + rk; } }
        const unsigned old = xb_add(&bar[XB_XSUB(b.x)], 1u);
        const unsigned gen = old / nloc;
        if (old + 1u == (gen + 1u) * nloc) {
            if (!local) {
            __builtin_amdgcn_fence(__ATOMIC_RELEASE, "agent");
            asm volatile("s_waitcnt vmcnt(0)" ::: "memory");
            const unsigned og = xb_add(&bar[XB_TOP], 1u);
            const unsigned tg = og / nx;
            if (og + 1u == (tg + 1u) * nx) xb_add(&bar[XB_TOPGEN], 1u);
            else XB_SPIN(xb_ld(&bar[XB_TOPGEN]) == tg, bar);
            }
            __builtin_amdgcn_fence(__ATOMIC_ACQUIRE, "agent");
            xb_add(&bar[XB_XGEN(b.x)], 1u);
            asm volatile("s_waitcnt vmcnt(0)" ::: "memory");
        } else {
            XB_SPIN(xb_ld(&bar[XB_XGEN(b.x)]) == gen, bar);
            __builtin_amdgcn_fence(__ATOMIC_ACQUIRE, "agent");
            asm volatile("s_waitcnt vmcnt(0)" ::: "memory");
        }
    }
    __syncthreads();
}

struct Args { const float* in[27]; float* out; unsigned char* ws; int ph_lo, ph_hi, bar_id, pad; };
constexpr int NPL = 10, NPH = 1 + DEPTH * NPL;
enum { K_PROJ = 0, K_RETA = 1, K_RETB = 2, K_BRANCH = 3, K_S5B = 4, K_OUT = 5, K_LNROUTE = 6, K_MOEGU = 7, K_MOEDN = 8, K_LN2 = 9 };
namespace ph {
#define LDSW() asm volatile("s_waitcnt lgkmcnt(0)" ::: "memory")
DEV int lane_id(int wbase) { return pg8::fresh_tid(wbase) & 63; }
DEV unsigned pk2(float lo, float hi) { return (unsigned)f2bf(lo) | ((unsigned)f2bf(hi) << 16); }
DEV void transpose_item(const float* __restrict__ W, int K, int N, bf16* __restrict__ WT, int rmul, int radd, LAS float* scr, int item, int lane) {
    const int nblk = N / 32, kb = item / nblk, nb = item % nblk, k0 = 64 * kb, n0 = 32 * nb;
#pragma unroll 8
    for (int i = 0; i < 32; ++i) { const int kk = 2 * i + (lane >> 5); scr[kk * 33 + (lane & 31)] = W[(size_t)(k0 + kk) * N + n0 + (lane & 31)]; }
    LDSW(); asm volatile("" ::: "memory");
    const int c = lane & 7;
#pragma unroll
    for (int j = 0; j < 4; ++j) { const int n = (lane >> 3) + 8 * j; const LAS float* s = scr + (8 * c) * 33 + n;
        uint4 o; o.x = pk2(s[0 * 33], s[1 * 33]); o.y = pk2(s[2 * 33], s[3 * 33]); o.z = pk2(s[4 * 33], s[5 * 33]); o.w = pk2(s[6 * 33], s[7 * 33]);
        *(uint4*)(WT + (size_t)((n0 + n) * rmul + radd) * K + k0 + 8 * c) = o; }
    LDSW(); asm volatile("" ::: "memory");
}
struct ConvItem { const float* W; bf16* WT; int K, N, rmul, radd, k0, n0; };
DEV void conv_issue(const ConvItem& c, LAS unsigned char* tile, int lane) {
    const float* src = c.W + (size_t)(c.k0 + (lane >> 3)) * c.N + c.n0;
#pragma unroll
    for (int j = 0; j < 8; ++j) __builtin_amdgcn_global_load_lds(src + (size_t)(8 * j) * c.N + (((lane & 7) ^ j) * 4), (LAS void*)(tile + j * 1024), 16, 0, 0);
}
DEV void conv_finish(const ConvItem& c, const LAS unsigned char* tile, int lane) {
    const int cc = lane & 7, nb = lane >> 3;
#pragma unroll
    for (int jj = 0; jj < 4; ++jj) { const int n = nb + 8 * jj; const LAS float* s = (const LAS float*)tile + cc * 256 + (((n >> 2) ^ cc) * 4) + (n & 3);
        uint4 o; o.x = pk2(s[0], s[32]); o.y = pk2(s[64], s[96]); o.z = pk2(s[128], s[160]); o.w = pk2(s[192], s[224]);
        *(uint4*)(c.WT + (size_t)((c.n0 + n) * c.rmul + c.radd) * c.K + c.k0 + 8 * cc) = o; }
}
template <class Dec> DEV void conv_run(const Dec& decode, int first, int stride, int total, LAS unsigned char* t0, int lane) {
    int it = first, par = 0; bool have = it < total; ConvItem cur{};
    if (have) { cur = decode(it); conv_issue(cur, t0, lane); }
    while (have) { const int nx = it + stride; const bool hn = nx < total; ConvItem nxt{};
        if (hn) { nxt = decode(nx); conv_issue(nxt, t0 + (par ^ 1) * 8192, lane); asm volatile("s_waitcnt vmcnt(8)" ::: "memory"); } else asm volatile("s_waitcnt vmcnt(0)" ::: "memory");
        conv_finish(cur, t0 + par * 8192, lane); cur = nxt; it = nx; have = hn; par ^= 1; }
}
DEV void ln_row(const float* pre, const bf16* preb, float scale, const bf16* y2, const float* __restrict__ g, const float* __restrict__ b, float* of, bf16* ob, int lane, float (&v)[16]) {
    float s = 0.f;
    if (pre) {
#pragma unroll
        for (int j = 0; j < 4; ++j) { const float4 x = *(const float4*)(pre + j * 256 + lane * 4); v[4 * j] = x.x * scale; v[4 * j + 1] = x.y * scale; v[4 * j + 2] = x.z * scale; v[4 * j + 3] = x.w * scale; }
    } else {
#pragma unroll
        for (int j = 0; j < 4; ++j) { const uint2 a = *(const uint2*)(preb + j * 256 + lane * 4);
            v[4 * j] = __uint_as_float(a.x << 16) * scale; v[4 * j + 1] = __uint_as_float(a.x & 0xffff0000u) * scale; v[4 * j + 2] = __uint_as_float(a.y << 16) * scale; v[4 * j + 3] = __uint_as_float(a.y & 0xffff0000u) * scale; }
    }
    if (y2) {
#pragma unroll
        for (int j = 0; j < 4; ++j) { const uint2 a = *(const uint2*)(y2 + j * 256 + lane * 4), c = *(const uint2*)(y2 + Dm + j * 256 + lane * 4);
            v[4 * j] += __uint_as_float(a.x << 16) + __uint_as_float(c.x << 16); v[4 * j + 1] += __uint_as_float(a.x & 0xffff0000u) + __uint_as_float(c.x & 0xffff0000u);
            v[4 * j + 2] += __uint_as_float(a.y << 16) + __uint_as_float(c.y << 16); v[4 * j + 3] += __uint_as_float(a.y & 0xffff0000u) + __uint_as_float(c.y & 0xffff0000u); }
    }
#pragma unroll
    for (int i = 0; i < 16; ++i) s += v[i];
    const float mean = wave_sum(s) * (1.f / Dm); float q = 0.f;
#pragma unroll
    for (int i = 0; i < 16; ++i) { v[i] -= mean; q += v[i] * v[i]; }
    const float rstd = rsqrtf(wave_sum(q) * (1.f / Dm) + LN_EPS);
#pragma unroll
    for (int j = 0; j < 4; ++j) { const float4 gg = *(const float4*)(g + j * 256 + lane * 4), bb = *(const float4*)(b + j * 256 + lane * 4);
        float4 o; o.x = v[4 * j] * rstd * gg.x + bb.x; o.y = v[4 * j + 1] * rstd * gg.y + bb.y; o.z = v[4 * j + 2] * rstd * gg.z + bb.z; o.w = v[4 * j + 3] * rstd * gg.w + bb.w;
        v[4 * j] = o.x; v[4 * j + 1] = o.y; v[4 * j + 2] = o.z; v[4 * j + 3] = o.w;
        if (of) *(float4*)(of + j * 256 + lane * 4) = o;
        uint2 w; w.x = pk2(o.x, o.y); w.y = pk2(o.z, o.w); *(uint2*)(ob + j * 256 + lane * 4) = w; }
}

struct ProIn { const float *x, *lng, *lnb, *w_in, *lam_re, *lam_im, *log_step, *b_re, *b_im, *c_re, *c_im, *w_glu, *w_bret, *w_bs5, *w_out, *w_rg, *w_re; float* out; };
DEV void prologue(const int wbase, LAS unsigned char* lds, unsigned char* ws, const ProIn P, int G, int vcu) {
    const int wave = wbase >> 6, lane = lane_id(wbase), tid = wbase + lane;
    LAS float* scr = (LAS float*)(lds + wave * 16384);
    const int gw = vcu * NWAVES + wave, NGW = G * NWAVES;
    constexpr int I_IN = (Dm / 64) * (INW / 32), I_GLU = (S5W / 64) * (S5W / 32), I_BRET = (RV / 64) * (Dm / 32), I_BS5 = (S5W / 64) * (Dm / 32), I_OUT = (Dm / 64) * (Dm / 32);
    constexpr int I_L = I_IN + I_GLU + I_BRET + I_BS5 + I_OUT;
    { auto decode = [&](int it) { const int l = it / I_L; int r = it % I_L;
          const float* W; bf16* WT; int K, N;
          if (r < I_IN) { W = P.w_in + (size_t)l * Dm * INW; K = Dm; N = INW; WT = (bf16*)(ws + W_IN) + (size_t)l * INW * Dm; }
          else if ((r -= I_IN) < I_GLU) { W = P.w_glu + (size_t)l * S5W * S5W; K = S5W; N = S5W; WT = (bf16*)(ws + W_GLU) + (size_t)l * S5W * S5W; }
          else if ((r -= I_GLU) < I_BRET) { W = P.w_bret + (size_t)l * RV * Dm; K = RV; N = Dm; WT = (bf16*)(ws + W_BRET) + (size_t)l * Dm * RV; }
          else if ((r -= I_BRET) < I_BS5) { W = P.w_bs5 + (size_t)l * S5W * Dm; K = S5W; N = Dm; WT = (bf16*)(ws + W_BS5) + (size_t)l * Dm * S5W; }
          else { r -= I_BS5; W = P.w_out + (size_t)l * Dm * Dm; K = Dm; N = Dm; WT = (bf16*)(ws + W_OUT) + (size_t)l * Dm * Dm; }
          const int nblk = N / 32; return ConvItem{W, WT, K, N, 1, 0, 64 * (r / nblk), 32 * (r % nblk)}; };
      conv_run(decode, gw, NGW, DEPTH * I_L, lds + wave * 16384, lane); }
    const int gt = vcu * (NWAVES * 64) + tid, NGT = G * NWAVES * 64;
    float* COS = (float*)(ws + TAB_COS); float* SIN = (float*)(ws + TAB_SIN); float* POWG = (float*)(ws + TAB_POWG);
    float* AB = (float*)(ws + TAB_AB); bf16* BBH = (bf16*)(ws + TAB_BBH); bf16* CTH = (bf16*)(ws + TAB_CTH); float* WRT = (float*)(ws + TAB_WRT);
    for (int gid = gt; gid < 2048 * 32; gid += NGT) { const int pos = gid >> 5, i = gid & 31; const float inv = exp2f(-(float)i * (13.287712379549449f / 32.0f)); const float ang = (float)pos * inv;
        COS[gid] = cosf(ang); SIN[gid] = sinf(ang); }
    for (int gid = gt; gid < 8 * 80; gid += NGT) { const int h = gid / 80, n = gid % 80; const float lg = log1pf(-exp2f(-5.0f - (float)h)); POWG[gid] = expf(lg * (float)n); }
    for (int gid = gt; gid < DEPTH * S5G * S5N; gid += NGT) {
        const int g = (gid / S5N) % S5G, l = gid / (S5G * S5N);
        float lr = P.lam_re[gid]; if (lr > -1e-4f) lr = -1e-4f; const float li = P.lam_im[gid];
        const float step = expf(P.log_step[l * S5G + g]);
        const float em1 = expm1f(lr * step), mag = em1 + 1.f, ang = li * step, cs = cosf(ang), sn = sinf(ang), sh = sinf(0.5f * ang);
        const float abr = mag * cs, abi = mag * sn;
        const float nre = em1 * cs - 2.f * sh * sh;
        const float den = lr * lr + li * li;
        const float zr = (nre * lr + abi * li) / den, zi = (abi * lr - nre * li) / den;
        AB[gid * 2] = abr; AB[gid * 2 + 1] = abi;
        const int n = gid % S5N, lg = gid / S5N;
        for (int c = 0; c < 16; ++c) { const float br = P.b_re[(size_t)gid * 16 + c], bi = P.b_im[(size_t)gid * 16 + c];
            BBH[((size_t)lg * 128 + n) * 16 + c] = f2bf(zr * br - zi * bi); BBH[((size_t)lg * 128 + 64 + n) * 16 + c] = f2bf(zr * bi + zi * br); }
    }
    for (int gid = gt; gid < DEPTH * S5G * 16 * 128; gid += NGT) { const int np = gid & 127, lgc = gid >> 7;
        CTH[gid] = f2bf(np < 64 ? P.c_re[(size_t)lgc * 64 + np] : -P.c_im[(size_t)lgc * 64 + np - 64]); }
    for (int gid = gt; gid < DEPTH * 36 * Dm; gid += NGT) { const int kk = gid % Dm, j = (gid / Dm) % 36, l = gid / (36 * Dm);
        WRT[gid] = j < 4 ? P.w_rg[((size_t)l * Dm + kk) * MG + j] : P.w_re[((size_t)l * Dm + kk) * NE + (j - 4)]; }
    { bf16* WRH = (bf16*)(ws + TAB_WRH); bf16* WRL = (bf16*)(ws + TAB_WRL);
      for (int gid = gt; gid < DEPTH * 48 * Dm; gid += NGT) { const int kk = gid % Dm, j = (gid / Dm) % 48, l = gid / (48 * Dm);
          const float w = j < 4 ? P.w_rg[((size_t)l * Dm + kk) * MG + j] : (j < 36 ? P.w_re[((size_t)l * Dm + kk) * NE + (j - 4)] : 0.f);
          const bf16 hi = f2bf(w); WRH[gid] = hi; WRL[gid] = f2bf(w - bf2f(hi)); } }
    float v[16];
    for (int m = gw; m < T; m += NGW) ln_row(P.x + (size_t)m * Dm, nullptr, 1.f, nullptr, P.lng, P.lnb, nullptr, (bf16*)(ws + WS_HBF) + (size_t)m * Dm, lane, v);
}

struct RouteIn { const float *lng, *lnb, *brg, *bre, *wg, *wu, *wd; };
DEV void phase_lnroute(const int wbase, LAS unsigned char* lds, unsigned char* ws, const RouteIn P, int layer, int G, int vcu) {
    const int wave = wbase >> 6, lane = lane_id(wbase);
    const int gw = vcu * NWAVES + wave, NGW = G * NWAVES;
    const bf16* preb = (const bf16*)(ws + WS_HB); bf16* ob = (bf16*)(ws + WS_HBF);
    const float* WRT = (const float*)(ws + TAB_WRT) + (size_t)layer * 36 * Dm;
    const float* brg = P.brg; const float* bre = P.bre;
    int* TE = (int*)(ws + RT_E); float* TC = (float*)(ws + RT_C); int* LIST = (int*)(ws + RT_LIST); unsigned* CNT = (unsigned*)(ws + WS_CNT) + layer * NE;
    typedef short bf16x8 __attribute__((ext_vector_type(8))); typedef float f32x4 __attribute__((ext_vector_type(4)));
    constexpr int AS = 2064, A_LO = 16 * AS, PL_OFF = 2 * 16 * AS, LG_OFF = PL_OFF + 8 * 16 * 48 * 4, RT_OFF = LG_OFF + 16 * 48 * 4, CAP = 128;
    LAS unsigned* lcnt = (LAS unsigned*)(lds + RT_OFF); LAS unsigned* gbase = lcnt + 32; LAS int* le1 = (LAS int*)(gbase + 32); LAS int* le2 = le1 + CAP;
    LAS unsigned* lr1 = (LAS unsigned*)(le2 + CAP); LAS unsigned* lr2 = lr1 + CAP; LAS float* lc1 = (LAS float*)(lr2 + CAP); LAS float* lc2 = lc1 + CAP; LAS int* lrow = (LAS int*)(lc2 + CAP);
    static_assert(RT_OFF + 64 * 4 + 7 * CAP * 4 <= RING_BYTES, "lnroute LDS");
    const int tid = wbase + lane, fr = lane & 15, fq = lane >> 4;
    bf16x8 bh[3][4], bl[3][4];
    { const bf16* WRH = (const bf16*)(ws + TAB_WRH) + (size_t)layer * 48 * Dm; const bf16* WRL = (const bf16*)(ws + TAB_WRL) + (size_t)layer * 48 * Dm;
#pragma unroll
      for (int nt = 0; nt < 3; ++nt)
#pragma unroll
          for (int ks = 0; ks < 4; ++ks) { const size_t o = (size_t)(16 * nt + fr) * Dm + wave * 128 + ks * 32 + 8 * fq; bh[nt][ks] = *(const bf16x8*)(WRH + o); bl[nt][ks] = *(const bf16x8*)(WRL + o); } }
    if (tid < 32) lcnt[tid] = 0u;
    int nent = 0;
    __syncthreads();
    const bool contig = ((T / 16) % G) == 0; const int nbw = contig ? (T / 16) / G : ((T / 16) + G - 1) / G;
    for (int ib = 0; ib < nbw; ++ib) { const int blk = contig ? vcu * nbw + ib : vcu + ib * G; if (blk >= T / 16) break;
#pragma unroll
        for (int jr = 0; jr < 2; ++jr) { const int lr = 2 * wave + jr, row = blk * 16 + lr;
            float v[16];
            ln_row(nullptr, preb + (size_t)row * Dm, 1.f, nullptr, P.lng, P.lnb, nullptr, ob + (size_t)row * Dm, lane, v);
#pragma unroll
            for (int j = 0; j < 4; ++j) { unsigned hw[2], lw[2];
#pragma unroll
                for (int e2 = 0; e2 < 2; ++e2) { const float x0 = v[4 * j + 2 * e2], x1 = v[4 * j + 2 * e2 + 1]; const bf16 h0 = f2bf(x0), h1 = f2bf(x1);
                    hw[e2] = (unsigned)h0 | ((unsigned)h1 << 16); lw[e2] = (unsigned)f2bf(x0 - bf2f(h0)) | ((unsigned)f2bf(x1 - bf2f(h1)) << 16); }
                *(LAS pg8::u32x2*)(lds + lr * AS + (j * 256 + lane * 4) * 2) = (pg8::u32x2){hw[0], hw[1]};
                *(LAS pg8::u32x2*)(lds + A_LO + lr * AS + (j * 256 + lane * 4) * 2) = (pg8::u32x2){lw[0], lw[1]}; } }
        __syncthreads();
        f32x4 acc[3];
#pragma unroll
        for (int nt = 0; nt < 3; ++nt) acc[nt] = (f32x4){0.f, 0.f, 0.f, 0.f};
#pragma unroll
        for (int ks = 0; ks < 4; ++ks) { const int ao = fr * AS + (wave * 128 + ks * 32 + 8 * fq) * 2;
            const bf16x8 ah = *(const LAS bf16x8*)(lds + ao), al = *(const LAS bf16x8*)(lds + A_LO + ao);
#pragma unroll
            for (int nt = 0; nt < 3; ++nt) { acc[nt] = __builtin_amdgcn_mfma_f32_16x16x32_bf16(ah, bh[nt][ks], acc[nt], 0, 0, 0);
                acc[nt] = __builtin_amdgcn_mfma_f32_16x16x32_bf16(al, bh[nt][ks], acc[nt], 0, 0, 0); acc[nt] = __builtin_amdgcn_mfma_f32_16x16x32_bf16(ah, bl[nt][ks], acc[nt], 0, 0, 0); } }
        { LAS float* PL = (LAS float*)(lds + PL_OFF) + wave * 16 * 48;
#pragma unroll
          for (int nt = 0; nt < 3; ++nt)
#pragma unroll
              for (int rg = 0; rg < 4; ++rg) PL[(4 * fq + rg) * 48 + 16 * nt + fr] = acc[nt][rg]; }
        __syncthreads();
        for (int idx = tid; idx < 16 * 48; idx += NWAVES * 64) { const LAS float* PL = (const LAS float*)(lds + PL_OFF) + idx; float s = 0.f;
#pragma unroll
            for (int w = 0; w < 8; ++w) s += PL[w * 16 * 48];
            ((LAS float*)(lds + LG_OFF))[idx] = s; }
        __syncthreads();
        if (tid < 16) { const LAS float* LG = (const LAS float*)(lds + LG_OFF) + tid * 48; const int row = blk * 16 + tid;
            float lg[4];
#pragma unroll
            for (int kk = 0; kk < 4; ++kk) lg[kk] = LG[kk] + brg[kk];
            int gi = 0; float gm = lg[0];
#pragma unroll
            for (int kk = 1; kk < 4; ++kk) if (lg[kk] > gm) { gm = lg[kk]; gi = kk; }
            float den = 0.f;
#pragma unroll
            for (int kk = 0; kk < 4; ++kk) den += __expf(lg[kk] - gm);
            const float gtop = 1.f / den;
            int i1 = 0, i2 = 0; float m1 = -INFINITY, m2 = -INFINITY;
            for (int kk = 0; kk < 8; ++kk) { const float x = LG[4 + gi * 8 + kk] + bre[gi * 8 + kk];
                if (x > m1) { m2 = m1; i2 = i1; m1 = x; i1 = kk; } else if (x > m2) { m2 = x; i2 = kk; } }
            const float p2 = __expf(m2 - m1);
            const float w1 = 1.f / (1.f + p2), w2 = p2 / (1.f + p2);
            const int e1 = gi * 8 + i1, e2 = gi * 8 + i2, li = nent + tid;
            le1[li] = e1; le2[li] = e2; lc1[li] = gtop * w1; lc2[li] = gtop * w2; lrow[li] = row;
            lr1[li] = __hip_atomic_fetch_add(lcnt + e1, 1u, __ATOMIC_RELAXED, __HIP_MEMORY_SCOPE_WORKGROUP); lr2[li] = __hip_atomic_fetch_add(lcnt + e2, 1u, __ATOMIC_RELAXED, __HIP_MEMORY_SCOPE_WORKGROUP); }
        nent += 16;
        const bool last = (ib + 1 >= nbw) || (!contig && blk + G >= T / 16);
        if (nent == CAP || last) {
            __syncthreads();
            if (tid < 32) { const unsigned c = lcnt[tid]; gbase[tid] = c ? atomicAdd(&CNT[tid], c) : 0u; }
            __syncthreads();
            if (tid < nent) { const int row = lrow[tid], e1 = le1[tid], e2 = le2[tid];
                TE[row * 2] = e1; TE[row * 2 + 1] = e2; TC[row * 2] = lc1[tid]; TC[row * 2 + 1] = lc2[tid];
                LIST[(size_t)e1 * T + gbase[e1] + lr1[tid]] = row * 2; LIST[(size_t)e2 * T + gbase[e2] + lr2[tid]] = row * 2 + 1; }
            __syncthreads();
            if (tid < 32) lcnt[tid] = 0u;
            nent = 0;
        }
        __syncthreads();
    }
    constexpr int I_G = (Dm / 64) * (FF / 32);
    { LAS unsigned char* t0 = lds + wave * 16384;
      auto decode = [&](int it) { const int e = it / (2 * I_G), r = it % (2 * I_G), m = r / I_G, q = r % I_G;
          return ConvItem{(m ? P.wu : P.wg) + (size_t)e * Dm * FF, (bf16*)(ws + R_WGU) + (size_t)e * 512 * Dm, Dm, FF, 2, m, 64 * (q / (FF / 32)), 32 * (q % (FF / 32))}; };
      __syncthreads();
      conv_run(decode, gw, NGW, NE * 2 * I_G, t0, lane); }
}
DEV void phase_ln2(const int wbase, unsigned char* ws, const float* lng, const float* lnb, float* out, int G, int vcu) {
    const int wave = wbase >> 6, lane = lane_id(wbase);
    const int gw = vcu * NWAVES + wave, NGW = G * NWAVES;
    float v[16];
    for (int row = gw; row < T; row += NGW)
        ln_row(nullptr, (const bf16*)(ws + WS_HBF) + (size_t)row * Dm, ALPHA, (const bf16*)(ws + R_Y) + (size_t)(2 * row) * Dm, lng, lnb, out ? out + (size_t)row * Dm : nullptr, (bf16*)(ws + WS_HBF) + (size_t)row * Dm, lane, v);
}
}

namespace ret {
typedef short bf16x8 __attribute__((ext_vector_type(8)));
typedef short s16x4 __attribute__((ext_vector_type(4)));
typedef float f32x16 __attribute__((ext_vector_type(16)));
typedef float f32x4 __attribute__((ext_vector_type(4)));
typedef float f32x2_t __attribute__((ext_vector_type(2))); typedef __bf16 bf16x2_t __attribute__((ext_vector_type(2)));
DEV unsigned cvtpk(float lo, float hi) { f32x2_t v = {lo, hi}; bf16x2_t b = __builtin_convertvector(v, bf16x2_t); return __builtin_bit_cast(unsigned, b); }
#define RMFMA(a, b, c) __builtin_amdgcn_mfma_f32_32x32x16_bf16((a), (b), (c), 0, 0, 0)
constexpr int LS = 72;
constexpr int L_KR = 0, L_QR = 9216, L_KDT = 18432, L_VT = 27648, L_ST = 46080, L_O = 64512, OS = 132, L_END = L_O + 64 * OS * 4;
static_assert(L_END <= RING_BYTES, "retention LDS");
constexpr int SEGC = 8, NSEG = NCH / SEGC;
DEV int crow(int reg, int h) { return (reg & 3) + 8 * (reg >> 2) + 4 * h; }
DEV float bflo(unsigned w) { return __uint_as_float(w << 16); }
DEV float bfhi(unsigned w) { return __uint_as_float(w & 0xffff0000u); }

struct Raw { uint2 k1, k2, q1, q2; float4 cs, sn; uint4 v0, v1; };
template <bool WITH_Q> DEV void load_raw(Raw& R, const unsigned char* ws, int row0, int pos0, int h, int tid) {
    const int j = tid >> 3, c0 = (tid & 7) * 4;
    const bf16* K = (const bf16*)(ws + R_K) + (size_t)(row0 + j) * 512 + h * 64 + c0;
    R.k1 = *(const uint2*)K; R.k2 = *(const uint2*)(K + 32);
    if (WITH_Q) { const bf16* Q = (const bf16*)(ws + R_Q) + (size_t)(row0 + j) * 512 + h * 64 + c0; R.q1 = *(const uint2*)Q; R.q2 = *(const uint2*)(Q + 32); }
    R.cs = *(const float4*)((const float*)(ws + TAB_COS) + (pos0 + j) * 32 + c0); R.sn = *(const float4*)((const float*)(ws + TAB_SIN) + (pos0 + j) * 32 + c0);
    const bf16* V = (const bf16*)(ws + R_V) + (size_t)(row0 + j) * 1024 + h * 128 + (tid & 7) * 16;
    R.v0 = *(const uint4*)V; R.v1 = *(const uint4*)(V + 8);
}
DEV void rot4(const uint2 x1, const uint2 x2, const float4 cs, const float4 sn, float (&r1)[4], float (&r2)[4]) {
    const float a[4] = {bflo(x1.x), bfhi(x1.x), bflo(x1.y), bfhi(x1.y)}, b[4] = {bflo(x2.x), bfhi(x2.x), bflo(x2.y), bfhi(x2.y)};
    const float c[4] = {cs.x, cs.y, cs.z, cs.w}, s[4] = {sn.x, sn.y, sn.z, sn.w};
#pragma unroll
    for (int e = 0; e < 4; ++e) { r1[e] = a[e] * c[e] - b[e] * s[e]; r2[e] = a[e] * s[e] + b[e] * c[e]; }
}
template <bool WITH_Q> DEV void stage(LAS unsigned char* lds, const Raw& R, int tid, float kd) {
    const int j = tid >> 3, c0 = (tid & 7) * 4;
    float r1[4], r2[4];
    rot4(R.k1, R.k2, R.cs, R.sn, r1, r2);
    if (WITH_Q) { LAS bf16* kr = (LAS bf16*)(lds + L_KR) + j * LS + c0;
        *(LAS pg8::u32x2*)kr = (pg8::u32x2){cvtpk(r1[0], r1[1]), cvtpk(r1[2], r1[3])}; *(LAS pg8::u32x2*)(kr + 32) = (pg8::u32x2){cvtpk(r2[0], r2[1]), cvtpk(r2[2], r2[3])}; }
    LAS bf16* kdt = (LAS bf16*)(lds + L_KDT) + c0 * LS + j;
#pragma unroll
    for (int e = 0; e < 4; ++e) { kdt[e * LS] = f2bf(r1[e] * kd); kdt[(32 + e) * LS] = f2bf(r2[e] * kd); }
    if (WITH_Q) { rot4(R.q1, R.q2, R.cs, R.sn, r1, r2); LAS bf16* qr = (LAS bf16*)(lds + L_QR) + j * LS + c0;
        *(LAS pg8::u32x2*)qr = (pg8::u32x2){cvtpk(r1[0], r1[1]), cvtpk(r1[2], r1[3])}; *(LAS pg8::u32x2*)(qr + 32) = (pg8::u32x2){cvtpk(r2[0], r2[1]), cvtpk(r2[2], r2[3])}; }
    LAS bf16* vt = (LAS bf16*)(lds + L_VT) + ((tid & 7) * 16) * LS + j;
    const unsigned vw[8] = {R.v0.x, R.v0.y, R.v0.z, R.v0.w, R.v1.x, R.v1.y, R.v1.z, R.v1.w};
#pragma unroll
    for (int e = 0; e < 8; ++e) { vt[(2 * e) * LS] = (bf16)(vw[e] & 0xffffu); vt[(2 * e + 1) * LS] = (bf16)(vw[e] >> 16); }
}
DEV bf16x8 ld8(const LAS bf16* p) { return *(const LAS bf16x8*)p; }
DEV void state_update(f32x16& ST, const LAS unsigned char* lds, int wi, int wd, int r, int hh, float cd) {
#pragma unroll
    for (int e = 0; e < 16; ++e) ST[e] *= cd;
    const LAS bf16* a = (const LAS bf16*)(lds + L_KDT) + (32 * wi + r) * LS + 8 * hh; const LAS bf16* b = (const LAS bf16*)(lds + L_VT) + (32 * wd + r) * LS + 8 * hh;
#pragma unroll
    for (int s = 0; s < 4; ++s) ST = RMFMA(ld8(a + 16 * s), ld8(b + 16 * s), ST);
}

DEV void phase_a(const int wbase, LAS unsigned char* lds, unsigned char* ws, int G, int vcu) {
    const int wave = wbase >> 6, tid = pg8::fresh_tid(wbase), lane = tid & 63, r = lane & 31, hh = lane >> 5, wi = wave >> 2, wd = wave & 3;
    for (int item = vcu; item < BATCH * RH * NSEG; item += G) {
        const int seg = item % NSEG, h = (item / NSEG) % RH, b = item / (NSEG * RH);
        const float lg2g = log1pf(-__builtin_amdgcn_exp2f(-5.0f - (float)h)) * 1.4426950408889634f, cd = __builtin_amdgcn_exp2f(64.f * lg2g);
        f32x16 ST;
#pragma unroll
        for (int e = 0; e < 16; ++e) ST[e] = 0.f;
        const float kdj = __builtin_amdgcn_exp2f((float)(63 - (tid >> 3)) * lg2g);
        Raw R; load_raw<false>(R, ws, b * SEQ + seg * SEGC * CHUNK, seg * SEGC * CHUNK, h, tid);
#pragma nounroll
        for (int n = 0; n < SEGC; ++n) {
            __syncthreads();
            stage<false>(lds, R, tid, kdj);
            __syncthreads();
            if (n + 1 < SEGC) load_raw<false>(R, ws, b * SEQ + (seg * SEGC + n + 1) * CHUNK, (seg * SEGC + n + 1) * CHUNK, h, tid);
            state_update(ST, lds, wi, wd, r, hh, cd);
        }
        float* TOT = (float*)(ws + WS_HB) + (size_t)item * 8192 + wave * 1024 + lane;
#pragma unroll
        for (int e = 0; e < 16; ++e) TOT[e * 64] = ST[e];
    }
    __syncthreads();
}
DEV void phase_b(const int wbase, LAS unsigned char* lds, unsigned char* ws, int G, int vcu) {
    const int wave = wbase >> 6, tid = pg8::fresh_tid(wbase), lane = tid & 63, r = lane & 31, hh = lane >> 5, wi = wave >> 2, wd = wave & 3;
    for (int item = vcu; item < BATCH * RH * NSEG; item += G) {
        const int seg = item % NSEG, h = (item / NSEG) % RH, b = item / (NSEG * RH);
        const float lg2g = log1pf(-__builtin_amdgcn_exp2f(-5.0f - (float)h)) * 1.4426950408889634f, cd = __builtin_amdgcn_exp2f(64.f * lg2g), cd8 = __builtin_amdgcn_exp2f(64.f * SEGC * lg2g);
        f32x16 ST;
#pragma unroll
        for (int e = 0; e < 16; ++e) ST[e] = 0.f;
#pragma nounroll
        for (int s = 0; s < seg; ++s) { const float* TOT = (const float*)(ws + WS_HB) + (size_t)(item - seg + s) * 8192 + wave * 1024 + lane;
#pragma unroll
            for (int e = 0; e < 16; ++e) ST[e] = cd8 * ST[e] + TOT[e * 64]; }
        const float kdj = __builtin_amdgcn_exp2f((float)(63 - (tid >> 3)) * lg2g);
        Raw R; load_raw<true>(R, ws, b * SEQ + seg * SEGC * CHUNK, seg * SEGC * CHUNK, h, tid);
        float mk0[16], mk1[16], qdec[16];
        { const int lq = pg8::fresh_tid(wbase) & 63, iq = 32 * wi + (lq & 31), hq = lq >> 5;
#pragma unroll
          for (int e = 0; e < 16; ++e) { const int j0 = crow(e, hq), d0 = iq > j0 ? iq - j0 : j0 - iq, d1 = iq > j0 + 32 ? iq - j0 - 32 : j0 + 32 - iq;
              mk0[e] = __builtin_amdgcn_exp2f((float)d0 * lg2g); mk1[e] = __builtin_amdgcn_exp2f((float)d1 * lg2g); qdec[e] = __builtin_amdgcn_exp2f((float)(32 * wi + j0 + 1) * lg2g); } }
#pragma nounroll
        for (int n = 0; n < SEGC; ++n) {
            const int row0 = b * SEQ + (seg * SEGC + n) * CHUNK;
            stage<true>(lds, R, tid, kdj);
            { LAS bf16* st = (LAS bf16*)(lds + L_ST) + (32 * wd + r) * LS + 32 * wi + 4 * hh;
#pragma unroll
              for (int g4 = 0; g4 < 4; ++g4) *(LAS pg8::u32x2*)(st + 8 * g4) = (pg8::u32x2){cvtpk(ST[4 * g4], ST[4 * g4 + 1]), cvtpk(ST[4 * g4 + 2], ST[4 * g4 + 3])}; }
            __syncthreads();
            if (n + 1 < SEGC) load_raw<true>(R, ws, row0 + CHUNK, (seg * SEGC + n + 1) * CHUNK, h, tid);
            const bf16* Gp = (const bf16*)(ws + R_G) + (size_t)(row0 + (tid >> 3)) * 1024 + h * 128 + (tid & 7) * 16;
            const uint4 g0 = *(const uint4*)Gp, g1 = *(const uint4*)(Gp + 8);
            f32x16 X0, X1;
#pragma unroll
            for (int e = 0; e < 16; ++e) { X0[e] = 0.f; X1[e] = 0.f; }
            const LAS bf16* kr = (const LAS bf16*)(lds + L_KR) + r * LS + 8 * hh; const LAS bf16* qr = (const LAS bf16*)(lds + L_QR) + (32 * wi + r) * LS + 8 * hh;
#pragma unroll
            for (int s = 0; s < 4; ++s) { const bf16x8 qb = ld8(qr + 16 * s); X0 = RMFMA(ld8(kr + 16 * s), qb, X0); X1 = RMFMA(ld8(kr + 32 * LS + 16 * s), qb, X1); }
#pragma unroll
            for (int e = 0; e < 16; ++e) { X0[e] *= mk0[e]; X1[e] *= mk1[e]; }
            f32x16 O;
#pragma unroll
            for (int e = 0; e < 16; ++e) O[e] = 0.f;
            const LAS bf16* stb = (const LAS bf16*)(lds + L_ST) + (32 * wd + r) * LS + 8 * hh;
#pragma unroll
            for (int s = 0; s < 4; ++s) O = RMFMA(ld8(qr + 16 * s), ld8(stb + 16 * s), O);
#pragma unroll
            for (int e = 0; e < 16; ++e) O[e] *= qdec[e];
            const LAS bf16* vt = (const LAS bf16*)(lds + L_VT) + (32 * wd + r) * LS + 4 * hh;
#pragma unroll
            for (int s = 0; s < 2; ++s) {
                bf16x8 pa, pb;
                { const unsigned w0 = cvtpk(X0[8 * s], X0[8 * s + 1]), w1 = cvtpk(X0[8 * s + 2], X0[8 * s + 3]), w2 = cvtpk(X0[8 * s + 4], X0[8 * s + 5]), w3 = cvtpk(X0[8 * s + 6], X0[8 * s + 7]);
                  const pg8::u32x4 p = {w0, w1, w2, w3}; pa = __builtin_bit_cast(bf16x8, p); }
                { const unsigned w0 = cvtpk(X1[8 * s], X1[8 * s + 1]), w1 = cvtpk(X1[8 * s + 2], X1[8 * s + 3]), w2 = cvtpk(X1[8 * s + 4], X1[8 * s + 5]), w3 = cvtpk(X1[8 * s + 6], X1[8 * s + 7]);
                  const pg8::u32x4 p = {w0, w1, w2, w3}; pb = __builtin_bit_cast(bf16x8, p); }
                const s16x4 a0 = *(const LAS s16x4*)(vt + 16 * s), a1 = *(const LAS s16x4*)(vt + 16 * s + 8), b0 = *(const LAS s16x4*)(vt + 32 + 16 * s), b1 = *(const LAS s16x4*)(vt + 32 + 16 * s + 8);
                O = RMFMA(pa, __builtin_shufflevector(a0, a1, 0, 1, 2, 3, 4, 5, 6, 7), O);
                O = RMFMA(pb, __builtin_shufflevector(b0, b1, 0, 1, 2, 3, 4, 5, 6, 7), O);
            }
            state_update(ST, lds, wi, wd, r, hh, cd);
            { LAS float* ob = (LAS float*)(lds + L_O) + (32 * wi + 4 * hh) * OS + 32 * wd + r;
#pragma unroll
              for (int e = 0; e < 16; ++e) ob[((e & 3) + 8 * (e >> 2)) * OS] = O[e]; }
            __syncthreads();
            { const int i = tid >> 3, c0 = (tid & 7) * 16; const LAS float* orow = (const LAS float*)(lds + L_O) + i * OS + c0;
              float o[16];
#pragma unroll
              for (int q4 = 0; q4 < 4; ++q4) { const f32x4 t4 = *(const LAS f32x4*)(orow + 4 * q4); o[4 * q4] = t4[0]; o[4 * q4 + 1] = t4[1]; o[4 * q4 + 2] = t4[2]; o[4 * q4 + 3] = t4[3]; }
              float sm = 0.f;
#pragma unroll
              for (int c = 0; c < 16; ++c) sm += o[c];
              sm += xshfl<1>(sm); sm += xshfl<2>(sm); sm += xshfl<4>(sm);
              const float mean = sm * (1.f / 128.f); float qq = 0.f;
#pragma unroll
              for (int c = 0; c < 16; ++c) { o[c] -= mean; qq += o[c] * o[c]; }
              qq += xshfl<1>(qq); qq += xshfl<2>(qq); qq += xshfl<4>(qq);
              const float rstd = rsqrtf(qq * (1.f / 128.f) + HN_EPS);
              const unsigned gw[8] = {g0.x, g0.y, g0.z, g0.w, g1.x, g1.y, g1.z, g1.w}; unsigned ow[8];
#pragma unroll
              for (int e = 0; e < 8; ++e) ow[e] = cvtpk(bflo(gw[e]) * o[2 * e] * rstd, bfhi(gw[e]) * o[2 * e + 1] * rstd);
              bf16* Ap = (bf16*)(ws + R_V) + (size_t)(row0 + i) * 1024 + h * 128 + c0;
              *(uint4*)Ap = make_uint4(ow[0], ow[1], ow[2], ow[3]); *(uint4*)(Ap + 8) = make_uint4(ow[4], ow[5], ow[6], ow[7]); }
        }
    }
    __syncthreads();
}
}

namespace s5 {
using ret::bf16x8; using ret::s16x4; using ret::f32x16; using ret::cvtpk; using ret::crow;
typedef short v4i16_t __attribute__((ext_vector_type(4)));
DEV s16x4 trr(const LAS unsigned char* p) { return __builtin_bit_cast(s16x4, __builtin_amdgcn_ds_read_tr16_b64_v4i16((LAS v4i16_t*)p)); }
struct Cx { float x, y; };
DEV Cx cmul(Cx a, Cx b) { return {a.x * b.x - a.y * b.y, a.x * b.y + a.y * b.x}; }
DEV Cx cfma(Cx a, Cx b, Cx c) { return {a.x * b.x - a.y * b.y + c.x, a.x * b.y + a.y * b.x + c.y}; }
DEV float shx32(float v) { return xshfl<32>(v); }

constexpr int SC = 4, NSG = NCH / SC;
template <bool OUT> DEV void pass(const int wbase, LAS unsigned char* lds, unsigned char* ws, const float* __restrict__ dsk, int layer, int G, int vcu) {
    const int wave = wbase >> 6;
    LAS unsigned char* img = lds + wave * 8192;
    bf16* U = (bf16*)(ws + R_U);
    for (int wi = vcu; wi < BATCH * NSG * (S5G / 8); wi += G) {
        const int lane = pg8::fresh_tid(wbase) & 63, r = lane & 31, hh = lane >> 5;
        const int oct = wi % (S5G / 8), sg = (wi / (S5G / 8)) % NSG, b = wi / ((S5G / 8) * NSG), g = oct * 8 + wave, lg = layer * S5G + g;
        const bf16* BBH = (const bf16*)(ws + TAB_BBH) + (size_t)lg * 128 * 16;
        bf16x8 bbf[4];
#pragma unroll
        for (int nt = 0; nt < 4; ++nt) bbf[nt] = *(const bf16x8*)(BBH + (32 * nt + r) * 16 + 8 * hh);
        Cx a1q[2], c[2];
#pragma unroll
        for (int q = 0; q < 2; ++q) {
            const float2 av = *(const float2*)((const float*)(ws + TAB_AB) + ((size_t)lg * S5N + 32 * q + r) * 2);
            a1q[q] = Cx{av.x, av.y}; c[q] = Cx{0.f, 0.f};
            if (OUT) { Cx ap = a1q[q];
#pragma unroll
                for (int sq = 0; sq < 8; ++sq) ap = cmul(ap, ap);
                const float2* E = (const float2*)(ws + WS_S5E) + ((size_t)(b * NSG) * S5G + g) * S5N + 32 * q + r;
                float2 ev[NSG - 1];
#pragma unroll
                for (int s = 0; s < NSG - 1; ++s) ev[s] = E[(size_t)s * S5G * S5N];
#pragma unroll
                for (int s = 0; s < NSG - 1; ++s) if (s < sg) c[q] = cfma(ap, c[q], Cx{ev[s].x, ev[s].y}); }
        }
        bf16x8 bd; LAS bf16x8* ctl = (LAS bf16x8*)(lds + 65536 + wave * 8192) + lane;
        if (OUT) { const bf16* CTH = (const bf16*)(ws + TAB_CTH) + ((size_t)lg * 16 + (r & 15)) * 128 + 8 * hh;
#pragma unroll
            for (int nt = 0; nt < 4; ++nt)
#pragma unroll
                for (int s = 0; s < 2; ++s) ctl[(nt * 2 + s) * 64] = *(const bf16x8*)(CTH + 32 * nt + 16 * s);
            const float dval = dsk[layer * 512 + g * 16 + (r & 15)];
#pragma unroll
            for (int e = 0; e < 8; ++e) bd[e] = (short)(((r & 15) == 8 * hh + e) ? f2bf(dval) : (bf16)0); }
        const int i16 = lane & 15, q4 = i16 >> 2, p4 = i16 & 3, blk = (lane >> 4) & 1;
        const int rowS = b * SEQ + sg * SC * 64;
        bf16x8 un[2];
#pragma unroll
        for (int th = 0; th < 2; ++th) un[th] = *(const bf16x8*)(U + (size_t)(rowS + 32 * th + r) * 512 + g * 16 + 8 * hh);
#pragma nounroll
        for (int jc = 0; jc < SC; ++jc) {
            const int row0 = rowS + jc * 64;
            bf16x8 ua[2]; ua[0] = un[0]; ua[1] = un[1];
            if (jc + 1 < SC) {
#pragma unroll
                for (int th = 0; th < 2; ++th) un[th] = *(const bf16x8*)(U + (size_t)(row0 + 64 + 32 * th + r) * 512 + g * 16 + 8 * hh); }
#pragma unroll
            for (int th = 0; th < 2; ++th) {
                f32x16 BU[4];
#pragma unroll
                for (int nt = 0; nt < 4; ++nt) { f32x16 z;
#pragma unroll
                    for (int e = 0; e < 16; ++e) z[e] = 0.f;
                    BU[nt] = RMFMA(ua[th], bbf[nt], z); }
#pragma unroll
                for (int q = 0; q < 2; ++q) {
                    const Cx a1 = a1q[q], a2 = cmul(a1, a1), a3 = cmul(a2, a1), a4 = cmul(a2, a2);
                    Cx cc = c[q];
#pragma unroll
                    for (int qb = 0; qb < 4; ++qb) {
                        f32x16& RE = BU[q]; f32x16& IM = BU[2 + q];
                        Cx x = {RE[4 * qb], IM[4 * qb]};
#pragma unroll
                        for (int i = 1; i < 4; ++i) x = cfma(a1, x, Cx{RE[4 * qb + i], IM[4 * qb + i]});
                        const Cx px = {shx32(x.x), shx32(x.y)};
                        const Cx g0 = hh ? px : x, g1 = hh ? x : px;
                        const Cx c0 = cc; cc = cfma(a4, cc, g0); const Cx c1 = cc; cc = cfma(a4, cc, g1);
                        if (OUT) { Cx hx = hh ? c1 : c0;
#pragma unroll
                            for (int i = 0; i < 4; ++i) { hx = cfma(a1, hx, Cx{RE[4 * qb + i], IM[4 * qb + i]}); RE[4 * qb + i] = hx.x; IM[4 * qb + i] = hx.y; } }
                    }
                    c[q] = cc;
                }
                if (OUT) {
                    asm volatile("s_waitcnt lgkmcnt(0)" ::: "memory");
#pragma unroll
                    for (int nt = 0; nt < 4; ++nt)
#pragma unroll
                        for (int g4 = 0; g4 < 4; ++g4) { const f32x16& X = BU[nt];
                            *(LAS pg8::u32x2*)(img + nt * 2048 + r * 64 + 8 * (2 * g4 + hh)) = (pg8::u32x2){cvtpk(X[4 * g4], X[4 * g4 + 1]), cvtpk(X[4 * g4 + 2], X[4 * g4 + 3])}; }
                    asm volatile("s_waitcnt lgkmcnt(0)" ::: "memory");
                    f32x16 Y;
#pragma unroll
                    for (int e = 0; e < 16; ++e) Y[e] = 0.f;
#pragma unroll
                    for (int nt = 0; nt < 4; ++nt)
#pragma unroll
                        for (int s = 0; s < 2; ++s) {
                            const s16x4 lo = trr(img + nt * 2048 + (16 * s + 8 * hh + q4) * 64 + 8 * (4 * blk + p4));
                            const s16x4 hi = trr(img + nt * 2048 + (16 * s + 8 * hh + 4 + q4) * 64 + 8 * (4 * blk + p4));
                            const bf16x8 xa = __builtin_shufflevector(lo, hi, 0, 1, 2, 3, 4, 5, 6, 7);
                            Y = RMFMA(xa, ctl[(nt * 2 + s) * 64], Y);
                        }
                    Y = RMFMA(ua[th], bd, Y);
                    { const int up = r >> 4;
#pragma unroll
                      for (int e = 0; e < 8; ++e) { const float yv = up ? Y[8 + e] : Y[e]; const float u3 = yv * yv * yv;
                          const float zz = yv * __builtin_amdgcn_rcpf(1.f + __expf(-1.5957691216057308f * (yv + 0.044715f * u3)));
                          U[(size_t)(row0 + 32 * th + (e & 3) + 8 * ((e >> 2) + 2 * up) + 4 * hh) * 512 + g * 16 + (r & 15)] = f2bf(zz); } }
                }
            }
        }
        if (!OUT) {
            if (hh == 0) { float2* E = (float2*)(ws + WS_S5E) + ((size_t)(b * NSG + sg) * S5G + g) * S5N + r;
                E[0] = make_float2(c[0].x, c[0].y); E[32] = make_float2(c[1].x, c[1].y); }
        }
    }
    asm volatile("s_waitcnt lgkmcnt(0)" ::: "memory");
    __syncthreads();
}
}

__global__ void __launch_bounds__(NWAVES * 64, 2) mk_fwd(Args args_k) {
    extern __shared__ __attribute__((aligned(16))) unsigned char lds_raw[];
    LAS unsigned char* lds = (LAS unsigned char*)lds_raw;
    volatile LAS unsigned* MISC = (volatile LAS unsigned*)(lds + MISC_OFF);
    const int wbase = __builtin_amdgcn_readfirstlane((int)threadIdx.x) & ~63;
    const int G = gridDim.x;
    unsigned* ctl = (unsigned*)(args_k.ws + WS_CTL);
    { const int tid = pg8::fresh_tid(wbase); for (int u = tid; u < (LDS_BYTES - LDSCTL_OFF) / 4; u += NWAVES * 64) ((LAS unsigned*)(lds + LDSCTL_OFF))[u] = 0u; }
    __syncthreads();
    if (pg8::fresh_tid(wbase) == 0) { const unsigned b0 = blockIdx.x; MISC[8 + 4] = b0; MISC[8 + 5] = (G % 8 == 0) ? (b0 % 8u) * (unsigned)(G / 8) + b0 / 8u : b0; }
    __syncthreads();
    if ((args_k.ph_hi - args_k.ph_lo) > 1) (void)xcd_barrier_post(ctl + CW_BAR + args_k.bar_id * XCD_BAR_WORDS, MISC + 8, pg8::fresh_tid(wbase) == 0);
    const int ph_lo = args_k.ph_lo, ph_hi = args_k.ph_hi;
    bool rep_done = false; (void)rep_done;
    for (int ph = ph_lo; ph < ph_hi; ++ph) {
        const int l = ph > 0 ? (ph - 1) / NPL : 0, k = ph > 0 ? (ph - 1) % NPL : -1;
        unsigned moff = MISC_OFF + 32; asm volatile("" : "+s"(moff));
        const volatile LAS unsigned* MS = (const volatile LAS unsigned*)(lds + moff);
        const bool lok = __builtin_amdgcn_readfirstlane((int)MS[2]) != 0;
        const int bx = __builtin_amdgcn_readfirstlane((int)MS[4]), vcu = __builtin_amdgcn_readfirstlane((int)MS[5]);
        const __attribute__((address_space(4))) Args* ap = (const __attribute__((address_space(4))) Args*)__builtin_amdgcn_kernarg_segment_ptr(); asm volatile("" : "+s"(ap));
        const Args& args = *(const Args*)ap;
        unsigned char* ws = ap->ws;
        float* hA = ap->out; float* hB = (float*)(ws + WS_HB); bf16* hbf = (bf16*)(ws + WS_HBF);
        switch (k) {
        case -1: { ph::ProIn P{args.in[0], args.in[1], args.in[2], args.in[3], args.in[4], args.in[5], args.in[6], args.in[7], args.in[8], args.in[9], args.in[10], args.in[12], args.in[13], args.in[14], args.in[15], args.in[18], args.in[20], args.out};
            ph::prologue(wbase, lds, ws, P, G, vcu); } break;
        case K_PROJ: case K_BRANCH: {
            if (k == K_BRANCH) {
            { pg8::Gemm g{(const bf16*)(ws + R_V), (const bf16*)(ws + W_BRET) + (size_t)l * Dm * RV, RV}; pg8::StaticOrder S; S.init(T, Dm, RV, G, bx);
              epi::EpiRet E{ws}; pg8::gemm_phase<RV, epi::EpiRet, pg8::StaticOrder, true>(wbase, lds + RING_OFF, lds + PARK_OFF, g, S, E); }
            { pg8::Gemm g{(const bf16*)(ws + R_U), (const bf16*)(ws + W_GLU) + (size_t)l * S5W * S5W, S5W}; pg8::StaticOrder S; S.init(T, S5W, S5W, G, bx);
              epi::EpiGlu E{ws}; pg8::gemm_phase<S5W, epi::EpiGlu, pg8::StaticOrder, true>(wbase, lds + RING_OFF, lds + PARK_OFF, g, S, E); }
            }
            { const bool late = (k == K_BRANCH); const int hg = G / 2;
              pg8::Gemm g{hbf, (const bf16*)(ws + W_IN) + (size_t)l * INW * Dm, Dm}; pg8::StaticOrder S; S.init(T, late ? 512 : INW - 512, Dm, G, late ? (bx >= hg ? bx - hg : bx + G - hg) : bx, late ? (INW - 512) / 256 : 0);
              epi::EpiProj E{ws}; pg8::gemm_phase<Dm, epi::EpiProj, pg8::StaticOrder, true>(wbase, lds + RING_OFF, lds + PARK_OFF, g, S, E); } } break;
        case K_RETA: ret::phase_a(wbase, lds, ws, G, vcu); s5::pass<false>(wbase, lds, ws, nullptr, l, G, vcu); break;
        case K_RETB: ret::phase_b(wbase, lds, ws, G, vcu); s5::pass<true>(wbase, lds, ws, ap->in[11], l, G, vcu); break;
        case K_S5B: {
            pg8::Gemm g{(const bf16*)(ws + R_S5IN), (const bf16*)(ws + W_BS5) + (size_t)l * Dm * S5W, S5W}; pg8::StaticOrder S; S.init(T, Dm, S5W, G, bx);
            epi::EpiS5b E{ws}; pg8::gemm_phase<S5W, epi::EpiS5b, pg8::StaticOrder, true>(wbase, lds + RING_OFF, lds + PARK_OFF, g, S, E); } break;
        case K_OUT: {
            pg8::Gemm g{(const bf16*)(ws + R_G), (const bf16*)(ws + W_OUT) + (size_t)l * Dm * Dm, Dm}; pg8::StaticOrder S; S.init(T, Dm, Dm, G, bx);
            epi::EpiOut E{hbf, (bf16*)hB}; pg8::gemm_phase<Dm, epi::EpiOut, pg8::StaticOrder, true>(wbase, lds + RING_OFF, lds + PARK_OFF, g, S, E); } break;
        case K_LNROUTE: { ph::RouteIn P{args.in[16] + l * Dm, args.in[17] + l * Dm, args.in[19] + l * MG, args.in[21] + l * NE, args.in[22] + (size_t)l * NE * Dm * FF, args.in[23] + (size_t)l * NE * Dm * FF, args.in[24] + (size_t)l * NE * FF * Dm};
            ph::phase_lnroute(wbase, lds, ws, P, l, G, vcu); } break;
        case K_MOEGU: case K_MOEDN: {
            LAS unsigned* tp = (LAS unsigned*)(lds + LDSCTL_OFF + 512);
            const int tid = pg8::fresh_tid(wbase);
            if (tid < 32) tp[33 + tid] = __hip_atomic_load((unsigned*)(ws + WS_CNT) + l * NE + tid, __ATOMIC_RELAXED, __HIP_MEMORY_SCOPE_AGENT);
            __syncthreads();
            if (tid == 0) { unsigned a = 0; for (int j = 0; j < 32; ++j) { tp[j] = a; a += (tp[33 + j] + 255u) >> 8; } tp[32] = a; }
            __syncthreads();
            const unsigned* LIST = (const unsigned*)(ws + RT_LIST);
            if (k == K_MOEGU) {
                pg8::Gemm g{hbf, (const bf16*)(ws + R_WGU), Dm}; pg8::GroupedOrder S{tp, LIST, 2, G, vcu, 1};
                epi::EpiMoeGU E{ws, LIST}; pg8::gemm_phase<Dm, epi::EpiMoeGU, pg8::GroupedOrder, true>(wbase, lds + RING_OFF, lds + PARK_OFF, g, S, E);
                { const int U = 2 * __builtin_amdgcn_readfirstlane((int)tp[32]), R2 = U > G ? (U - G < G ? U - G : G) : 0, W1 = G - R2;
                  const int lane = pg8::fresh_tid(wbase) & 63, wv = wbase >> 6; constexpr int I_D = (FF / 64) * (Dm / 32);
                  const float* wd = ap->in[24] + (size_t)l * NE * FF * Dm;
                  auto decode = [&](int it) { const int e = it / I_D, r = it % I_D;
                      return ph::ConvItem{wd + (size_t)e * FF * Dm, (bf16*)(ws + R_WDN) + (size_t)e * Dm * FF, FF, Dm, 1, 0, 64 * (r / (Dm / 32)), 32 * (r % (Dm / 32))}; };
                  if (W1 > 0) { if (vcu >= R2) ph::conv_run(decode, (vcu - R2) * NWAVES + wv, W1 * NWAVES, NE * I_D, lds + wv * 16384, lane); }
                  else ph::conv_run(decode, bx * NWAVES + wv, G * NWAVES, NE * I_D, lds + wv * 16384, lane);
                  __syncthreads(); }
            } else {
                pg8::Gemm g{(const bf16*)(ws + R_ACT), (const bf16*)(ws + R_WDN), FF}; pg8::GroupedOrder S{tp, LIST, 4, G, vcu, 0};
                epi::EpiMoeDN E{ws, LIST}; pg8::gemm_phase<FF, epi::EpiMoeDN, pg8::GroupedOrder, true>(wbase, lds + RING_OFF, lds + PARK_OFF, g, S, E);
            } } break;
        case K_LN2: ph::phase_ln2(wbase, ws, args.in[25] + l * Dm, args.in[26] + l * Dm, l == DEPTH - 1 ? args.out : nullptr, G, vcu); break;
        default: break;
        }
#ifdef PROBE_REP_MASK
        if (((k >= 0 && ((PROBE_REP_MASK >> k) & 1)) || (k < 0 && (PROBE_REP_MASK & 0x8000))) && !rep_done) { rep_done = true; --ph; } else rep_done = false;
#endif
        if (ph + 1 < ph_hi) { XcdBarrier bar; bar.bar = (unsigned*)(ws + WS_CTL) + CW_BAR + ap->bar_id * XCD_BAR_WORDS; bar.x = xb_xcc_id(); bar.st = (volatile LAS unsigned*)(lds + MISC_OFF) + 8;
            const bool local = lok && (k == K_PROJ || k == K_RETA || k == K_RETB || k == K_BRANCH || k == K_S5B || k == K_OUT);
            xcd_barrier(bar, pg8::fresh_tid(wbase) == 0, local); }
    }
}
#ifndef MK_ONE_LAUNCH
#define MK_ONE_LAUNCH 1
#endif
static int g_grid = 0;
static void launch_mk(const Args& base, int lo, int hi, int bar_id, hipStream_t stream) {
    Args a = base; a.ph_lo = lo; a.ph_hi = hi; a.bar_id = bar_id;
    hipLaunchKernelGGL(mk_fwd, dim3(g_grid), dim3(NWAVES * 64), LDS_BYTES, stream, a);
}
extern "C" void kernel_launch(void* const* d_in, const int* in_sizes, int n_in, void* d_out, int out_size, void* d_ws, size_t ws_size, hipStream_t stream) {
    static int ok = 0;
    if (ok == 0) {
        if (n_in != 27 || in_sizes[0] != T * Dm || out_size != T * Dm || ws_size < WS_END) { fprintf(stderr, "kernel_launch: unexpected shapes/ws (%d, %d, %d, %zu < %zu)\n", n_in, n_in > 0 ? in_sizes[0] : -1, out_size, ws_size, (size_t)WS_END); ok = -1; return; }
        int dev = 0, cus = 0;
        if (hipGetDevice(&dev) != hipSuccess || hipDeviceGetAttribute(&cus, hipDeviceAttributeMultiprocessorCount, dev) != hipSuccess) { fprintf(stderr, "kernel_launch: device query failed\n"); ok = -1; return; }
        if (hipFuncSetAttribute((const void*)mk_fwd, hipFuncAttributeMaxDynamicSharedMemorySize, LDS_BYTES) != hipSuccess) { fprintf(stderr, "kernel_launch: LDS attribute failed\n"); ok = -1; return; }
        g_grid = cus;
        ok = 1;
    }
    if (ok < 0) return;
    unsigned char* ws = (unsigned char*)d_ws;
    const float* const* in = (const float* const*)d_in;
    float* hA = (float*)d_out;
    (void)hipMemsetAsync(ws + WS_CTL, 0, 1 * MiB, stream);
    Args base{}; for (int i = 0; i < 27; ++i) base.in[i] = in[i]; base.out = hA; base.ws = ws;
#if MK_ONE_LAUNCH
    launch_mk(base, 0, NPH, 0, stream);
#else
    for (int p = 0; p < NPH; ++p) launch_mk(base, p, p + 1, 0, stream);
#endif
}
```

```cpp
#include <hip/hip_runtime.h>
#include <cstdio>
#include <cstdint>
#include <cmath>

typedef unsigned short bf16;
#define DEV __device__ __forceinline__

constexpr int Dm = 1024, BATCH = 8, SEQ = 2048, T = BATCH * SEQ, DEPTH = 2;
constexpr int CHUNK = 64, NCH = SEQ / CHUNK;
constexpr int RH = 8, RQK = 512, RV = 1024, DK = 64, DV = 128;
constexpr int S5W = 512, S5G = 32, S5GC = 16, S5N = 64;
constexpr int MG = 4, EPG = 8, NE = 32, FF = 256;
constexpr int INW = 5632;
constexpr float LN_EPS = 1e-5f, HN_EPS = 1e-6f;
constexpr float ALPHA = 1.41421356237309515f;

constexpr size_t MiB = 1u << 20;
constexpr size_t WS_CTL = 0;
constexpr size_t WS_CNT = 64 * 1024;
constexpr size_t WS_TAB = 1 * MiB;
constexpr size_t TAB_COS = WS_TAB;
constexpr size_t TAB_SIN = TAB_COS + 2048 * 32 * 4;
constexpr size_t TAB_POWG = TAB_SIN + 2048 * 32 * 4;
constexpr size_t TAB_AB = TAB_POWG + 8 * 80 * 4;
constexpr size_t TAB_BBH = TAB_AB + DEPTH * S5G * S5N * 2 * 4;
constexpr size_t TAB_CTH = TAB_BBH + (size_t)DEPTH * S5G * 128 * 16 * 2;
constexpr size_t TAB_WRT = TAB_CTH + (size_t)DEPTH * S5G * 16 * 128 * 2;
constexpr size_t TAB_WRH = TAB_WRT + (size_t)DEPTH * 36 * Dm * 4;
constexpr size_t TAB_WRL = TAB_WRH + (size_t)DEPTH * 48 * Dm * 2;
constexpr size_t TAB_END = TAB_WRL + (size_t)DEPTH * 48 * Dm * 2;
static_assert(TAB_END <= 3 * MiB, "tables");
constexpr size_t WS_S5E = 3 * MiB;
constexpr size_t WS_ROUTE = 7 * MiB;
constexpr size_t RT_E = WS_ROUTE, RT_C = RT_E + (size_t)T * 2 * 4, RT_LIST = RT_C + (size_t)T * 2 * 4;
static_assert(RT_LIST + (size_t)NE * T * 4 <= 10 * MiB, "route");
constexpr size_t WS_WSM = 10 * MiB;
constexpr size_t W_IN = WS_WSM;
constexpr size_t W_GLU = W_IN + (size_t)DEPTH * INW * Dm * 2;
constexpr size_t W_BRET = W_GLU + (size_t)DEPTH * S5W * S5W * 2;
constexpr size_t W_BS5 = W_BRET + (size_t)DEPTH * Dm * RV * 2;
constexpr size_t W_OUT = W_BS5 + (size_t)DEPTH * Dm * S5W * 2;
constexpr size_t W_END = W_OUT + (size_t)DEPTH * Dm * Dm * 2;
static_assert(W_END <= 44 * MiB, "small weights");
constexpr size_t WS_HB = 44 * MiB;
constexpr size_t WS_HBF = 108 * MiB;
constexpr size_t WS_R1 = 140 * MiB;
constexpr size_t R_Q = WS_R1, R_K = R_Q + 16 * MiB, R_U = R_K + 16 * MiB, R_GR = R_U + 16 * MiB, R_GS = R_GR + 32 * MiB;
constexpr size_t WS_R2 = 252 * MiB;
constexpr size_t R_V = WS_R2, R_G = R_V + 32 * MiB;
constexpr size_t WS_END = 316 * MiB;
constexpr size_t R_S5IN = R_Q;
constexpr size_t R_WGU = WS_R1;
constexpr size_t R_WDN = WS_R1 + 32 * MiB;
constexpr size_t R_ACT = WS_R1 + 48 * MiB;
constexpr size_t R_Y = WS_R2;

DEV float bf2f(bf16 v) { return __uint_as_float((unsigned)v << 16); }
DEV bf16 f2bf(float f) { unsigned u = __float_as_uint(f); return (bf16)((u + 0x7fffu + ((u >> 16) & 1u)) >> 16); }
DEV float sigmoidf_(float x) { return 1.f / (1.f + __expf(-x)); }
DEV float siluf_(float x) { return x * sigmoidf_(x); }
DEV float geluf_(float x) { const float c = 0.7978845608028654f; float t = tanhf(c * (x + 0.044715f * x * x * x)); return 0.5f * x * (1.f + t); }
template <int M> DEV float xshfl(float v) { static_assert(M < 32, "ds_swizzle bit mode"); return __int_as_float(__builtin_amdgcn_ds_swizzle(__float_as_int(v), 0x1f | (M << 10))); }
DEV void xhalves(float v, float& lo, float& hi) { const unsigned u = __float_as_uint(v); auto rr = __builtin_amdgcn_permlane32_swap(u, u, false, false); lo = __uint_as_float(rr[0]); hi = __uint_as_float(rr[1]); }
template <int CTRL> DEV float dpp_add(float v) { return v + __int_as_float(__builtin_amdgcn_update_dpp(0, __float_as_int(v), CTRL, 0xf, 0xf, true)); }
DEV float wave_sum(float v) {
    v = dpp_add<0xB1>(v); v = dpp_add<0x4E>(v); v = dpp_add<0x141>(v); v = dpp_add<0x140>(v); v += xshfl<16>(v); { float lo, hi; xhalves(v, lo, hi); v = lo + hi; }
    return v;
}

namespace pg8 {
#define PG8_LAS __attribute__((address_space(3)))
typedef unsigned short bf16_t;
typedef short bf16x8 __attribute__((ext_vector_type(8)));
typedef float f32x4 __attribute__((ext_vector_type(4)));
typedef unsigned u32x4 __attribute__((ext_vector_type(4)));
typedef unsigned u32x2 __attribute__((ext_vector_type(2)));
typedef float f32x2 __attribute__((ext_vector_type(2)));
constexpr int BM = 256, BK = 64, HALF = 128, HTB = HALF * BK * 2  , STAGE_BYTES = 8 * HTB, NXCD = 8, WGM = 8;

__host__ __device__ __forceinline__ int lds_byte(int r, int c) { const int st = (r >> 4) * 2 + (c >> 5), rr = r & 15, cc = c & 31, ob = rr * 64 + cc * 2; return st * 1024 + (ob ^ (((ob >> 9) & 1) << 5)); }
__host__ __device__ __forceinline__ void stage_rc(int b, int& R, int& C) { const int st = b / 1024, sb = b % 1024, swz = sb ^ (((sb >> 9) & 1) << 5); R = (st >> 1) * 16 + swz / 64; C = (st & 1) * 32 + (swz % 64) / 2; }
__host__ __device__ __forceinline__ int perm32(int rho) { const int n = rho >> 4, i = rho & 15; return 8 * (i >> 2) + 4 * n + (i & 3); }

struct Unit { int pm, pn, pnb, e, cnt; };
struct Gemm { const bf16_t* A; const bf16_t* Bt; int K; };

struct StaticOrder {
    int nM, nN, nwg, G, c, K, pn0;
    __device__ void init(int M, int N, int K_, int G_, int c_, int pn0_ = 0) { nM = M / BM; nN = N / BM; nwg = nM * nN; G = G_; c = c_; K = K_; pn0 = pn0_; }
    __device__ bool next(int i, Unit& u) const {
        const unsigned L = (unsigned)i * (unsigned)G + (unsigned)c; if (L >= (unsigned)nwg) return false;
        int wgid = (int)L; { const int q = nwg / NXCD, r = nwg % NXCD, xcd = wgid % NXCD, off = wgid / NXCD; wgid = (xcd < r ? xcd * (q + 1) : r * (q + 1) + (xcd - r) * q) + off; }
        const int nig = WGM * nN, gid = wgid / nig, fm = gid * WGM, gsz = (nM - fm) < WGM ? (nM - fm) : WGM;
        u.pm = fm + ((wgid % nig) % gsz); u.pn = pn0 + (wgid % nig) / gsz; u.pnb = u.pn; u.e = 0; u.cnt = 0; return true;
    }
    static constexpr bool GATHER = false;
    __device__ __forceinline__ const unsigned* list_ptr(const Unit&, int) const { return nullptr; }
    __device__ __forceinline__ unsigned row_of(unsigned e) const { return e; }
};

__device__ __forceinline__ unsigned cvt_pk_bf16(float lo, float hi) { unsigned r; asm volatile("v_cvt_pk_bf16_f32 %0, %1, %2" : "=v"(r) : "v"(lo), "v"(hi)); return r; }

__device__ __forceinline__ int fresh_tid(int wbase) { int t; asm volatile("v_mbcnt_lo_u32_b32 %0, -1, 0\n\tv_mbcnt_hi_u32_b32 %0, -1, %0" : "=v"(t)); return t + wbase; }
template <int K, class Epi, class Sched, bool ALIGN_EPI = false>
__device__ __forceinline__ void gemm_phase(const int wbase, PG8_LAS unsigned char* lds, PG8_LAS unsigned char* park, const Gemm g, const Sched& S, const Epi& E) {
    constexpr bool GA = Sched::GATHER;
    const int wid = wbase >> 6, wr = wid >> 2, wc = wid & 3;
    const int tid = fresh_tid(wbase);
    constexpr int nt = K / BK; static_assert(K % 128 == 0 && K >= 256, "K");
    unsigned voffA[2], voffB[2];
#pragma unroll
    for (int i = 0; i < 2; ++i) { int R, C; stage_rc(tid * 16 + i * 8192, R, C); const int Rb = Epi::PERM ? ((R & ~31) + perm32(R & 31)) : R;
        voffA[i] = (unsigned)(R * K + C) * 2u; voffB[i] = (unsigned)(Rb * K + C) * 2u; }
#define PG8_RC(i, R, C) int R, C; stage_rc(fresh_tid(wbase) * 16 + (i) * 8192, R, C)
    const int kstep = BK * 2;
    const int hstep = HALF * K * 2;
    const int tstep = 2 * hstep;
    const __amdgpu_buffer_rsrc_t rsA = __builtin_amdgcn_make_buffer_rsrc((void*)g.A, 0, 0x7fffffff, 0x00020000);
    const __amdgpu_buffer_rsrc_t rsB = __builtin_amdgcn_make_buffer_rsrc((void*)g.Bt, 0, 0x7fffffff, 0x00020000);
    const unsigned ldsw = (unsigned)wid * 1024u;
    const int aoff = lds_byte(wr * 64 + (tid & 15), ((tid & 63) >> 4) * 8), boff = lds_byte(wc * 32 + (tid & 15), ((tid & 63) >> 4) * 8);
#define PG8_SA(b, h) (((b) * 2 + (h)) * HTB)
#define PG8_SB(b, h) ((4 + (b) * 2 + (h)) * HTB)
#define PG8_STAGE(bufoff, rs, voff, so) do { _Pragma("unroll") for (int _i = 0; _i < 2; ++_i) \
        __builtin_amdgcn_raw_ptr_buffer_load_lds(rs, (PG8_LAS void*)(lds + (bufoff) + ldsw + _i * 8192), 16, (int)(voff)[_i], (int)(so), 0, 0); } while (0)
#define PG8_STAGE_B(bufoff, so) PG8_STAGE(bufoff, rsB, voffB, so)
#define PG8_STAGE_A(bufoff, h, kb) do { if constexpr (GA) { if ((h) == 0) PG8_STAGE(bufoff, rsA, ao0, kb); else PG8_STAGE(bufoff, rsA, ao1, kb); } else { PG8_STAGE(bufoff, rsA, voffA, (kb) + (h) * hstep); } } while (0)
#define PG8_LDA(dst, b, h) do { _Pragma("unroll") for (int m = 0; m < 4; ++m) _Pragma("unroll") for (int k = 0; k < 2; ++k) dst[m][k] = *(const PG8_LAS bf16x8*)(lds + PG8_SA(b, h) + aoff + m * 2048 + k * 1024); } while (0)
#define PG8_LDB(dst, b, h) do { _Pragma("unroll") for (int n = 0; n < 2; ++n) _Pragma("unroll") for (int k = 0; k < 2; ++k) dst[n][k] = *(const PG8_LAS bf16x8*)(lds + PG8_SB(b, h) + boff + n * 2048 + k * 1024); } while (0)
#define PG8_MMA(ai, bj, At, Bt) do { __builtin_amdgcn_s_setprio(1); _Pragma("unroll") for (int m = 0; m < 4; ++m) _Pragma("unroll") for (int n = 0; n < 2; ++n) _Pragma("unroll") for (int k = 0; k < 2; ++k) \
        acc[ai][bj][m][n] = __builtin_amdgcn_mfma_f32_16x16x32_bf16(Bt[n][k], At[m][k], acc[ai][bj][m][n], 0, 0, 0); __builtin_amdgcn_s_setprio(0); } while (0)
#define PG8_WAIT_V(n) asm volatile("s_waitcnt vmcnt(" #n ")" ::: "memory")
#define PG8_WAIT_L(n) asm volatile("s_waitcnt lgkmcnt(" #n ")" ::: "memory")
#define PG8_BAR __builtin_amdgcn_s_barrier()
#define PG8_SCHED __builtin_amdgcn_sched_barrier(0)
    Unit cur, nxt; int ui = 0;
    if (!S.next(0, cur)) return;
    f32x4 acc[2][2][4][2];
#pragma unroll
    for (int a = 0; a < 2; ++a)
#pragma unroll
        for (int b = 0; b < 2; ++b)
#pragma unroll
            for (int m = 0; m < 4; ++m)
#pragma unroll
                for (int n = 0; n < 2; ++n) acc[a][b][m][n] = (f32x4){0.f, 0.f, 0.f, 0.f};
    bf16x8 At[4][2], B0[2][2], B1[2][2];
    unsigned ao0[2] = {0u, 0u}, ao1[2] = {0u, 0u};
    if constexpr (GA) {
#pragma unroll
        for (int i = 0; i < 2; ++i) { PG8_RC(i, R, C); ao0[i] = (S.row_of(*S.list_ptr(cur, R)) * (unsigned)K + (unsigned)C) * 2u; ao1[i] = (S.row_of(*S.list_ptr(cur, HALF + R)) * (unsigned)K + (unsigned)C) * 2u; }
    }
    int cA = GA ? 0 : cur.pm * tstep;
    int cB = cur.pnb * tstep;
    PG8_STAGE_B(PG8_SB(0, 0), cB); PG8_STAGE_B(PG8_SB(0, 1), cB + hstep); PG8_STAGE_A(PG8_SA(0, 0), 0, cA); PG8_STAGE_A(PG8_SA(0, 1), 1, cA);
    if (wr == 1) PG8_BAR;
    PG8_WAIT_V(2); PG8_BAR;
    PG8_STAGE_B(PG8_SB(1, 0), cB + kstep); PG8_STAGE_A(PG8_SA(1, 0), 0, cA + kstep); PG8_STAGE_B(PG8_SB(1, 1), cB + hstep + kstep);
    PG8_WAIT_V(6); PG8_BAR;
    for (;;) {
        const bool has_next = S.next(ui + 1, nxt);
        const int nA = (GA || !has_next) ? cA : nxt.pm * tstep; const int nB = has_next ? nxt.pnb * tstep : cB;
        if constexpr (GA) { if (has_next) {
#pragma unroll
            for (int s = 0; s < 4; ++s) { PG8_RC(s & 1, R, C); (void)C; __builtin_amdgcn_global_load_lds(S.list_ptr(nxt, (s >> 1) * HALF + R), (PG8_LAS unsigned*)(park + s * 2048 + wid * 256), 4, 0, 0); } } }
#define PG8_TRIP(LASTT) do { \
            const int a1 = cA + (t + 1) * kstep; \
            PG8_LDB(B0, 0, 0); PG8_LDB(B1, 0, 1); PG8_SCHED; PG8_LDA(At, 0, 0); PG8_STAGE_A(PG8_SA(1, 1), 1, a1); \
            if constexpr (GA && (LASTT)) { if (has_next) { _Pragma("unroll") for (int i = 0; i < 2; ++i) { PG8_RC(i, R, C); (void)R; const int t4 = fresh_tid(wbase) * 4; \
                ao0[i] = (S.row_of(*(const PG8_LAS unsigned*)(park + (0 + i) * 2048 + t4)) * (unsigned)K + (unsigned)C) * 2u; \
                ao1[i] = (S.row_of(*(const PG8_LAS unsigned*)(park + (2 + i) * 2048 + t4)) * (unsigned)K + (unsigned)C) * 2u; } } } \
            const int a2 = (LASTT) ? nA : cA + (t + 2) * kstep; const int b2 = (LASTT) ? nB : cB + (t + 2) * kstep; \
            const int a3 = a2 + kstep; const int b3 = b2 + kstep; \
            PG8_WAIT_V(8); PG8_WAIT_L(0); PG8_BAR; PG8_MMA(0, 0, At, B0); PG8_MMA(0, 1, At, B1); PG8_BAR; PG8_SCHED; \
            PG8_LDA(At, 0, 1); PG8_STAGE_B(PG8_SB(0, 0), b2); PG8_STAGE_B(PG8_SB(0, 1), b2 + hstep); PG8_STAGE_A(PG8_SA(0, 0), 0, a2); \
            PG8_WAIT_V(8); PG8_WAIT_L(0); PG8_BAR; PG8_MMA(1, 0, At, B0); PG8_MMA(1, 1, At, B1); PG8_BAR; PG8_SCHED; \
            PG8_LDB(B0, 1, 0); PG8_LDB(B1, 1, 1); PG8_SCHED; PG8_LDA(At, 1, 0); PG8_STAGE_A(PG8_SA(0, 1), 1, a2); \
            PG8_WAIT_V(8); PG8_WAIT_L(0); PG8_BAR; PG8_MMA(0, 0, At, B0); PG8_MMA(0, 1, At, B1); PG8_BAR; PG8_SCHED; \
            PG8_LDA(At, 1, 1); PG8_STAGE_B(PG8_SB(1, 0), b3); PG8_STAGE_B(PG8_SB(1, 1), b3 + hstep); PG8_STAGE_A(PG8_SA(1, 0), 0, a3); \
            PG8_WAIT_V(8); PG8_WAIT_L(0); PG8_BAR; PG8_MMA(1, 0, At, B0); PG8_MMA(1, 1, At, B1); PG8_BAR; PG8_SCHED; \
        } while (0)
        int t = 0; int ntm = nt - 2; asm volatile("" : "+s"(ntm));
        for (; t < ntm; t += 2) PG8_TRIP(false);
        PG8_TRIP(true);
#undef PG8_TRIP
        if constexpr (ALIGN_EPI) { if (wr == 0) PG8_BAR; }
        { const int te = fresh_tid(wbase); E(acc, cur, wr, wc, te & 15, (te & 63) >> 4); }
        if (!has_next) break;
#pragma unroll
        for (int a = 0; a < 2; ++a)
#pragma unroll
            for (int b = 0; b < 2; ++b)
#pragma unroll
                for (int m = 0; m < 4; ++m)
#pragma unroll
                    for (int n = 0; n < 2; ++n) acc[a][b][m][n] = (f32x4){0.f, 0.f, 0.f, 0.f};
        cur = nxt; cA = nA; cB = nB; ++ui;
        if constexpr (ALIGN_EPI) { if (wr == 1) PG8_BAR; }
    }
    PG8_WAIT_V(0);
    if constexpr (!ALIGN_EPI) { if (wr == 0) PG8_BAR; }
    PG8_BAR;
#undef PG8_SA
#undef PG8_SB
#undef PG8_STAGE
#undef PG8_STAGE_A
#undef PG8_STAGE_B
#undef PG8_RC
#undef PG8_LDA
#undef PG8_LDB
#undef PG8_MMA
#undef PG8_WAIT_V
#undef PG8_WAIT_L
#undef PG8_BAR
#undef PG8_SCHED
}
}
namespace epi {
using pg8::f32x4; using pg8::u32x4; using pg8::u32x2; using pg8::Unit; using pg8::cvt_pk_bf16;
DEV float fsig(float x) { return __builtin_amdgcn_rcpf(1.f + __expf(-x)); }
DEV void st16(void* p, const u32x4 v) { asm volatile("global_store_dwordx4 %0, %1, off sc1\n\ts_nop 1" :: "v"(p), "v"(v) : "memory"); }
DEV u32x4 pack8(const f32x4 a, const f32x4 b) { u32x4 w; w.x = cvt_pk_bf16(a[0], a[1]); w.y = cvt_pk_bf16(a[2], a[3]); w.z = cvt_pk_bf16(b[0], b[1]); w.w = cvt_pk_bf16(b[2], b[3]); return w; }
DEV void unpack8(const u32x4 w, f32x4& a, f32x4& b) {
    a[0] = __uint_as_float(w.x << 16); a[1] = __uint_as_float(w.x & 0xffff0000u); a[2] = __uint_as_float(w.y << 16); a[3] = __uint_as_float(w.y & 0xffff0000u);
    b[0] = __uint_as_float(w.z << 16); b[1] = __uint_as_float(w.z & 0xffff0000u); b[2] = __uint_as_float(w.w << 16); b[3] = __uint_as_float(w.w & 0xffff0000u); }
#define EPI_FOR8(...) _Pragma("unroll") for (int ai = 0; ai < 2; ++ai) _Pragma("unroll") for (int m = 0; m < 4; ++m) _Pragma("unroll") for (int bj = 0; bj < 2; ++bj) { \
        const int row = u.pm * 256 + ai * 128 + wr * 64 + m * 16 + fr; const int ct = bj * 128 + wc * 32 + 8 * fq; f32x4 v0 = acc[ai][bj][m][0], v1 = acc[ai][bj][m][1]; __VA_ARGS__ }

struct EpiProj {
    static constexpr bool PERM = true;
    unsigned char* ws;
    DEV void operator()(const f32x4 (&acc)[2][2][4][2], const Unit& u, int wr, int wc, int fr, int fq) const {
        const int pn = u.pn; bf16* base; int ld, c0, act; float sc = 1.f;
        if (pn < 2) { base = (bf16*)(ws + R_Q); ld = 512; c0 = pn * 256; act = 0; }
        else if (pn < 4) { base = (bf16*)(ws + R_K); ld = 512; c0 = (pn - 2) * 256; act = 0; sc = 0.125f; }
        else if (pn < 8) { base = (bf16*)(ws + R_V); ld = 1024; c0 = (pn - 4) * 256; act = 0; }
        else if (pn < 12) { base = (bf16*)(ws + R_G); ld = 1024; c0 = (pn - 8) * 256; act = 1; }
        else if (pn < 14) { base = (bf16*)(ws + R_U); ld = 512; c0 = (pn - 12) * 256; act = 0; }
        else if (pn < 18) { base = (bf16*)(ws + R_GR); ld = 1024; c0 = (pn - 14) * 256; act = 2; }
        else { base = (bf16*)(ws + R_GS); ld = 1024; c0 = (pn - 18) * 256; act = 2; }
        EPI_FOR8(
            if (act == 1) { _Pragma("unroll") for (int j = 0; j < 4; ++j) { v0[j] = v0[j] * fsig(v0[j]); v1[j] = v1[j] * fsig(v1[j]); } }
            else if (act == 2) { _Pragma("unroll") for (int j = 0; j < 4; ++j) { v0[j] = fsig(v0[j]); v1[j] = fsig(v1[j]); } }
            else { v0 = v0 * sc; v1 = v1 * sc; }
            st16(base + (size_t)row * ld + c0 + ct, pack8(v0, v1)); )
    }
};
#define EPI_OFF(m, bj, LD) ((size_t)(u.pm * 256 + ai * 128 + wr * 64 + (m) * 16 + fr) * (LD) + u.pn * 256 + (bj) * 128 + wc * 32 + 8 * fq)
struct EpiRet {
    static constexpr bool PERM = true;
    unsigned char* ws;
    DEV void operator()(const f32x4 (&acc)[2][2][4][2], const Unit& u, int wr, int wc, int fr, int fq) const {
        const bf16* GR = (const bf16*)(ws + R_GR); bf16* O = (bf16*)(ws + R_G);
#pragma unroll
        for (int ai = 0; ai < 2; ++ai) { u32x4 gv[4][2];
#pragma unroll
            for (int m = 0; m < 4; ++m)
#pragma unroll
                for (int bj = 0; bj < 2; ++bj) gv[m][bj] = *(const u32x4*)(GR + EPI_OFF(m, bj, 1024));
#pragma unroll
            for (int m = 0; m < 4; ++m)
#pragma unroll
                for (int bj = 0; bj < 2; ++bj) { f32x4 g0, g1; unpack8(gv[m][bj], g0, g1); st16(O + EPI_OFF(m, bj, 1024), pack8(acc[ai][bj][m][0] * g0, acc[ai][bj][m][1] * g1)); } }
    }
};
struct EpiGlu {
    static constexpr bool PERM = true;
    unsigned char* ws;
    DEV void operator()(const f32x4 (&acc)[2][2][4][2], const Unit& u, int wr, int wc, int fr, int fq) const {
        const bf16* Z = (const bf16*)(ws + R_U); bf16* O = (bf16*)(ws + R_S5IN);
#pragma unroll
        for (int ai = 0; ai < 2; ++ai) { u32x4 zv[4][2];
#pragma unroll
            for (int m = 0; m < 4; ++m)
#pragma unroll
                for (int bj = 0; bj < 2; ++bj) zv[m][bj] = *(const u32x4*)(Z + EPI_OFF(m, bj, 512));
#pragma unroll
            for (int m = 0; m < 4; ++m)
#pragma unroll
                for (int bj = 0; bj < 2; ++bj) { f32x4 z0, z1, v0 = acc[ai][bj][m][0], v1 = acc[ai][bj][m][1]; unpack8(zv[m][bj], z0, z1);
#pragma unroll
                    for (int q = 0; q < 4; ++q) { v0[q] = z0[q] * fsig(v0[q]); v1[q] = z1[q] * fsig(v1[q]); }
                    st16(O + EPI_OFF(m, bj, 512), pack8(v0, v1)); } }
    }
};
struct EpiS5b {
    static constexpr bool PERM = true;
    unsigned char* ws;
    DEV void operator()(const f32x4 (&acc)[2][2][4][2], const Unit& u, int wr, int wc, int fr, int fq) const {
        const bf16* GS = (const bf16*)(ws + R_GS); bf16* O = (bf16*)(ws + R_G);
#pragma unroll
        for (int ai = 0; ai < 2; ++ai) { u32x4 gv[4][2], pv[4][2];
#pragma unroll
            for (int m = 0; m < 4; ++m)
#pragma unroll
                for (int bj = 0; bj < 2; ++bj) { gv[m][bj] = *(const u32x4*)(GS + EPI_OFF(m, bj, 1024)); pv[m][bj] = *(const u32x4*)(O + EPI_OFF(m, bj, 1024)); }
#pragma unroll
            for (int m = 0; m < 4; ++m)
#pragma unroll
                for (int bj = 0; bj < 2; ++bj) { f32x4 g0, g1, p0, p1; unpack8(gv[m][bj], g0, g1); unpack8(pv[m][bj], p0, p1);
                    st16(O + EPI_OFF(m, bj, 1024), pack8(p0 + acc[ai][bj][m][0] * g0, p1 + acc[ai][bj][m][1] * g1)); } }
    }
};
struct EpiOut {
    static constexpr bool PERM = true;
    const bf16* hres; bf16* out;
    DEV void operator()(const f32x4 (&acc)[2][2][4][2], const Unit& u, int wr, int wc, int fr, int fq) const {
#pragma unroll
        for (int ai = 0; ai < 2; ++ai) { u32x4 hv[4][2];
#pragma unroll
            for (int m = 0; m < 4; ++m)
#pragma unroll
                for (int bj = 0; bj < 2; ++bj) hv[m][bj] = *(const u32x4*)(hres + EPI_OFF(m, bj, Dm));
#pragma unroll
            for (int m = 0; m < 4; ++m)
#pragma unroll
                for (int bj = 0; bj < 2; ++bj) { f32x4 h0, h1; unpack8(hv[m][bj], h0, h1); st16(out + EPI_OFF(m, bj, Dm), pack8(h0 * ALPHA + acc[ai][bj][m][0], h1 * ALPHA + acc[ai][bj][m][1])); } }
    }
};
}
namespace pg8 {
struct GroupedOrder {
    static constexpr bool GATHER = true;
    const PG8_LAS unsigned* tp; const unsigned* list; int NT, G, c, shift;
    __device__ bool next(int i, Unit& u) const {
        const unsigned total = (unsigned)__builtin_amdgcn_readfirstlane((int)tp[32]) * (unsigned)NT; const unsigned L = (unsigned)i * (unsigned)G + (unsigned)c;
        if (L >= total) return false;
        const unsigned mt = L / (unsigned)NT; int e = 0;
#pragma unroll
        for (int j = 1; j < 32; ++j) e += (mt >= tp[j]) ? 1 : 0;
        e = __builtin_amdgcn_readfirstlane(e);
        u.e = e; u.pm = (int)mt - __builtin_amdgcn_readfirstlane((int)tp[e]); u.pn = (int)(L % (unsigned)NT); u.pnb = e * NT + u.pn; u.cnt = __builtin_amdgcn_readfirstlane((int)tp[33 + e]); return true;
    }
    __device__ __forceinline__ const unsigned* list_ptr(const Unit& u, int r) const { int rr = u.pm * BM + r; rr = rr < u.cnt ? rr : u.cnt - 1; return list + (size_t)u.e * T + rr; }
    __device__ __forceinline__ unsigned row_of(unsigned e) const { return e >> shift; }
};
}
namespace epi {
struct EpiMoeGU {
    static constexpr bool PERM = true;
    unsigned char* ws; const unsigned* list;
    DEV void operator()(const f32x4 (&acc)[2][2][4][2], const Unit& u, int wr, int wc, int fr, int fq) const {
        bf16* ACT = (bf16*)(ws + R_ACT);
        unsigned pp[2][4];
#pragma unroll
        for (int ai = 0; ai < 2; ++ai)
#pragma unroll
            for (int m = 0; m < 4; ++m) { int r = u.pm * 256 + ai * 128 + wr * 64 + m * 16 + fr; r = r < u.cnt ? r : u.cnt - 1; pp[ai][m] = list[(size_t)u.e * T + r]; }
#pragma unroll
        for (int ai = 0; ai < 2; ++ai)
#pragma unroll
            for (int m = 0; m < 4; ++m) { const int r = u.pm * 256 + ai * 128 + wr * 64 + m * 16 + fr;
                if (r < u.cnt) { const unsigned p = pp[ai][m];
#pragma unroll
                    for (int bj = 0; bj < 2; ++bj) { const int f0 = u.pn * 128 + bj * 64 + wc * 16 + 4 * fq; const f32x4 v0 = acc[ai][bj][m][0], v1 = acc[ai][bj][m][1];
                        const float a0 = v0[0] * fsig(v0[0]) * v0[1], a1 = v0[2] * fsig(v0[2]) * v0[3], a2 = v1[0] * fsig(v1[0]) * v1[1], a3 = v1[2] * fsig(v1[2]) * v1[3];
                        u32x2 w; w.x = cvt_pk_bf16(a0, a1); w.y = cvt_pk_bf16(a2, a3); *(u32x2*)(ACT + (size_t)p * 256 + f0) = w; } } }
    }
};
struct EpiMoeDN {
    static constexpr bool PERM = true;
    unsigned char* ws; const unsigned* list;
    DEV void operator()(const f32x4 (&acc)[2][2][4][2], const Unit& u, int wr, int wc, int fr, int fq) const {
        bf16* Y = (bf16*)(ws + R_Y); const float* TC = (const float*)(ws + RT_C);
        unsigned pp[2][4]; float cw[2][4];
#pragma unroll
        for (int ai = 0; ai < 2; ++ai)
#pragma unroll
            for (int m = 0; m < 4; ++m) { int r = u.pm * 256 + ai * 128 + wr * 64 + m * 16 + fr; r = r < u.cnt ? r : u.cnt - 1; pp[ai][m] = list[(size_t)u.e * T + r]; }
#pragma unroll
        for (int ai = 0; ai < 2; ++ai)
#pragma unroll
            for (int m = 0; m < 4; ++m) cw[ai][m] = TC[pp[ai][m]];
#pragma unroll
        for (int ai = 0; ai < 2; ++ai)
#pragma unroll
            for (int m = 0; m < 4; ++m) { const int r = u.pm * 256 + ai * 128 + wr * 64 + m * 16 + fr;
                if (r < u.cnt) { const unsigned p = pp[ai][m]; const float c = cw[ai][m];
#pragma unroll
                    for (int bj = 0; bj < 2; ++bj) { const int d0 = u.pn * 256 + bj * 128 + wc * 32 + 8 * fq;
                        st16(Y + (size_t)p * Dm + d0, pack8(acc[ai][bj][m][0] * c, acc[ai][bj][m][1] * c)); } } }
    }
};
}
#define GAS __attribute__((address_space(1)))
#define LAS __attribute__((address_space(3)))
constexpr int NWAVES = 8;
constexpr int RING_OFF = 0, RING_BYTES = 131072;
constexpr int LDSCTL_OFF = RING_BYTES, MISC_OFF = LDSCTL_OFF + 320, PARK_OFF = RING_BYTES + 1024;
constexpr int LDS_BYTES = 147456;
constexpr int CW_TMO = 0, CW_CODE = 1, CW_BAR = 4096;

#define XB_TMO      128
#define XB_XCNT(j)  (256  + 64 * (j))
#define XB_XSUB(j)  (1280 + 64 * (j))
#define XB_XGEN(j)  (2304 + 64 * (j))
#define XB_TOP      3328
#define XB_TOPGEN   3392
#define XCD_BAR_WORDS 3456
#define XB_SPIN_CAP (1u << 18)
__device__ __forceinline__ unsigned xb_ld(unsigned* p)              { return __hip_atomic_load(p, __ATOMIC_RELAXED, __HIP_MEMORY_SCOPE_AGENT); }
__device__ __forceinline__ unsigned xb_add(unsigned* p, unsigned v) { return __hip_atomic_fetch_add(p, v, __ATOMIC_RELAXED, __HIP_MEMORY_SCOPE_AGENT); }
__device__ __forceinline__ unsigned xb_xcc_id() { return (unsigned)__builtin_amdgcn_s_getreg((3 << 11) | 20) & 0xFu; }
#define XB_SPIN(cond, bar) do { unsigned _sp = 0; while (cond) { __builtin_amdgcn_s_sleep(1); \
    if ((++_sp & 255u) == 0u) { if (xb_ld(&(bar)[XB_TMO])) break; if (_sp > XB_SPIN_CAP) { atomicAdd(&(bar)[XB_TMO], 1u); break; } } } } while (0)
struct XcdBarrier { unsigned* bar; unsigned x; volatile LAS unsigned* st; };
__device__ __forceinline__ XcdBarrier xcd_barrier_post(unsigned* bar, volatile LAS unsigned* st, bool t0) {
    XcdBarrier b; b.bar = bar; b.x = xb_xcc_id(); b.st = st;
    if (t0) st[3] = xb_add(&bar[XB_XCNT(b.x)], 1u);
    return b;
}
__device__ __forceinline__ void xcd_barrier_complete(unsigned* bar, unsigned x, unsigned& nloc, unsigned& nx) {
    const unsigned G = gridDim.x * gridDim.y * gridDim.z;
    unsigned sum, cnt, mine, sp = 0u;
    for (;;) {
        sum = 0u; cnt = 0u; mine = 0u;
#pragma unroll
        for (unsigned j = 0; j < 16; ++j) { const unsigned c = xb_ld(&bar[XB_XCNT(j)]); sum += c; cnt += (c > 0u) ? 1u : 0u; mine = (j == x) ? c : mine; }
        if (sum == G) break;
        __builtin_amdgcn_s_sleep(1);
        if ((++sp & 255u) == 0u) { if (xb_ld(&bar[XB_TMO])) break; if (sp > XB_SPIN_CAP) { atomicAdd(&bar[XB_TMO], 1u); break; } }
    }
    nloc = mine > 0u ? mine : 1u; nx = cnt > 0u ? cnt : 1u;
}
__device__ __forceinline__ void xcd_barrier(const XcdBarrier& b, bool t0, bool local) {
    asm volatile("s_waitcnt vmcnt(0)" ::: "memory");
    __syncthreads();
    if (t0) {
        unsigned* bar = b.bar;
        __builtin_amdgcn_s_waitcnt(0);
        unsigned nloc = b.st[0], nx = b.st[1];
        if (nloc == 0u) { xcd_barrier_complete(bar, b.x, nloc, nx); b.st[0] = nloc; b.st[1] = nx;
            const unsigned G = gridDim.x; unsigned even = (nx == 8u && (G & 7u) == 0u) ? 1u : 0u;
#pragma unroll
            for (unsigned j = 0; j < 8; ++j) even &= (xb_ld(&bar[XB_XCNT(j)]) == G / 8u) ? 1u : 0u;
            b.st[2] = even;
            if (even) { const unsigned rk = b.st[3]; b.st[4] = rk * 8u + b.x; b.st[5] = b.x * (G / 8u) + rk; } }
        const unsigned old = xb_add(&bar[XB_XSUB(b.x)], 1u);
        const unsigned gen = old / nloc;
        if (old + 1u == (gen + 1u) * nloc) {
            if (!local) {
            __builtin_amdgcn_fence(__ATOMIC_RELEASE, "agent");
            asm volatile("s_waitcnt vmcnt(0)" ::: "memory");
            const unsigned og = xb_add(&bar[XB_TOP], 1u);
            const unsigned tg = og / nx;
            if (og + 1u == (tg + 1u) * nx) xb_add(&bar[XB_TOPGEN], 1u);
            else XB_SPIN(xb_ld(&bar[XB_TOPGEN]) == tg, bar);
            }
            __builtin_amdgcn_fence(__ATOMIC_ACQUIRE, "agent");
            xb_add(&bar[XB_XGEN(b.x)], 1u);
            asm volatile("s_waitcnt vmcnt(0)" ::: "memory");
        } else {
            XB_SPIN(xb_ld(&bar[XB_XGEN(b.x)]) == gen, bar);
            __builtin_amdgcn_fence(__ATOMIC_ACQUIRE, "agent");
            asm volatile("s_waitcnt vmcnt(0)" ::: "memory");
        }
    }
    __syncthreads();
}

struct Args { const float* in[27]; float* out; unsigned char* ws; int ph_lo, ph_hi, bar_id, pad; };
constexpr int NPL = 10, NPH = 1 + DEPTH * NPL;
enum { K_PROJ = 0, K_RETA = 1, K_RETB = 2, K_BRANCH = 3, K_S5B = 4, K_OUT = 5, K_LNROUTE = 6, K_MOEGU = 7, K_MOEDN = 8, K_LN2 = 9 };
namespace ph {
#define LDSW() asm volatile("s_waitcnt lgkmcnt(0)" ::: "memory")
DEV int lane_id(int wbase) { return pg8::fresh_tid(wbase) & 63; }
DEV unsigned pk2(float lo, float hi) { return (unsigned)f2bf(lo) | ((unsigned)f2bf(hi) << 16); }
DEV void transpose_item(const float* __restrict__ W, int K, int N, bf16* __restrict__ WT, int rmul, int radd, LAS float* scr, int item, int lane) {
    const int nblk = N / 32, kb = item / nblk, nb = item % nblk, k0 = 64 * kb, n0 = 32 * nb;
#pragma unroll 8
    for (int i = 0; i < 32; ++i) { const int kk = 2 * i + (lane >> 5); scr[kk * 33 + (lane & 31)] = W[(size_t)(k0 + kk) * N + n0 + (lane & 31)]; }
    LDSW(); asm volatile("" ::: "memory");
    const int c = lane & 7;
#pragma unroll
    for (int j = 0; j < 4; ++j) { const int n = (lane >> 3) + 8 * j; const LAS float* s = scr + (8 * c) * 33 + n;
        uint4 o; o.x = pk2(s[0 * 33], s[1 * 33]); o.y = pk2(s[2 * 33], s[3 * 33]); o.z = pk2(s[4 * 33], s[5 * 33]); o.w = pk2(s[6 * 33], s[7 * 33]);
        *(uint4*)(WT + (size_t)((n0 + n) * rmul + radd) * K + k0 + 8 * c) = o; }
    LDSW(); asm volatile("" ::: "memory");
}
struct ConvItem { const float* W; bf16* WT; int K, N, rmul, radd, k0, n0; };
DEV void conv_issue(const ConvItem& c, LAS unsigned char* tile, int lane) {
    const float* src = c.W + (size_t)(c.k0 + (lane >> 3)) * c.N + c.n0;
#pragma unroll
    for (int j = 0; j < 8; ++j) __builtin_amdgcn_global_load_lds(src + (size_t)(8 * j) * c.N + (((lane & 7) ^ j) * 4), (LAS void*)(tile + j * 1024), 16, 0, 0);
}
DEV void conv_finish(const ConvItem& c, const LAS unsigned char* tile, int lane) {
    const int cc = lane & 7, nb = lane >> 3;
#pragma unroll
    for (int jj = 0; jj < 4; ++jj) { const int n = nb + 8 * jj; const LAS float* s = (const LAS float*)tile + cc * 256 + (((n >> 2) ^ cc) * 4) + (n & 3);
        uint4 o; o.x = pk2(s[0], s[32]); o.y = pk2(s[64], s[96]); o.z = pk2(s[128], s[160]); o.w = pk2(s[192], s[224]);
        *(uint4*)(c.WT + (size_t)((c.n0 + n) * c.rmul + c.radd) * c.K + c.k0 + 8 * cc) = o; }
}
template <class Dec> DEV void conv_run(const Dec& decode, int first, int stride, int total, LAS unsigned char* t0, int lane) {
    int it = first, par = 0; bool have = it < total; ConvItem cur{};
    if (have) { cur = decode(it); conv_issue(cur, t0, lane); }
    while (have) { const int nx = it + stride; const bool hn = nx < total; ConvItem nxt{};
        if (hn) { nxt = decode(nx); conv_issue(nxt, t0 + (par ^ 1) * 8192, lane); asm volatile("s_waitcnt vmcnt(8)" ::: "memory"); } else asm volatile("s_waitcnt vmcnt(0)" ::: "memory");
        conv_finish(cur, t0 + par * 8192, lane); cur = nxt; it = nx; have = hn; par ^= 1; }
}
DEV void ln_finish(float (&v)[16], const float* __restrict__ g, const float* __restrict__ b, float* of, bf16* ob, int lane) {
    float s = 0.f;
#pragma unroll
    for (int i = 0; i < 16; ++i) s += v[i];
    const float mean = wave_sum(s) * (1.f / Dm); float q = 0.f;
#pragma unroll
    for (int i = 0; i < 16; ++i) { v[i] -= mean; q += v[i] * v[i]; }
    const float rstd = rsqrtf(wave_sum(q) * (1.f / Dm) + LN_EPS);
#pragma unroll
    for (int j = 0; j < 4; ++j) { const float4 gg = *(const float4*)(g + j * 256 + lane * 4), bb = *(const float4*)(b + j * 256 + lane * 4);
        float4 o; o.x = v[4 * j] * rstd * gg.x + bb.x; o.y = v[4 * j + 1] * rstd * gg.y + bb.y; o.z = v[4 * j + 2] * rstd * gg.z + bb.z; o.w = v[4 * j + 3] * rstd * gg.w + bb.w;
        v[4 * j] = o.x; v[4 * j + 1] = o.y; v[4 * j + 2] = o.z; v[4 * j + 3] = o.w;
        if (of) *(float4*)(of + j * 256 + lane * 4) = o;
        uint2 w; w.x = pk2(o.x, o.y); w.y = pk2(o.z, o.w); *(uint2*)(ob + j * 256 + lane * 4) = w; }
}

DEV void ln_row(const float* pre, const bf16* preb, float scale, const bf16* y2, const float* __restrict__ g, const float* __restrict__ b, float* of, bf16* ob, int lane, float (&v)[16]) {
    if (pre) {
#pragma unroll
        for (int j = 0; j < 4; ++j) { const float4 x = *(const float4*)(pre + j * 256 + lane * 4); v[4 * j] = x.x * scale; v[4 * j + 1] = x.y * scale; v[4 * j + 2] = x.z * scale; v[4 * j + 3] = x.w * scale; }
    } else {
#pragma unroll
        for (int j = 0; j < 4; ++j) { const uint2 a = *(const uint2*)(preb + j * 256 + lane * 4);
            v[4 * j] = __uint_as_float(a.x << 16) * scale; v[4 * j + 1] = __uint_as_float(a.x & 0xffff0000u) * scale; v[4 * j + 2] = __uint_as_float(a.y << 16) * scale; v[4 * j + 3] = __uint_as_float(a.y & 0xffff0000u) * scale; }
    }
    if (y2) {
#pragma unroll
        for (int j = 0; j < 4; ++j) { const uint2 a = *(const uint2*)(y2 + j * 256 + lane * 4), c = *(const uint2*)(y2 + Dm + j * 256 + lane * 4);
            v[4 * j] += __uint_as_float(a.x << 16) + __uint_as_float(c.x << 16); v[4 * j + 1] += __uint_as_float(a.x & 0xffff0000u) + __uint_as_float(c.x & 0xffff0000u);
            v[4 * j + 2] += __uint_as_float(a.y << 16) + __uint_as_float(c.y << 16); v[4 * j + 3] += __uint_as_float(a.y & 0xffff0000u) + __uint_as_float(c.y & 0xffff0000u); }
    }
    ln_finish(v, g, b, of, ob, lane);
}

struct ProIn { const float *x, *lng, *lnb, *w_in, *lam_re, *lam_im, *log_step, *b_re, *b_im, *c_re, *c_im, *w_glu, *w_bret, *w_bs5, *w_out, *w_rg, *w_re; float* out; };
DEV void prologue(const int wbase, LAS unsigned char* lds, unsigned char* ws, const ProIn P, int G, int vcu) {
    const int wave = wbase >> 6, lane = lane_id(wbase), tid = wbase + lane;
    LAS float* scr = (LAS float*)(lds + wave * 16384);
    const int gw = vcu * NWAVES + wave, NGW = G * NWAVES;
    constexpr int I_IN = (Dm / 64) * (INW / 32), I_GLU = (S5W / 64) * (S5W / 32), I_BRET = (RV / 64) * (Dm / 32), I_BS5 = (S5W / 64) * (Dm / 32), I_OUT = (Dm / 64) * (Dm / 32);
    constexpr int I_L = I_IN + I_GLU + I_BRET + I_BS5 + I_OUT;
    { auto decode = [&](int it) { const int l = it / I_L; int r = it % I_L;
          const float* W; bf16* WT; int K, N;
          if (r < I_IN) { W = P.w_in + (size_t)l * Dm * INW; K = Dm; N = INW; WT = (bf16*)(ws + W_IN) + (size_t)l * INW * Dm; }
          else if ((r -= I_IN) < I_GLU) { W = P.w_glu + (size_t)l * S5W * S5W; K = S5W; N = S5W; WT = (bf16*)(ws + W_GLU) + (size_t)l * S5W * S5W; }
          else if ((r -= I_GLU) < I_BRET) { W = P.w_bret + (size_t)l * RV * Dm; K = RV; N = Dm; WT = (bf16*)(ws + W_BRET) + (size_t)l * Dm * RV; }
          else if ((r -= I_BRET) < I_BS5) { W = P.w_bs5 + (size_t)l * S5W * Dm; K = S5W; N = Dm; WT = (bf16*)(ws + W_BS5) + (size_t)l * Dm * S5W; }
          else { r -= I_BS5; W = P.w_out + (size_t)l * Dm * Dm; K = Dm; N = Dm; WT = (bf16*)(ws + W_OUT) + (size_t)l * Dm * Dm; }
          const int nblk = N / 32; return ConvItem{W, WT, K, N, 1, 0, 64 * (r / nblk), 32 * (r % nblk)}; };
      conv_run(decode, gw, NGW, DEPTH * I_L, lds + wave * 16384, lane); }
    const int gt = vcu * (NWAVES * 64) + tid, NGT = G * NWAVES * 64;
    float* COS = (float*)(ws + TAB_COS); float* SIN = (float*)(ws + TAB_SIN); float* POWG = (float*)(ws + TAB_POWG);
    float* AB = (float*)(ws + TAB_AB); bf16* BBH = (bf16*)(ws + TAB_BBH); bf16* CTH = (bf16*)(ws + TAB_CTH); float* WRT = (float*)(ws + TAB_WRT);
    for (int gid = gt; gid < 2048 * 32; gid += NGT) { const int pos = gid >> 5, i = gid & 31; const float inv = exp2f(-(float)i * (13.287712379549449f / 32.0f)); const float ang = (float)pos * inv;
        COS[gid] = cosf(ang); SIN[gid] = sinf(ang); }
    for (int gid = gt; gid < 8 * 80; gid += NGT) { const int h = gid / 80, n = gid % 80; const float lg = log1pf(-exp2f(-5.0f - (float)h)); POWG[gid] = expf(lg * (float)n); }
    for (int gid = gt; gid < DEPTH * S5G * S5N; gid += NGT) {
        const int g = (gid / S5N) % S5G, l = gid / (S5G * S5N);
        float lr = P.lam_re[gid]; if (lr > -1e-4f) lr = -1e-4f; const float li = P.lam_im[gid];
        const float step = expf(P.log_step[l * S5G + g]);
        const float em1 = expm1f(lr * step), mag = em1 + 1.f, ang = li * step, cs = cosf(ang), sn = sinf(ang), sh = sinf(0.5f * ang);
        const float abr = mag * cs, abi = mag * sn;
        const float nre = em1 * cs - 2.f * sh * sh;
        const float den = lr * lr + li * li;
        const float zr = (nre * lr + abi * li) / den, zi = (abi * lr - nre * li) / den;
        AB[gid * 2] = abr; AB[gid * 2 + 1] = abi;
        const int n = gid % S5N, lg = gid / S5N;
        for (int c = 0; c < 16; ++c) { const float br = P.b_re[(size_t)gid * 16 + c], bi = P.b_im[(size_t)gid * 16 + c];
            BBH[((size_t)lg * 128 + n) * 16 + c] = f2bf(zr * br - zi * bi); BBH[((size_t)lg * 128 + 64 + n) * 16 + c] = f2bf(zr * bi + zi * br); }
    }
    for (int gid = gt; gid < DEPTH * S5G * 16 * 128; gid += NGT) { const int np = gid & 127, lgc = gid >> 7;
        CTH[gid] = f2bf(np < 64 ? P.c_re[(size_t)lgc * 64 + np] : -P.c_im[(size_t)lgc * 64 + np - 64]); }
    for (int gid = gt; gid < DEPTH * 36 * Dm; gid += NGT) { const int kk = gid % Dm, j = (gid / Dm) % 36, l = gid / (36 * Dm);
        WRT[gid] = j < 4 ? P.w_rg[((size_t)l * Dm + kk) * MG + j] : P.w_re[((size_t)l * Dm + kk) * NE + (j - 4)]; }
    { bf16* WRH = (bf16*)(ws + TAB_WRH); bf16* WRL = (bf16*)(ws + TAB_WRL);
      for (int gid = gt; gid < DEPTH * 48 * Dm; gid += NGT) { const int kk = gid % Dm, j = (gid / Dm) % 48, l = gid / (48 * Dm);
          const float w = j < 4 ? P.w_rg[((size_t)l * Dm + kk) * MG + j] : (j < 36 ? P.w_re[((size_t)l * Dm + kk) * NE + (j - 4)] : 0.f);
          const bf16 hi = f2bf(w); WRH[gid] = hi; WRL[gid] = f2bf(w - bf2f(hi)); } }
    float v[16];
    for (int m = gw; m < T; m += NGW) ln_row(P.x + (size_t)m * Dm, nullptr, 1.f, nullptr, P.lng, P.lnb, nullptr, (bf16*)(ws + WS_HBF) + (size_t)m * Dm, lane, v);
}

struct RouteIn { const float *lng, *lnb, *brg, *bre, *wg, *wu, *wd; };
DEV void phase_lnroute(const int wbase, LAS unsigned char* lds, unsigned char* ws, const RouteIn P, int layer, int G, int vcu) {
    const int wave = wbase >> 6, lane = lane_id(wbase);
    const int gw = vcu * NWAVES + wave, NGW = G * NWAVES;
    const bf16* preb = (const bf16*)(ws + WS_HB); bf16* ob = (bf16*)(ws + WS_HBF);
    const float* WRT = (const float*)(ws + TAB_WRT) + (size_t)layer * 36 * Dm;
    const float* brg = P.brg; const float* bre = P.bre;
    int* TE = (int*)(ws + RT_E); float* TC = (float*)(ws + RT_C); int* LIST = (int*)(ws + RT_LIST); unsigned* CNT = (unsigned*)(ws + WS_CNT) + layer * NE;
    typedef short bf16x8 __attribute__((ext_vector_type(8))); typedef float f32x4 __attribute__((ext_vector_type(4)));
    constexpr int AS = 2064, A_LO = 16 * AS, PL_OFF = 2 * 16 * AS, LG_OFF = PL_OFF + 8 * 16 * 48 * 4, RT_OFF = LG_OFF + 16 * 48 * 4, CAP = 128;
    LAS unsigned* lcnt = (LAS unsigned*)(lds + RT_OFF); LAS unsigned* gbase = lcnt + 32; LAS int* le1 = (LAS int*)(gbase + 32); LAS int* le2 = le1 + CAP;
    LAS unsigned* lr1 = (LAS unsigned*)(le2 + CAP); LAS unsigned* lr2 = lr1 + CAP; LAS float* lc1 = (LAS float*)(lr2 + CAP); LAS float* lc2 = lc1 + CAP; LAS int* lrow = (LAS int*)(lc2 + CAP);
    static_assert(RT_OFF + 64 * 4 + 7 * CAP * 4 <= RING_BYTES, "lnroute LDS");
    const int tid = wbase + lane, fr = lane & 15, fq = lane >> 4;
    bf16x8 bh[3][4], bl[3][4];
    { const bf16* WRH = (const bf16*)(ws + TAB_WRH) + (size_t)layer * 48 * Dm; const bf16* WRL = (const bf16*)(ws + TAB_WRL) + (size_t)layer * 48 * Dm;
#pragma unroll
      for (int nt = 0; nt < 3; ++nt)
#pragma unroll
          for (int ks = 0; ks < 4; ++ks) { const size_t o = (size_t)(16 * nt + fr) * Dm + wave * 128 + ks * 32 + 8 * fq; bh[nt][ks] = *(const bf16x8*)(WRH + o); bl[nt][ks] = *(const bf16x8*)(WRL + o); } }
    if (tid < 32) lcnt[tid] = 0u;
    int nent = 0;
    __syncthreads();
    const bool contig = ((T / 16) % G) == 0; const int nbw = contig ? (T / 16) / G : ((T / 16) + G - 1) / G;
    constexpr int PF_OFF = 98304; static_assert(PF_OFF >= RT_OFF + 64 * 4 + 7 * CAP * 4 && PF_OFF + 16 * 2048 <= RING_BYTES, "lnroute prefetch LDS");
    auto blk_of = [&](int ib) { return contig ? vcu * nbw + ib : vcu + ib * G; };
    auto prefetch = [&](int blk) {
#pragma unroll
        for (int jr = 0; jr < 2; ++jr) { const int lr = 2 * wave + jr; const bf16* src = preb + (size_t)(blk * 16 + lr) * Dm + lane * 8;
            __builtin_amdgcn_global_load_lds(src, (LAS void*)(lds + PF_OFF + lr * 2048), 16, 0, 0); __builtin_amdgcn_global_load_lds(src + 512, (LAS void*)(lds + PF_OFF + lr * 2048 + 1024), 16, 0, 0); } };
    if (nbw > 0 && blk_of(0) < T / 16) prefetch(blk_of(0));
    for (int ib = 0; ib < nbw; ++ib) { const int blk = blk_of(ib); if (blk >= T / 16) break;
        pg8::u32x2 raw[2][4];
        asm volatile("s_waitcnt vmcnt(0)" ::: "memory");
#pragma unroll
        for (int jr = 0; jr < 2; ++jr)
#pragma unroll
            for (int j = 0; j < 4; ++j) raw[jr][j] = *(const LAS pg8::u32x2*)(lds + PF_OFF + (2 * wave + jr) * 2048 + j * 512 + lane * 8);
        LDSW(); asm volatile("" ::: "memory");
        if (ib + 1 < nbw && blk_of(ib + 1) < T / 16) prefetch(blk_of(ib + 1));
#pragma unroll
        for (int jr = 0; jr < 2; ++jr) { const int lr = 2 * wave + jr, row = blk * 16 + lr;
            float v[16];
#pragma unroll
            for (int j = 0; j < 4; ++j) { const pg8::u32x2 a = raw[jr][j];
                v[4 * j] = __uint_as_float(a.x << 16); v[4 * j + 1] = __uint_as_float(a.x & 0xffff0000u); v[4 * j + 2] = __uint_as_float(a.y << 16); v[4 * j + 3] = __uint_as_float(a.y & 0xffff0000u); }
            ln_finish(v, P.lng, P.lnb, nullptr, ob + (size_t)row * Dm, lane);
#pragma unroll
            for (int j = 0; j < 4; ++j) { unsigned hw[2], lw[2];
#pragma unroll
                for (int e2 = 0; e2 < 2; ++e2) { const float x0 = v[4 * j + 2 * e2], x1 = v[4 * j + 2 * e2 + 1]; const bf16 h0 = f2bf(x0), h1 = f2bf(x1);
                    hw[e2] = (unsigned)h0 | ((unsigned)h1 << 16); lw[e2] = (unsigned)f2bf(x0 - bf2f(h0)) | ((unsigned)f2bf(x1 - bf2f(h1)) << 16); }
                *(LAS pg8::u32x2*)(lds + lr * AS + (j * 256 + lane * 4) * 2) = (pg8::u32x2){hw[0], hw[1]};
                *(LAS pg8::u32x2*)(lds + A_LO + lr * AS + (j * 256 + lane * 4) * 2) = (pg8::u32x2){lw[0], lw[1]}; } }
        __syncthreads();
        f32x4 acc[3];
#pragma unroll
        for (int nt = 0; nt < 3; ++nt) acc[nt] = (f32x4){0.f, 0.f, 0.f, 0.f};
#pragma unroll
        for (int ks = 0; ks < 4; ++ks) { const int ao = fr * AS + (wave * 128 + ks * 32 + 8 * fq) * 2;
            const bf16x8 ah = *(const LAS bf16x8*)(lds + ao), al = *(const LAS bf16x8*)(lds + A_LO + ao);
#pragma unroll
            for (int nt = 0; nt < 3; ++nt) { acc[nt] = __builtin_amdgcn_mfma_f32_16x16x32_bf16(ah, bh[nt][ks], acc[nt], 0, 0, 0);
                acc[nt] = __builtin_amdgcn_mfma_f32_16x16x32_bf16(al, bh[nt][ks], acc[nt], 0, 0, 0); acc[nt] = __builtin_amdgcn_mfma_f32_16x16x32_bf16(ah, bl[nt][ks], acc[nt], 0, 0, 0); } }
        { LAS float* PL = (LAS float*)(lds + PL_OFF) + wave * 16 * 48;
#pragma unroll
          for (int nt = 0; nt < 3; ++nt)
#pragma unroll
              for (int rg = 0; rg < 4; ++rg) PL[(4 * fq + rg) * 48 + 16 * nt + fr] = acc[nt][rg]; }
        __syncthreads();
        for (int idx = tid; idx < 16 * 48; idx += NWAVES * 64) { const LAS float* PL = (const LAS float*)(lds + PL_OFF) + idx; float s = 0.f;
#pragma unroll
            for (int w = 0; w < 8; ++w) s += PL[w * 16 * 48];
            ((LAS float*)(lds + LG_OFF))[idx] = s; }
        __syncthreads();
        if (tid < 16) { const LAS float* LG = (const LAS float*)(lds + LG_OFF) + tid * 48; const int row = blk * 16 + tid;
            float lg[4];
#pragma unroll
            for (int kk = 0; kk < 4; ++kk) lg[kk] = LG[kk] + brg[kk];
            int gi = 0; float gm = lg[0];
#pragma unroll
            for (int kk = 1; kk < 4; ++kk) if (lg[kk] > gm) { gm = lg[kk]; gi = kk; }
            float den = 0.f;
#pragma unroll
            for (int kk = 0; kk < 4; ++kk) den += __expf(lg[kk] - gm);
            const float gtop = 1.f / den;
            int i1 = 0, i2 = 0; float m1 = -INFINITY, m2 = -INFINITY;
            for (int kk = 0; kk < 8; ++kk) { const float x = LG[4 + gi * 8 + kk] + bre[gi * 8 + kk];
                if (x > m1) { m2 = m1; i2 = i1; m1 = x; i1 = kk; } else if (x > m2) { m2 = x; i2 = kk; } }
            const float p2 = __expf(m2 - m1);
            const float w1 = 1.f / (1.f + p2), w2 = p2 / (1.f + p2);
            const int e1 = gi * 8 + i1, e2 = gi * 8 + i2, li = nent + tid;
            le1[li] = e1; le2[li] = e2; lc1[li] = gtop * w1; lc2[li] = gtop * w2; lrow[li] = row;
            lr1[li] = __hip_atomic_fetch_add(lcnt + e1, 1u, __ATOMIC_RELAXED, __HIP_MEMORY_SCOPE_WORKGROUP); lr2[li] = __hip_atomic_fetch_add(lcnt + e2, 1u, __ATOMIC_RELAXED, __HIP_MEMORY_SCOPE_WORKGROUP); }
        nent += 16;
        const bool last = (ib + 1 >= nbw) || (!contig && blk + G >= T / 16);
        if (nent == CAP || last) {
            __syncthreads();
            if (tid < 32) { const unsigned c = lcnt[tid]; gbase[tid] = c ? atomicAdd(&CNT[tid], c) : 0u; }
            __syncthreads();
            if (tid < nent) { const int row = lrow[tid], e1 = le1[tid], e2 = le2[tid];
                TE[row * 2] = e1; TE[row * 2 + 1] = e2; TC[row * 2] = lc1[tid]; TC[row * 2 + 1] = lc2[tid];
                LIST[(size_t)e1 * T + gbase[e1] + lr1[tid]] = row * 2; LIST[(size_t)e2 * T + gbase[e2] + lr2[tid]] = row * 2 + 1; }
            __syncthreads();
            if (tid < 32) lcnt[tid] = 0u;
            nent = 0;
        }
        __syncthreads();
    }
    constexpr int I_G = (Dm / 64) * (FF / 32);
    { LAS unsigned char* t0 = lds + wave * 16384;
      auto decode = [&](int it) { const int e = it / (2 * I_G), r = it % (2 * I_G), m = r / I_G, q = r % I_G;
          return ConvItem{(m ? P.wu : P.wg) + (size_t)e * Dm * FF, (bf16*)(ws + R_WGU) + (size_t)e * 512 * Dm, Dm, FF, 2, m, 64 * (q / (FF / 32)), 32 * (q % (FF / 32))}; };
      __syncthreads();
      conv_run(decode, gw, NGW, NE * 2 * I_G, t0, lane); }
}
DEV void phase_ln2(const int wbase, unsigned char* ws, const float* lng, const float* lnb, float* out, int G, int vcu) {
    const int wave = wbase >> 6, lane = lane_id(wbase);
    const int gw = vcu * NWAVES + wave, NGW = G * NWAVES;
    float v[16];
    for (int row = gw; row < T; row += NGW)
        ln_row(nullptr, (const bf16*)(ws + WS_HBF) + (size_t)row * Dm, ALPHA, (const bf16*)(ws + R_Y) + (size_t)(2 * row) * Dm, lng, lnb, out ? out + (size_t)row * Dm : nullptr, (bf16*)(ws + WS_HBF) + (size_t)row * Dm, lane, v);
}
}

namespace ret {
typedef short bf16x8 __attribute__((ext_vector_type(8)));
typedef short s16x4 __attribute__((ext_vector_type(4)));
typedef float f32x16 __attribute__((ext_vector_type(16)));
typedef float f32x4 __attribute__((ext_vector_type(4)));
typedef float f32x2_t __attribute__((ext_vector_type(2))); typedef __bf16 bf16x2_t __attribute__((ext_vector_type(2)));
DEV unsigned cvtpk(float lo, float hi) { f32x2_t v = {lo, hi}; bf16x2_t b = __builtin_convertvector(v, bf16x2_t); return __builtin_bit_cast(unsigned, b); }
#define RMFMA(a, b, c) __builtin_amdgcn_mfma_f32_32x32x16_bf16((a), (b), (c), 0, 0, 0)
constexpr int LS = 72;
constexpr int L_KR = 0, L_QR = 9216, L_KDT = 18432, L_VT = 27648, L_ST = 46080, L_O = 64512, OS = 132, L_END = L_O + 64 * OS * 4;
static_assert(L_END <= RING_BYTES, "retention LDS");
constexpr int SEGC = 8, NSEG = NCH / SEGC;
DEV int crow(int reg, int h) { return (reg & 3) + 8 * (reg >> 2) + 4 * h; }
DEV float bflo(unsigned w) { return __uint_as_float(w << 16); }
DEV float bfhi(unsigned w) { return __uint_as_float(w & 0xffff0000u); }

struct Raw { uint2 k1, k2, q1, q2; float4 cs, sn; uint4 v0, v1; };
template <bool WITH_Q> DEV void load_raw(Raw& R, const unsigned char* ws, int row0, int pos0, int h, int tid) {
    const int j = tid >> 3, c0 = (tid & 7) * 4;
    const bf16* K = (const bf16*)(ws + R_K) + (size_t)(row0 + j) * 512 + h * 64 + c0;
    R.k1 = *(const uint2*)K; R.k2 = *(const uint2*)(K + 32);
    if (WITH_Q) { const bf16* Q = (const bf16*)(ws + R_Q) + (size_t)(row0 + j) * 512 + h * 64 + c0; R.q1 = *(const uint2*)Q; R.q2 = *(const uint2*)(Q + 32); }
    R.cs = *(const float4*)((const float*)(ws + TAB_COS) + (pos0 + j) * 32 + c0); R.sn = *(const float4*)((const float*)(ws + TAB_SIN) + (pos0 + j) * 32 + c0);
    const bf16* V = (const bf16*)(ws + R_V) + (size_t)(row0 + j) * 1024 + h * 128 + (tid & 7) * 16;
    R.v0 = *(const uint4*)V; R.v1 = *(const uint4*)(V + 8);
}
DEV void rot4(const uint2 x1, const uint2 x2, const float4 cs, const float4 sn, float (&r1)[4], float (&r2)[4]) {
    const float a[4] = {bflo(x1.x), bfhi(x1.x), bflo(x1.y), bfhi(x1.y)}, b[4] = {bflo(x2.x), bfhi(x2.x), bflo(x2.y), bfhi(x2.y)};
    const float c[4] = {cs.x, cs.y, cs.z, cs.w}, s[4] = {sn.x, sn.y, sn.z, sn.w};
#pragma unroll
    for (int e = 0; e < 4; ++e) { r1[e] = a[e] * c[e] - b[e] * s[e]; r2[e] = a[e] * s[e] + b[e] * c[e]; }
}
template <bool WITH_Q> DEV void stage(LAS unsigned char* lds, const Raw& R, int tid, float kd) {
    const int j = tid >> 3, c0 = (tid & 7) * 4;
    float r1[4], r2[4];
    rot4(R.k1, R.k2, R.cs, R.sn, r1, r2);
    if (WITH_Q) { LAS bf16* kr = (LAS bf16*)(lds + L_KR) + j * LS + c0;
        *(LAS pg8::u32x2*)kr = (pg8::u32x2){cvtpk(r1[0], r1[1]), cvtpk(r1[2], r1[3])}; *(LAS pg8::u32x2*)(kr + 32) = (pg8::u32x2){cvtpk(r2[0], r2[1]), cvtpk(r2[2], r2[3])}; }
    LAS bf16* kdt = (LAS bf16*)(lds + L_KDT) + c0 * LS + j;
#pragma unroll
    for (int e = 0; e < 4; ++e) { kdt[e * LS] = f2bf(r1[e] * kd); kdt[(32 + e) * LS] = f2bf(r2[e] * kd); }
    if (WITH_Q) { rot4(R.q1, R.q2, R.cs, R.sn, r1, r2); LAS bf16* qr = (LAS bf16*)(lds + L_QR) + j * LS + c0;
        *(LAS pg8::u32x2*)qr = (pg8::u32x2){cvtpk(r1[0], r1[1]), cvtpk(r1[2], r1[3])}; *(LAS pg8::u32x2*)(qr + 32) = (pg8::u32x2){cvtpk(r2[0], r2[1]), cvtpk(r2[2], r2[3])}; }
    LAS bf16* vt = (LAS bf16*)(lds + L_VT) + ((tid & 7) * 16) * LS + j;
    const unsigned vw[8] = {R.v0.x, R.v0.y, R.v0.z, R.v0.w, R.v1.x, R.v1.y, R.v1.z, R.v1.w};
#pragma unroll
    for (int e = 0; e < 8; ++e) { vt[(2 * e) * LS] = (bf16)(vw[e] & 0xffffu); vt[(2 * e + 1) * LS] = (bf16)(vw[e] >> 16); }
}
DEV bf16x8 ld8(const LAS bf16* p) { return *(const LAS bf16x8*)p; }
DEV void state_update(f32x16& ST, const LAS unsigned char* lds, int wi, int wd, int r, int hh, float cd) {
#pragma unroll
    for (int e = 0; e < 16; ++e) ST[e] *= cd;
    const LAS bf16* a = (const LAS bf16*)(lds + L_KDT) + (32 * wi + r) * LS + 8 * hh; const LAS bf16* b = (const LAS bf16*)(lds + L_VT) + (32 * wd + r) * LS + 8 * hh;
#pragma unroll
    for (int s = 0; s < 4; ++s) ST = RMFMA(ld8(a + 16 * s), ld8(b + 16 * s), ST);
}

DEV void phase_a(const int wbase, LAS unsigned char* lds, unsigned char* ws, int G, int vcu) {
    const int wave = wbase >> 6, tid = pg8::fresh_tid(wbase), lane = tid & 63, r = lane & 31, hh = lane >> 5, wi = wave >> 2, wd = wave & 3;
    for (int item = vcu; item < BATCH * RH * NSEG; item += G) {
        const int seg = item % NSEG, h = (item / NSEG) % RH, b = item / (NSEG * RH);
        const float lg2g = log1pf(-__builtin_amdgcn_exp2f(-5.0f - (float)h)) * 1.4426950408889634f, cd = __builtin_amdgcn_exp2f(64.f * lg2g);
        f32x16 ST;
#pragma unroll
        for (int e = 0; e < 16; ++e) ST[e] = 0.f;
        const float kdj = __builtin_amdgcn_exp2f((float)(63 - (tid >> 3)) * lg2g);
        Raw R; load_raw<false>(R, ws, b * SEQ + seg * SEGC * CHUNK, seg * SEGC * CHUNK, h, tid);
#pragma nounroll
        for (int n = 0; n < SEGC; ++n) {
            __syncthreads();
            stage<false>(lds, R, tid, kdj);
            __syncthreads();
            if (n + 1 < SEGC) load_raw<false>(R, ws, b * SEQ + (seg * SEGC + n + 1) * CHUNK, (seg * SEGC + n + 1) * CHUNK, h, tid);
            state_update(ST, lds, wi, wd, r, hh, cd);
        }
        float* TOT = (float*)(ws + WS_HB) + (size_t)item * 8192 + wave * 1024 + lane;
#pragma unroll
        for (int e = 0; e < 16; ++e) TOT[e * 64] = ST[e];
    }
    __syncthreads();
}
DEV void phase_b(const int wbase, LAS unsigned char* lds, unsigned char* ws, int G, int vcu) {
    const int wave = wbase >> 6, tid = pg8::fresh_tid(wbase), lane = tid & 63, r = lane & 31, hh = lane >> 5, wi = wave >> 2, wd = wave & 3;
    for (int item = vcu; item < BATCH * RH * NSEG; item += G) {
        const int seg = item % NSEG, h = (item / NSEG) % RH, b = item / (NSEG * RH);
        const float lg2g = log1pf(-__builtin_amdgcn_exp2f(-5.0f - (float)h)) * 1.4426950408889634f, cd = __builtin_amdgcn_exp2f(64.f * lg2g), cd8 = __builtin_amdgcn_exp2f(64.f * SEGC * lg2g);
        f32x16 ST;
#pragma unroll
        for (int e = 0; e < 16; ++e) ST[e] = 0.f;
#pragma nounroll
        for (int s = 0; s < seg; ++s) { const float* TOT = (const float*)(ws + WS_HB) + (size_t)(item - seg + s) * 8192 + wave * 1024 + lane;
#pragma unroll
            for (int e = 0; e < 16; ++e) ST[e] = cd8 * ST[e] + TOT[e * 64]; }
        const float kdj = __builtin_amdgcn_exp2f((float)(63 - (tid >> 3)) * lg2g);
        Raw R; load_raw<true>(R, ws, b * SEQ + seg * SEGC * CHUNK, seg * SEGC * CHUNK, h, tid);
        float mk0[16], mk1[16], qdec[16];
        { const int lq = pg8::fresh_tid(wbase) & 63, iq = 32 * wi + (lq & 31), hq = lq >> 5;
#pragma unroll
          for (int e = 0; e < 16; ++e) { const int j0 = crow(e, hq), d0 = iq > j0 ? iq - j0 : j0 - iq, d1 = iq > j0 + 32 ? iq - j0 - 32 : j0 + 32 - iq;
              mk0[e] = __builtin_amdgcn_exp2f((float)d0 * lg2g); mk1[e] = __builtin_amdgcn_exp2f((float)d1 * lg2g); qdec[e] = __builtin_amdgcn_exp2f((float)(32 * wi + j0 + 1) * lg2g); } }
#pragma nounroll
        for (int n = 0; n < SEGC; ++n) {
            const int row0 = b * SEQ + (seg * SEGC + n) * CHUNK;
            stage<true>(lds, R, tid, kdj);
            { LAS bf16* st = (LAS bf16*)(lds + L_ST) + (32 * wd + r) * LS + 32 * wi + 4 * hh;
#pragma unroll
              for (int g4 = 0; g4 < 4; ++g4) *(LAS pg8::u32x2*)(st + 8 * g4) = (pg8::u32x2){cvtpk(ST[4 * g4], ST[4 * g4 + 1]), cvtpk(ST[4 * g4 + 2], ST[4 * g4 + 3])}; }
            __syncthreads();
            if (n + 1 < SEGC) load_raw<true>(R, ws, row0 + CHUNK, (seg * SEGC + n + 1) * CHUNK, h, tid);
            const bf16* Gp = (const bf16*)(ws + R_G) + (size_t)(row0 + (tid >> 3)) * 1024 + h * 128 + (tid & 7) * 16;
            const uint4 g0 = *(const uint4*)Gp, g1 = *(const uint4*)(Gp + 8);
            f32x16 X0, X1;
#pragma unroll
            for (int e = 0; e < 16; ++e) { X0[e] = 0.f; X1[e] = 0.f; }
            const LAS bf16* kr = (const LAS bf16*)(lds + L_KR) + r * LS + 8 * hh; const LAS bf16* qr = (const LAS bf16*)(lds + L_QR) + (32 * wi + r) * LS + 8 * hh;
#pragma unroll
            for (int s = 0; s < 4; ++s) { const bf16x8 qb = ld8(qr + 16 * s); X0 = RMFMA(ld8(kr + 16 * s), qb, X0); X1 = RMFMA(ld8(kr + 32 * LS + 16 * s), qb, X1); }
#pragma unroll
            for (int e = 0; e < 16; ++e) { X0[e] *= mk0[e]; X1[e] *= mk1[e]; }
            f32x16 O;
#pragma unroll
            for (int e = 0; e < 16; ++e) O[e] = 0.f;
            const LAS bf16* stb = (const LAS bf16*)(lds + L_ST) + (32 * wd + r) * LS + 8 * hh;
#pragma unroll
            for (int s = 0; s < 4; ++s) O = RMFMA(ld8(qr + 16 * s), ld8(stb + 16 * s), O);
#pragma unroll
            for (int e = 0; e < 16; ++e) O[e] *= qdec[e];
            const LAS bf16* vt = (const LAS bf16*)(lds + L_VT) + (32 * wd + r) * LS + 4 * hh;
#pragma unroll
            for (int s = 0; s < 2; ++s) {
                bf16x8 pa, pb;
                { const unsigned w0 = cvtpk(X0[8 * s], X0[8 * s + 1]), w1 = cvtpk(X0[8 * s + 2], X0[8 * s + 3]), w2 = cvtpk(X0[8 * s + 4], X0[8 * s + 5]), w3 = cvtpk(X0[8 * s + 6], X0[8 * s + 7]);
                  const pg8::u32x4 p = {w0, w1, w2, w3}; pa = __builtin_bit_cast(bf16x8, p); }
                { const unsigned w0 = cvtpk(X1[8 * s], X1[8 * s + 1]), w1 = cvtpk(X1[8 * s + 2], X1[8 * s + 3]), w2 = cvtpk(X1[8 * s + 4], X1[8 * s + 5]), w3 = cvtpk(X1[8 * s + 6], X1[8 * s + 7]);
                  const pg8::u32x4 p = {w0, w1, w2, w3}; pb = __builtin_bit_cast(bf16x8, p); }
                const s16x4 a0 = *(const LAS s16x4*)(vt + 16 * s), a1 = *(const LAS s16x4*)(vt + 16 * s + 8), b0 = *(const LAS s16x4*)(vt + 32 + 16 * s), b1 = *(const LAS s16x4*)(vt + 32 + 16 * s + 8);
                O = RMFMA(pa, __builtin_shufflevector(a0, a1, 0, 1, 2, 3, 4, 5, 6, 7), O);
                O = RMFMA(pb, __builtin_shufflevector(b0, b1, 0, 1, 2, 3, 4, 5, 6, 7), O);
            }
            state_update(ST, lds, wi, wd, r, hh, cd);
            { LAS float* ob = (LAS float*)(lds + L_O) + (32 * wi + 4 * hh) * OS + 32 * wd + r;
#pragma unroll
              for (int e = 0; e < 16; ++e) ob[((e & 3) + 8 * (e >> 2)) * OS] = O[e]; }
            __syncthreads();
            { const int i = tid >> 3, c0 = (tid & 7) * 16; const LAS float* orow = (const LAS float*)(lds + L_O) + i * OS + c0;
              float o[16];
#pragma unroll
              for (int q4 = 0; q4 < 4; ++q4) { const f32x4 t4 = *(const LAS f32x4*)(orow + 4 * q4); o[4 * q4] = t4[0]; o[4 * q4 + 1] = t4[1]; o[4 * q4 + 2] = t4[2]; o[4 * q4 + 3] = t4[3]; }
              float sm = 0.f;
#pragma unroll
              for (int c = 0; c < 16; ++c) sm += o[c];
              sm += xshfl<1>(sm); sm += xshfl<2>(sm); sm += xshfl<4>(sm);
              const float mean = sm * (1.f / 128.f); float qq = 0.f;
#pragma unroll
              for (int c = 0; c < 16; ++c) { o[c] -= mean; qq += o[c] * o[c]; }
              qq += xshfl<1>(qq); qq += xshfl<2>(qq); qq += xshfl<4>(qq);
              const float rstd = rsqrtf(qq * (1.f / 128.f) + HN_EPS);
              const unsigned gw[8] = {g0.x, g0.y, g0.z, g0.w, g1.x, g1.y, g1.z, g1.w}; unsigned ow[8];
#pragma unroll
              for (int e = 0; e < 8; ++e) ow[e] = cvtpk(bflo(gw[e]) * o[2 * e] * rstd, bfhi(gw[e]) * o[2 * e + 1] * rstd);
              bf16* Ap = (bf16*)(ws + R_V) + (size_t)(row0 + i) * 1024 + h * 128 + c0;
              *(uint4*)Ap = make_uint4(ow[0], ow[1], ow[2], ow[3]); *(uint4*)(Ap + 8) = make_uint4(ow[4], ow[5], ow[6], ow[7]); }
        }
    }
    __syncthreads();
}
}

namespace s5 {
using ret::bf16x8; using ret::s16x4; using ret::f32x16; using ret::cvtpk; using ret::crow;
typedef short v4i16_t __attribute__((ext_vector_type(4)));
DEV s16x4 trr(const LAS unsigned char* p) { return __builtin_bit_cast(s16x4, __builtin_amdgcn_ds_read_tr16_b64_v4i16((LAS v4i16_t*)p)); }
struct Cx { float x, y; };
DEV Cx cmul(Cx a, Cx b) { return {a.x * b.x - a.y * b.y, a.x * b.y + a.y * b.x}; }
DEV Cx cfma(Cx a, Cx b, Cx c) { return {a.x * b.x - a.y * b.y + c.x, a.x * b.y + a.y * b.x + c.y}; }

constexpr int SC = 4, NSG = NCH / SC;
template <bool OUT> DEV void pass(const int wbase, LAS unsigned char* lds, unsigned char* ws, const float* __restrict__ dsk, int layer, int G, int vcu) {
    const int wave = wbase >> 6;
    LAS unsigned char* img = lds + wave * 8192;
    bf16* U = (bf16*)(ws + R_U);
    for (int wi = vcu; wi < BATCH * NSG * (S5G / 8); wi += G) {
        const int lane = pg8::fresh_tid(wbase) & 63, r = lane & 31, hh = lane >> 5;
        const int oct = wi % (S5G / 8), sg = (wi / (S5G / 8)) % NSG, b = wi / ((S5G / 8) * NSG), g = oct * 8 + wave, lg = layer * S5G + g;
        const bf16* BBH = (const bf16*)(ws + TAB_BBH) + (size_t)lg * 128 * 16;
        bf16x8 bbf[4];
#pragma unroll
        for (int nt = 0; nt < 4; ++nt) bbf[nt] = *(const bf16x8*)(BBH + (32 * nt + r) * 16 + 8 * hh);
        Cx a1q[2], c[2];
#pragma unroll
        for (int q = 0; q < 2; ++q) {
            const float2 av = *(const float2*)((const float*)(ws + TAB_AB) + ((size_t)lg * S5N + 32 * q + r) * 2);
            a1q[q] = Cx{av.x, av.y}; c[q] = Cx{0.f, 0.f};
            if (OUT) { Cx ap = a1q[q];
#pragma unroll
                for (int sq = 0; sq < 8; ++sq) ap = cmul(ap, ap);
                const float2* E = (const float2*)(ws + WS_S5E) + ((size_t)(b * NSG) * S5G + g) * S5N + 32 * q + r;
                float2 ev[NSG - 1];
#pragma unroll
                for (int s = 0; s < NSG - 1; ++s) ev[s] = E[(size_t)s * S5G * S5N];
#pragma unroll
                for (int s = 0; s < NSG - 1; ++s) if (s < sg) c[q] = cfma(ap, c[q], Cx{ev[s].x, ev[s].y}); }
        }
        bf16x8 bd; LAS bf16x8* ctl = (LAS bf16x8*)(lds + 65536 + wave * 8192) + lane;
        if (OUT) { const bf16* CTH = (const bf16*)(ws + TAB_CTH) + ((size_t)lg * 16 + (r & 15)) * 128 + 8 * hh;
#pragma unroll
            for (int nt = 0; nt < 4; ++nt)
#pragma unroll
                for (int s = 0; s < 2; ++s) ctl[(nt * 2 + s) * 64] = *(const bf16x8*)(CTH + 32 * nt + 16 * s);
            const float dval = dsk[layer * 512 + g * 16 + (r & 15)];
#pragma unroll
            for (int e = 0; e < 8; ++e) bd[e] = (short)(((r & 15) == 8 * hh + e) ? f2bf(dval) : (bf16)0); }
        const int i16 = lane & 15, q4 = i16 >> 2, p4 = i16 & 3, blk = (lane >> 4) & 1;
        const int rowS = b * SEQ + sg * SC * 64;
        bf16x8 un[2];
#pragma unroll
        for (int th = 0; th < 2; ++th) un[th] = *(const bf16x8*)(U + (size_t)(rowS + 32 * th + r) * 512 + g * 16 + 8 * hh);
#pragma nounroll
        for (int jc = 0; jc < SC; ++jc) {
            const int row0 = rowS + jc * 64;
            bf16x8 ua[2]; ua[0] = un[0]; ua[1] = un[1];
            if (jc + 1 < SC) {
#pragma unroll
                for (int th = 0; th < 2; ++th) un[th] = *(const bf16x8*)(U + (size_t)(row0 + 64 + 32 * th + r) * 512 + g * 16 + 8 * hh); }
#pragma unroll
            for (int th = 0; th < 2; ++th) {
                f32x16 BU[4];
#pragma unroll
                for (int nt = 0; nt < 4; ++nt) { f32x16 z;
#pragma unroll
                    for (int e = 0; e < 16; ++e) z[e] = 0.f;
                    BU[nt] = RMFMA(ua[th], bbf[nt], z); }
#pragma unroll
                for (int q = 0; q < 2; ++q) {
                    const Cx a1 = a1q[q], a2 = cmul(a1, a1), a3 = cmul(a2, a1), a4 = cmul(a2, a2);
                    Cx cc = c[q];
#pragma unroll
                    for (int qb = 0; qb < 4; ++qb) {
                        f32x16& RE = BU[q]; f32x16& IM = BU[2 + q];
                        Cx x = {RE[4 * qb], IM[4 * qb]};
#pragma unroll
                        for (int i = 1; i < 4; ++i) x = cfma(a1, x, Cx{RE[4 * qb + i], IM[4 * qb + i]});
                        Cx g0, g1; xhalves(x.x, g0.x, g1.x); xhalves(x.y, g0.y, g1.y);
                        const Cx c0 = cc; cc = cfma(a4, cc, g0); const Cx c1 = cc; cc = cfma(a4, cc, g1);
                        if (OUT) { Cx hx = hh ? c1 : c0;
#pragma unroll
                            for (int i = 0; i < 4; ++i) { hx = cfma(a1, hx, Cx{RE[4 * qb + i], IM[4 * qb + i]}); RE[4 * qb + i] = hx.x; IM[4 * qb + i] = hx.y; } }
                    }
                    c[q] = cc;
                }
                if (OUT) {
                    asm volatile("s_waitcnt lgkmcnt(0)" ::: "memory");
#pragma unroll
                    for (int nt = 0; nt < 4; ++nt)
#pragma unroll
                        for (int g4 = 0; g4 < 4; ++g4) { const f32x16& X = BU[nt];
                            *(LAS pg8::u32x2*)(img + nt * 2048 + r * 64 + 8 * (2 * g4 + hh)) = (pg8::u32x2){cvtpk(X[4 * g4], X[4 * g4 + 1]), cvtpk(X[4 * g4 + 2], X[4 * g4 + 3])}; }
                    asm volatile("s_waitcnt lgkmcnt(0)" ::: "memory");
                    f32x16 Y;
#pragma unroll
                    for (int e = 0; e < 16; ++e) Y[e] = 0.f;
#pragma unroll
                    for (int nt = 0; nt < 4; ++nt)
#pragma unroll
                        for (int s = 0; s < 2; ++s) {
                            const s16x4 lo = trr(img + nt * 2048 + (16 * s + 8 * hh + q4) * 64 + 8 * (4 * blk + p4));
                            const s16x4 hi = trr(img + nt * 2048 + (16 * s + 8 * hh + 4 + q4) * 64 + 8 * (4 * blk + p4));
                            const bf16x8 xa = __builtin_shufflevector(lo, hi, 0, 1, 2, 3, 4, 5, 6, 7);
                            Y = RMFMA(xa, ctl[(nt * 2 + s) * 64], Y);
                        }
                    Y = RMFMA(ua[th], bd, Y);
                    { const int up = r >> 4;
#pragma unroll
                      for (int e = 0; e < 8; ++e) { const float yv = up ? Y[8 + e] : Y[e]; const float u3 = yv * yv * yv;
                          const float zz = yv * __builtin_amdgcn_rcpf(1.f + __expf(-1.5957691216057308f * (yv + 0.044715f * u3)));
                          U[(size_t)(row0 + 32 * th + (e & 3) + 8 * ((e >> 2) + 2 * up) + 4 * hh) * 512 + g * 16 + (r & 15)] = f2bf(zz); } }
                }
            }
        }
        if (!OUT) {
            if (hh == 0) { float2* E = (float2*)(ws + WS_S5E) + ((size_t)(b * NSG + sg) * S5G + g) * S5N + r;
                E[0] = make_float2(c[0].x, c[0].y); E[32] = make_float2(c[1].x, c[1].y); }
        }
    }
    asm volatile("s_waitcnt lgkmcnt(0)" ::: "memory");
    __syncthreads();
}
}

__global__ void __launch_bounds__(NWAVES * 64, 2) mk_fwd(Args args_k) {
    extern __shared__ __attribute__((aligned(16))) unsigned char lds_raw[];
    LAS unsigned char* lds = (LAS unsigned char*)lds_raw;
    volatile LAS unsigned* MISC = (volatile LAS unsigned*)(lds + MISC_OFF);
    const int wbase = __builtin_amdgcn_readfirstlane((int)threadIdx.x) & ~63;
    const int G = gridDim.x;
    unsigned* ctl = (unsigned*)(args_k.ws + WS_CTL);
    { const int tid = pg8::fresh_tid(wbase); for (int u = tid; u < (LDS_BYTES - LDSCTL_OFF) / 4; u += NWAVES * 64) ((LAS unsigned*)(lds + LDSCTL_OFF))[u] = 0u; }
    __syncthreads();
    if (pg8::fresh_tid(wbase) == 0) { const unsigned b0 = blockIdx.x; MISC[8 + 4] = b0; MISC[8 + 5] = (G % 8 == 0) ? (b0 % 8u) * (unsigned)(G / 8) + b0 / 8u : b0; }
    __syncthreads();
    if ((args_k.ph_hi - args_k.ph_lo) > 1) (void)xcd_barrier_post(ctl + CW_BAR + args_k.bar_id * XCD_BAR_WORDS, MISC + 8, pg8::fresh_tid(wbase) == 0);
    const int ph_lo = args_k.ph_lo, ph_hi = args_k.ph_hi;
    bool rep_done = false; (void)rep_done;
    for (int ph = ph_lo; ph < ph_hi; ++ph) {
        const int l = ph > 0 ? (ph - 1) / NPL : 0, k = ph > 0 ? (ph - 1) % NPL : -1;
        unsigned moff = MISC_OFF + 32; asm volatile("" : "+s"(moff));
        const volatile LAS unsigned* MS = (const volatile LAS unsigned*)(lds + moff);
        const bool lok = __builtin_amdgcn_readfirstlane((int)MS[2]) != 0;
        const int bx = __builtin_amdgcn_readfirstlane((int)MS[4]), vcu = __builtin_amdgcn_readfirstlane((int)MS[5]);
        const __attribute__((address_space(4))) Args* ap = (const __attribute__((address_space(4))) Args*)__builtin_amdgcn_kernarg_segment_ptr(); asm volatile("" : "+s"(ap));
        const Args& args = *(const Args*)ap;
        unsigned char* ws = ap->ws;
        float* hA = ap->out; float* hB = (float*)(ws + WS_HB); bf16* hbf = (bf16*)(ws + WS_HBF);
        switch (k) {
        case -1: { ph::ProIn P{args.in[0], args.in[1], args.in[2], args.in[3], args.in[4], args.in[5], args.in[6], args.in[7], args.in[8], args.in[9], args.in[10], args.in[12], args.in[13], args.in[14], args.in[15], args.in[18], args.in[20], args.out};
            ph::prologue(wbase, lds, ws, P, G, vcu); } break;
        case K_PROJ: case K_BRANCH: {
            if (k == K_BRANCH) {
            { pg8::Gemm g{(const bf16*)(ws + R_V), (const bf16*)(ws + W_BRET) + (size_t)l * Dm * RV, RV}; pg8::StaticOrder S; S.init(T, Dm, RV, G, bx);
              epi::EpiRet E{ws}; pg8::gemm_phase<RV, epi::EpiRet, pg8::StaticOrder, true>(wbase, lds + RING_OFF, lds + PARK_OFF, g, S, E); }
            { pg8::Gemm g{(const bf16*)(ws + R_U), (const bf16*)(ws + W_GLU) + (size_t)l * S5W * S5W, S5W}; pg8::StaticOrder S; S.init(T, S5W, S5W, G, bx);
              epi::EpiGlu E{ws}; pg8::gemm_phase<S5W, epi::EpiGlu, pg8::StaticOrder, true>(wbase, lds + RING_OFF, lds + PARK_OFF, g, S, E); }
            }
            { const bool late = (k == K_BRANCH); const int hg = G / 2;
              pg8::Gemm g{hbf, (const bf16*)(ws + W_IN) + (size_t)l * INW * Dm, Dm}; pg8::StaticOrder S; S.init(T, late ? 512 : INW - 512, Dm, G, late ? (bx >= hg ? bx - hg : bx + G - hg) : bx, late ? (INW - 512) / 256 : 0);
              epi::EpiProj E{ws}; pg8::gemm_phase<Dm, epi::EpiProj, pg8::StaticOrder, true>(wbase, lds + RING_OFF, lds + PARK_OFF, g, S, E); } } break;
        case K_RETA: ret::phase_a(wbase, lds, ws, G, vcu); s5::pass<false>(wbase, lds, ws, nullptr, l, G, vcu); break;
        case K_RETB: ret::phase_b(wbase, lds, ws, G, vcu); s5::pass<true>(wbase, lds, ws, ap->in[11], l, G, vcu); break;
        case K_S5B: {
            pg8::Gemm g{(const bf16*)(ws + R_S5IN), (const bf16*)(ws + W_BS5) + (size_t)l * Dm * S5W, S5W}; pg8::StaticOrder S; S.init(T, Dm, S5W, G, bx);
            epi::EpiS5b E{ws}; pg8::gemm_phase<S5W, epi::EpiS5b, pg8::StaticOrder, true>(wbase, lds + RING_OFF, lds + PARK_OFF, g, S, E); } break;
        case K_OUT: {
            pg8::Gemm g{(const bf16*)(ws + R_G), (const bf16*)(ws + W_OUT) + (size_t)l * Dm * Dm, Dm}; pg8::StaticOrder S; S.init(T, Dm, Dm, G, bx);
            epi::EpiOut E{hbf, (bf16*)hB}; pg8::gemm_phase<Dm, epi::EpiOut, pg8::StaticOrder, true>(wbase, lds + RING_OFF, lds + PARK_OFF, g, S, E); } break;
        case K_LNROUTE: { ph::RouteIn P{args.in[16] + l * Dm, args.in[17] + l * Dm, args.in[19] + l * MG, args.in[21] + l * NE, args.in[22] + (size_t)l * NE * Dm * FF, args.in[23] + (size_t)l * NE * Dm * FF, args.in[24] + (size_t)l * NE * FF * Dm};
            ph::phase_lnroute(wbase, lds, ws, P, l, G, vcu); } break;
        case K_MOEGU: case K_MOEDN: {
            LAS unsigned* tp = (LAS unsigned*)(lds + LDSCTL_OFF + 512);
            const int tid = pg8::fresh_tid(wbase);
            if (tid < 32) tp[33 + tid] = __hip_atomic_load((unsigned*)(ws + WS_CNT) + l * NE + tid, __ATOMIC_RELAXED, __HIP_MEMORY_SCOPE_AGENT);
            __syncthreads();
            if (tid == 0) { unsigned a = 0; for (int j = 0; j < 32; ++j) { tp[j] = a; a += (tp[33 + j] + 255u) >> 8; } tp[32] = a; }
            __syncthreads();
            const unsigned* LIST = (const unsigned*)(ws + RT_LIST);
            if (k == K_MOEGU) {
                pg8::Gemm g{hbf, (const bf16*)(ws + R_WGU), Dm}; pg8::GroupedOrder S{tp, LIST, 2, G, vcu, 1};
                epi::EpiMoeGU E{ws, LIST}; pg8::gemm_phase<Dm, epi::EpiMoeGU, pg8::GroupedOrder, true>(wbase, lds + RING_OFF, lds + PARK_OFF, g, S, E);
                { const int U = 2 * __builtin_amdgcn_readfirstlane((int)tp[32]), R2 = U > G ? (U - G < G ? U - G : G) : 0, W1 = G - R2;
                  const int lane = pg8::fresh_tid(wbase) & 63, wv = wbase >> 6; constexpr int I_D = (FF / 64) * (Dm / 32);
                  const float* wd = ap->in[24] + (size_t)l * NE * FF * Dm;
                  auto decode = [&](int it) { const int e = it / I_D, r = it % I_D;
                      return ph::ConvItem{wd + (size_t)e * FF * Dm, (bf16*)(ws + R_WDN) + (size_t)e * Dm * FF, FF, Dm, 1, 0, 64 * (r / (Dm / 32)), 32 * (r % (Dm / 32))}; };
                  if (W1 > 0) { if (vcu >= R2) ph::conv_run(decode, (vcu - R2) * NWAVES + wv, W1 * NWAVES, NE * I_D, lds + wv * 16384, lane); }
                  else ph::conv_run(decode, bx * NWAVES + wv, G * NWAVES, NE * I_D, lds + wv * 16384, lane);
                  __syncthreads(); }
            } else {
                pg8::Gemm g{(const bf16*)(ws + R_ACT), (const bf16*)(ws + R_WDN), FF}; pg8::GroupedOrder S{tp, LIST, 4, G, vcu, 0};
                epi::EpiMoeDN E{ws, LIST}; pg8::gemm_phase<FF, epi::EpiMoeDN, pg8::GroupedOrder, true>(wbase, lds + RING_OFF, lds + PARK_OFF, g, S, E);
            } } break;
        case K_LN2: ph::phase_ln2(wbase, ws, args.in[25] + l * Dm, args.in[26] + l * Dm, l == DEPTH - 1 ? args.out : nullptr, G, vcu); break;
        default: break;
        }
#ifdef PROBE_REP_MASK
        if (((k >= 0 && ((PROBE_REP_MASK >> k) & 1)) || (k < 0 && (PROBE_REP_MASK & 0x8000))) && !rep_done) { rep_done = true; --ph; } else rep_done = false;
#endif
        if (ph + 1 < ph_hi) { XcdBarrier bar; bar.bar = (unsigned*)(ws + WS_CTL) + CW_BAR + ap->bar_id * XCD_BAR_WORDS; bar.x = xb_xcc_id(); bar.st = (volatile LAS unsigned*)(lds + MISC_OFF) + 8;
            const bool local = lok && (k == K_PROJ || k == K_RETA || k == K_RETB || k == K_BRANCH || k == K_S5B || k == K_OUT);
            xcd_barrier(bar, pg8::fresh_tid(wbase) == 0, local); }
    }
}
#ifndef MK_ONE_LAUNCH
#define MK_ONE_LAUNCH 1
#endif
static int g_grid = 0;
static void launch_mk(const Args& base, int lo, int hi, int bar_id, hipStream_t stream) {
    Args a = base; a.ph_lo = lo; a.ph_hi = hi; a.bar_id = bar_id;
    hipLaunchKernelGGL(mk_fwd, dim3(g_grid), dim3(NWAVES * 64), LDS_BYTES, stream, a);
}
extern "C" void kernel_launch(void* const* d_in, const int* in_sizes, int n_in, void* d_out, int out_size, void* d_ws, size_t ws_size, hipStream_t stream) {
    static int ok = 0;
    if (ok == 0) {
        if (n_in != 27 || in_sizes[0] != T * Dm || out_size != T * Dm || ws_size < WS_END) { fprintf(stderr, "kernel_launch: unexpected shapes/ws (%d, %d, %d, %zu < %zu)\n", n_in, n_in > 0 ? in_sizes[0] : -1, out_size, ws_size, (size_t)WS_END); ok = -1; return; }
        int dev = 0, cus = 0;
        if (hipGetDevice(&dev) != hipSuccess || hipDeviceGetAttribute(&cus, hipDeviceAttributeMultiprocessorCount, dev) != hipSuccess) { fprintf(stderr, "kernel_launch: device query failed\n"); ok = -1; return; }
        if (hipFuncSetAttribute((const void*)mk_fwd, hipFuncAttributeMaxDynamicSharedMemorySize, LDS_BYTES) != hipSuccess) { fprintf(stderr, "kernel_launch: LDS attribute failed\n"); ok = -1; return; }
        g_grid = cus;
        ok = 1;
    }
    if (ok < 0) return;
    unsigned char* ws = (unsigned char*)d_ws;
    const float* const* in = (const float* const*)d_in;
    float* hA = (float*)d_out;
    (void)hipMemsetAsync(ws + WS_CTL, 0, 1 * MiB, stream);
    Args base{}; for (int i = 0; i < 27; ++i) base.in[i] = in[i]; base.out = hA; base.ws = ws;
#if MK_ONE_LAUNCH
    launch_mk(base, 0, NPH, 0, stream);
#else
    for (int p = 0; p < NPH; ++p) launch_mk(base, p, p + 1, 0, stream);
#endif
}
```
